# Optimizing an MI355X kernel written in HIP

```python
import math
import jax, jax.numpy as jnp
from jax import lax
import numpy as np

D_MODEL = 2048
BATCH = 2
SEQ = 4096
DEPTH = 1

CHUNK = 64
N_MEM = 256
BRANCH_WIDTH = D_MODEL // 2
N_BRANCH = 3
GLA_HEADS = 4
GLA_DK = (D_MODEL // 4) // GLA_HEADS
GLA_DV = BRANCH_WIDTH // GLA_HEADS
GLA_RANK = 16
GLA_GATE_NORM = 16.0
DIFF_HEADS = 4
DIFF_DV = BRANCH_WIDTH // DIFF_HEADS
DIFF_DH = DIFF_DV // 2
Q_BLOCK = 128
MEM_HEADS = 4
MEM_DH = BRANCH_WIDTH // MEM_HEADS
_FF_RAW = -(-8 * D_MODEL // 3)
D_FF = -(-_FF_RAW // 256) * 256

NORM_EPS = 1e-6
NEG_INF = -1e30

IN_SIZES = (
    GLA_HEADS * GLA_DK,
    GLA_HEADS * GLA_DK,
    GLA_HEADS * GLA_DV,
    GLA_HEADS * GLA_DV,
    GLA_RANK,
    DIFF_HEADS * 2 * DIFF_DH,
    DIFF_HEADS * 2 * DIFF_DH,
    DIFF_HEADS * DIFF_DV,
    MEM_HEADS * MEM_DH,
)

kernel_name = "hybrid_gla_diffattn_memxattn_swiglu"


def rms_norm(x, g):
    xf = x.astype(jnp.float32)
    y = xf * lax.rsqrt(jnp.mean(xf * xf, axis=-1, keepdims=True) + NORM_EPS)
    return (y * g.astype(jnp.float32)).astype(x.dtype)


def split_cols(z, sizes):
    parts, start = [], 0
    for s in sizes:
        parts.append(z[..., start:start + s])
        start += s
    return parts


def gla_mixer(q, k, v, g, a_low, w_alpha_up, b_alpha, norm_g):
    B, S, _ = q.shape
    N = S // CHUNK
    f32 = jnp.float32
    log_a = jax.nn.log_sigmoid((a_low @ w_alpha_up + b_alpha).astype(f32)) / GLA_GATE_NORM

    def heads(t, d):
        return t.reshape(B, N, CHUNK, GLA_HEADS, d).transpose(0, 3, 1, 2, 4)

    qh = heads(q, GLA_DK).astype(f32) * (GLA_DK ** -0.5)
    kh = heads(k, GLA_DK).astype(f32)
    vh = heads(v, GLA_DV).astype(f32)
    bcum = jnp.cumsum(heads(log_a, GLA_DK), axis=3)
    b_last = bcum[:, :, :, -1:, :]
    q_dec = qh * jnp.exp(bcum)
    k_dec = kh * jnp.exp(-bcum)
    causal = jnp.tril(jnp.ones((CHUNK, CHUNK), dtype=bool))
    att = jnp.where(causal, jnp.einsum('bhnld,bhnmd->bhnlm', q_dec, k_dec), 0.0)
    o_intra = jnp.einsum('bhnlm,bhnmv->bhnlv', att, vh)
    k_tail = kh * jnp.exp(b_last - bcum)
    inc = jnp.einsum('bhnld,bhnlv->nbhdv', k_tail, vh)
    decay = jnp.exp(b_last[:, :, :, 0, :]).transpose(2, 0, 1, 3)

    def step(state, inp):
        dec, add = inp
        return dec[..., None] * state + add, state

    s0 = jnp.zeros((B, GLA_HEADS, GLA_DK, GLA_DV), f32)
    _, s_prev = lax.scan(step, s0, (decay, inc))
    o_inter = jnp.einsum('bhnld,nbhdv->bhnlv', q_dec, s_prev)
    o = (o_intra + o_inter).transpose(0, 2, 3, 1, 4).reshape(B, S, GLA_HEADS, GLA_DV)
    o = rms_norm(o, norm_g).reshape(B, S, GLA_HEADS * GLA_DV)
    return (o * jax.nn.silu(g.astype(f32))).astype(q.dtype)


def diff_mixer(q, k, v, qn_g, kn_g, lq1, lk1, lq2, lk2, subln_g, lam_init):
    B, S, _ = q.shape
    f32 = jnp.float32
    qh = rms_norm(q.reshape(B, S, DIFF_HEADS, 2, DIFF_DH), qn_g).transpose(0, 2, 3, 1, 4)
    kh = rms_norm(k.reshape(B, S, DIFF_HEADS, 2, DIFF_DH), kn_g).transpose(0, 2, 3, 1, 4)
    vh = v.reshape(B, S, DIFF_HEADS, DIFF_DV).transpose(0, 2, 1, 3)
    lam = (jnp.exp(jnp.sum(lq1 * lk1).astype(f32)) - jnp.exp(jnp.sum(lq2 * lk2).astype(f32))
           + lam_init)
    nb = S // Q_BLOCK
    q_blocks = qh.reshape(B, DIFF_HEADS, 2, nb, Q_BLOCK, DIFF_DH).transpose(3, 0, 1, 2, 4, 5)
    k_chunk = jnp.arange(S) // CHUNK
    scale = DIFF_DH ** -0.5

    def one_block(args):
        qb, blk = args
        q_chunk = (blk * Q_BLOCK + jnp.arange(Q_BLOCK)) // CHUNK
        mask = k_chunk[None, :] <= q_chunk[:, None]
        s = jnp.einsum('bhjqd,bhjkd->bhjqk', qb, kh).astype(f32) * scale
        p = jax.nn.softmax(jnp.where(mask, s, NEG_INF), axis=-1)
        a = p[:, :, 0] - lam * p[:, :, 1]
        return jnp.einsum('bhqk,bhkv->bhqv', a.astype(vh.dtype), vh)

    o = lax.map(one_block, (q_blocks, jnp.arange(nb)))
    o = o.transpose(1, 0, 3, 2, 4).reshape(B, S, DIFF_HEADS, DIFF_DV)
    o = rms_norm(o, subln_g) * (1.0 - lam_init)
    return o.reshape(B, S, DIFF_HEADS * DIFF_DV)


def mem_cross_attention(q, mem_n, w_mem_kv, qn_g, kn_g):
    B, S, _ = q.shape
    M = mem_n.shape[1]
    qh = rms_norm(q.reshape(B, S, MEM_HEADS, MEM_DH), qn_g)
    km, vm = jnp.split(mem_n @ w_mem_kv, 2, axis=-1)
    kh = rms_norm(km.reshape(B, M, MEM_HEADS, MEM_DH), kn_g)
    vh = vm.reshape(B, M, MEM_HEADS, MEM_DH)
    s = jnp.einsum('bshd,bmhd->bhsm', qh, kh).astype(jnp.float32) * (MEM_DH ** -0.5)
    p = jax.nn.softmax(s, axis=-1).astype(vh.dtype)
    o = jnp.einsum('bhsm,bmhd->bshd', p, vh)
    return o.reshape(B, S, MEM_HEADS * MEM_DH)


def setup_inputs(seed: int = 0) -> dict:
    key = jax.random.key(seed)
    ks = jax.random.split(key, 32)
    f32 = jnp.float32
    L = DEPTH
    d_in = sum(IN_SIZES)

    def nrm(k, shape, scale):
        return jax.random.normal(k, shape, f32) * scale

    def gain(k, shape):
        return 1.0 + 0.02 * jax.random.normal(k, shape, f32)

    return {
        "x": nrm(ks[0], (BATCH, SEQ, D_MODEL), 1.0),
        "mem": nrm(ks[1], (BATCH, N_MEM, D_MODEL), 1.0),
        "norm_mix_g": gain(ks[2], (L, D_MODEL)),
        "norm_mem_g": gain(ks[3], (L, D_MODEL)),
        "w_in": nrm(ks[4], (L, D_MODEL, d_in), D_MODEL ** -0.5),
        "gla_w_alpha_up": nrm(ks[5], (L, GLA_RANK, GLA_HEADS * GLA_DK), GLA_RANK ** -0.5),
        "gla_b_alpha": nrm(ks[6], (L, GLA_HEADS * GLA_DK), 0.1),
        "gla_norm_g": gain(ks[7], (L, GLA_DV)),
        "diff_q_norm_g": gain(ks[8], (L, DIFF_DH)),
        "diff_k_norm_g": gain(ks[9], (L, DIFF_DH)),
        "diff_lambda_q1": nrm(ks[10], (L, DIFF_DH), 0.1),
        "diff_lambda_k1": nrm(ks[11], (L, DIFF_DH), 0.1),
        "diff_lambda_q2": nrm(ks[12], (L, DIFF_DH), 0.1),
        "diff_lambda_k2": nrm(ks[13], (L, DIFF_DH), 0.1),
        "diff_subln_g": gain(ks[14], (L, DIFF_DV)),
        "mem_q_norm_g": gain(ks[15], (L, MEM_DH)),
        "mem_k_norm_g": gain(ks[16], (L, MEM_DH)),
        "w_mem_kv": nrm(ks[17], (L, D_MODEL, 2 * MEM_HEADS * MEM_DH), D_MODEL ** -0.5),
        "w_branch": nrm(ks[18], (L, N_BRANCH, BRANCH_WIDTH, D_MODEL), BRANCH_WIDTH ** -0.5),
        "w_gate": nrm(ks[19], (L, D_MODEL, N_BRANCH * D_MODEL), D_MODEL ** -0.5),
        "b_gate": nrm(ks[20], (L, N_BRANCH * D_MODEL), 0.02),
        "w_out": nrm(ks[21], (L, D_MODEL, D_MODEL), D_MODEL ** -0.5),
        "norm_ffn_g": gain(ks[22], (L, D_MODEL)),
        "w_ffn_in": nrm(ks[23], (L, D_MODEL, 2 * D_FF), D_MODEL ** -0.5),
        "w_ffn_down": nrm(ks[24], (L, D_FF, D_MODEL), D_FF ** -0.5),
    }


def reference(x, mem, norm_mix_g, norm_mem_g, w_in, gla_w_alpha_up, gla_b_alpha, gla_norm_g,
              diff_q_norm_g, diff_k_norm_g, diff_lambda_q1, diff_lambda_k1, diff_lambda_q2,
              diff_lambda_k2, diff_subln_g, mem_q_norm_g, mem_k_norm_g, w_mem_kv, w_branch,
              w_gate, b_gate, w_out, norm_ffn_g, w_ffn_in, w_ffn_down):
    B, S, D = x.shape
    for l in range(DEPTH):
        lam_init = 0.8 - 0.6 * math.exp(-0.3 * l)
        h = rms_norm(x, norm_mix_g[l])
        z = h @ w_in[l]
        (g_q, g_k, g_v, g_g, g_a, d_q, d_k, d_v, m_q) = split_cols(z, IN_SIZES)
        y_gla = gla_mixer(g_q, g_k, g_v, g_g, g_a, gla_w_alpha_up[l], gla_b_alpha[l], gla_norm_g[l])
        y_diff = diff_mixer(d_q, d_k, d_v, diff_q_norm_g[l], diff_k_norm_g[l],
                            diff_lambda_q1[l], diff_lambda_k1[l], diff_lambda_q2[l],
                            diff_lambda_k2[l], diff_subln_g[l], lam_init)
        y_mem = mem_cross_attention(m_q, rms_norm(mem, norm_mem_g[l]), w_mem_kv[l],
                                    mem_q_norm_g[l], mem_k_norm_g[l])
        y = jnp.stack([y_gla.astype(x.dtype), y_diff.astype(x.dtype), y_mem.astype(x.dtype)],
                      axis=2)
        proj = jnp.einsum('bsiw,iwd->bsid', y, w_branch[l])
        gates = jax.nn.sigmoid((h @ w_gate[l] + b_gate[l]).astype(jnp.float32))
        gates = gates.reshape(B, S, N_BRANCH, D).astype(proj.dtype)
        merged = jnp.sum(gates * proj, axis=2)
        x = x + (merged @ w_out[l]).astype(x.dtype)
        hf = rms_norm(x, norm_ffn_g[l])
        f_gate, f_up = jnp.split(hf @ w_ffn_in[l], 2, axis=-1)
        x = x + ((jax.nn.silu(f_gate) * f_up) @ w_ffn_down[l]).astype(x.dtype)
    return x
```

```cpp
#include <hip/hip_runtime.h>
#include <cstdio>
#include <cstdint>

#ifndef MK_N_LAUNCHES
#define MK_N_LAUNCHES 1
#endif

#define WGM_P1 3
#define WGM_P3 3
#define WGM_P4 3
#define WGM_P5 3
#define WGM_P6 3
#define LAS __attribute__((address_space(3)))
#define GAS __attribute__((address_space(1)))
typedef unsigned short bf16;
typedef short bf16x8 __attribute__((ext_vector_type(8)));
typedef short s16x4 __attribute__((ext_vector_type(4)));
typedef float f32x2 __attribute__((ext_vector_type(2)));
typedef float f32x4 __attribute__((ext_vector_type(4)));
typedef float f32x16 __attribute__((ext_vector_type(16)));
typedef unsigned u32x2 __attribute__((ext_vector_type(2)));
typedef unsigned u32x4 __attribute__((ext_vector_type(4)));
typedef __bf16 bf16x2_t __attribute__((ext_vector_type(2)));
typedef GAS unsigned gu32;

constexpr int BATCH = 2, SEQ = 4096, DM = 2048, TOK = BATCH * SEQ;
constexpr int NMEM = 256, MEMROWS = BATCH * NMEM;
constexpr int DFF = 5632;
constexpr int NZ = 7680;
constexpr int NGT = 6144;
constexpr int N1 = NZ + NGT;
constexpr int ZQ_GLA = 0, ZK_GLA = 512, ZV_GLA = 1024, ZG_GLA = 2048, ZQ_DIFF = 3072, ZK_DIFF = 4096, ZV_DIFF = 5120, ZQ_MEM = 6144, ZA_GLA = 7168;
constexpr int WIN_LD = 7184;
constexpr float NORM_EPS = 1e-6f;
constexpr float LAM_INIT = 0.2f;
constexpr float LOG2E = 1.4426950408889634f;

constexpr size_t MiB = 1u << 20;
constexpr size_t WS_CTL = 0, CTL_ZERO_BYTES = 32768;
constexpr size_t WS_RINVX = 1 * MiB;
constexpr size_t WS_RINVM = WS_RINVX + 32768;
constexpr size_t WS_SC = WS_RINVM + 4096;
constexpr size_t WS_SS8 = WS_SC + 4096;
constexpr size_t WS_DEC = WS_SS8 + 262144;
static_assert(WS_DEC + 262144 <= 2 * MiB, "small region");
constexpr size_t WS_WOT = 2 * MiB;
constexpr size_t WS_WBT = 10 * MiB;
constexpr size_t WS_KVM = 22 * MiB;
constexpr size_t WS_RA = 24 * MiB;
constexpr size_t WS_W1T = WS_RA;
constexpr size_t WS_WG8 = WS_RA + 30 * MiB;
constexpr size_t WS_XQ = WS_RA + 42 * MiB;
constexpr size_t WS_XB = WS_RA + 58 * MiB;
constexpr size_t WS_WKVT = WS_RA + 90 * MiB;
constexpr size_t WS_MEMB = WS_RA + 98 * MiB;
constexpr size_t WS_WFIT = WS_RA;
constexpr size_t WS_WFDT = WS_RA + 44 * MiB;
constexpr size_t WS_SB = WS_RA + 66 * MiB;
constexpr size_t WS_RZ = 128 * MiB;
constexpr size_t WS_Z = WS_RZ;
constexpr size_t WS_PART = WS_RZ;
constexpr size_t WS_MERGED = WS_RZ + 64 * MiB;
constexpr size_t WS_ACT = WS_RZ;
constexpr size_t WS_RG = 248 * MiB;
constexpr size_t WS_GATES = WS_RG;
constexpr size_t WS_X1B = WS_RG;
constexpr size_t WS_END = 344 * MiB;
constexpr int CW_TMO = 0, CW_BAR = 4096;

constexpr int RING_BYTES = 131072;
constexpr int LDS_BYTES = 163840;
constexpr int LDSCTL_OFF = LDS_BYTES - 1024, MISC_OFF = LDSCTL_OFF + 320;
constexpr int NWAVES = 8;

#define LDS_WAIT() asm volatile("s_waitcnt lgkmcnt(0)" ::: "memory")
#define VM_WAIT() asm volatile("s_waitcnt vmcnt(0)" ::: "memory")
#define RLX_AGENT __ATOMIC_RELAXED, __HIP_MEMORY_SCOPE_AGENT
__device__ __forceinline__ unsigned pk2(float lo, float hi) { f32x2 v = {lo, hi}; bf16x2_t b = __builtin_convertvector(v, bf16x2_t); return __builtin_bit_cast(unsigned, b); }
__device__ __forceinline__ float bflo(unsigned u) { return __uint_as_float(u << 16); }
__device__ __forceinline__ float bfhi(unsigned u) { return __uint_as_float(u & 0xffff0000u); }
__device__ __forceinline__ float bf1(bf16 v) { return __uint_as_float((unsigned)v << 16); }
__device__ __forceinline__ float fexp2(float x) { return __builtin_amdgcn_exp2f(x); }
__device__ __forceinline__ float fexp(float x) { return __builtin_amdgcn_exp2f(x * LOG2E); }
__device__ __forceinline__ float flog(float x) { return __builtin_amdgcn_logf(x) * 0.6931471805599453f; }
__device__ __forceinline__ float frcp(float x) { return __builtin_amdgcn_rcpf(x); }
__device__ __forceinline__ float frsq(float x) { return __builtin_amdgcn_rsqf(x); }
__device__ __forceinline__ float sigmoidf_(float x) { return frcp(1.0f + fexp(-x)); }
__device__ __forceinline__ float logsigmoidf_(float x) { return fminf(x, 0.f) - flog(1.0f + fexp(-fabsf(x))); }
__device__ __forceinline__ float wave_sum(float v) {
#pragma unroll
    for (int o = 1; o < 64; o <<= 1) v += __shfl_xor(v, o);
    return v;
}
__device__ __forceinline__ float wave_max(float v) {
#pragma unroll
    for (int o = 1; o < 64; o <<= 1) v = fmaxf(v, __shfl_xor(v, o));
    return v;
}
typedef short v4i16_t __attribute__((ext_vector_type(4)));
__device__ __forceinline__ s16x4 ldtr(LAS const unsigned char* p) { return __builtin_bit_cast(s16x4, __builtin_amdgcn_ds_read_tr16_b64_v4i16((LAS v4i16_t*)p)); }
__device__ __forceinline__ bf16x8 trfrag(LAS const unsigned char* p, int four_rows) {
    const s16x4 lo = ldtr(p), hi = ldtr(p + four_rows);
    return (bf16x8){lo[0], lo[1], lo[2], lo[3], hi[0], hi[1], hi[2], hi[3]};
}
__device__ __forceinline__ int crow(int r, int hi) { return (r & 3) + 8 * (r >> 2) + 4 * hi; }
#define MFMA32(a, b, c) __builtin_amdgcn_mfma_f32_32x32x16_bf16((a), (b), (c), 0, 0, 0)

namespace pg8 {
constexpr int BM = 256, BK = 64, HALF = 128, HTB = HALF * BK * 2, STAGE_BYTES = 8 * HTB, NXCD = 8, WGM = 8;
__host__ __device__ __forceinline__ int lds_byte(int r, int c) { const int st = (r >> 4) * 2 + (c >> 5), rr = r & 15, cc = c & 31, ob = rr * 64 + cc * 2; return st * 1024 + (ob ^ (((ob >> 9) & 1) << 5)); }
__host__ __device__ __forceinline__ void stage_rc(int b, int& R, int& C) { const int st = b / 1024, sb = b % 1024, swz = sb ^ (((sb >> 9) & 1) << 5); R = (st >> 1) * 16 + swz / 64; C = (st & 1) * 32 + (swz % 64) / 2; }
__host__ __device__ __forceinline__ int perm32(int rho) { const int n = rho >> 4, i = rho & 15; return 8 * (i >> 2) + 4 * n + (i & 3); }

struct Unit { int pm, pn, sub; };
struct TileMap {
    int nM, nN, nwg, wgm;
    __device__ __forceinline__ void init(int M, int N, int wgm_) { nM = M / BM; nN = N / BM; nwg = nM * nN; wgm = wgm_; }
    __device__ __forceinline__ void map(int L, int& pm, int& pn) const {
        int wgid = L; { const int q = nwg / NXCD, r = nwg % NXCD, xcd = wgid % NXCD, off = wgid / NXCD; wgid = (xcd < r ? xcd * (q + 1) : r * (q + 1) + (xcd - r) * q) + off; }
        const int nig = wgm * nN, gid = wgid / nig, fm = gid * wgm, gsz = (nM - fm) < wgm ? (nM - fm) : wgm;
        pm = fm + ((wgid % nig) % gsz); pn = (wgid % nig) / gsz;
    }
};
struct SchedPlain {
    TileMap tm; int G, c; const char* A; const char* B; size_t tstep;
    __device__ __forceinline__ bool next(int i, Unit& u) const { const long L = (long)i * G + c; if (L >= tm.nwg) return false; tm.map((int)L, u.pm, u.pn); u.sub = 0; return true; }
    __device__ __forceinline__ const char* aptr(const Unit& u) const { return A + (size_t)u.pm * tstep; }
    __device__ __forceinline__ const char* bptr(const Unit& u) const { return B + (size_t)u.pn * tstep; }
};
struct SchedP1 {
    TileMap tm; int G, c; const char* A; const char* B; const char* A2; const char* B2; size_t tstep;
    __device__ __forceinline__ bool next(int i, Unit& u) const {
        long L = (long)i * G + c; if (L < tm.nwg) { tm.map((int)L, u.pm, u.pn); u.sub = 0; return true; }
        L -= tm.nwg; if (L < 16) { u.pm = (int)(L & 1); u.pn = (int)(L >> 1); u.sub = 1; return true; } return false; }
    __device__ __forceinline__ const char* aptr(const Unit& u) const { return (u.sub ? A2 : A) + (size_t)u.pm * tstep; }
    __device__ __forceinline__ const char* bptr(const Unit& u) const { return (u.sub ? B2 : B) + (size_t)u.pn * tstep; }
};
struct SchedP3 {
    TileMap tm; int G, c; const char* A; const char* B; size_t tstep, astride, bstride;
    __device__ __forceinline__ bool next(int i, Unit& u) const { const int t = i / 3; const long L = (long)t * G + c; if (L >= tm.nwg) return false; tm.map((int)L, u.pm, u.pn); u.sub = i - 3 * t; return true; }
    __device__ __forceinline__ const char* aptr(const Unit& u) const { return A + (size_t)u.sub * astride + (size_t)u.pm * tstep; }
    __device__ __forceinline__ const char* bptr(const Unit& u) const { return B + (size_t)u.sub * bstride + (size_t)u.pn * tstep; }
};

typedef f32x4 Acc[2][2][4][2];

struct Epi1 {
    static constexpr bool PERM = true, AFTER_DRAIN = false;
    bf16* Z; bf16* GT; bf16* KVM; const float* rinvx; const float* rinvm; const float* b_alpha; const float* b_gate;
    __device__ __forceinline__ void operator()(const Acc& acc, const Unit& u, int wr, int wc, int fr, int fq) const {
        const int row0 = u.pm * BM + wr * 64 + fr; const int colt = u.pn * BM + wc * 32 + 8 * fq;
        int kind; bf16* base; int ld; const float* bias = nullptr; const float* rv = rinvx;
        if (u.sub) { kind = 0; base = KVM + colt; ld = 2048; rv = rinvm; }
        else if (u.pn < 28) { kind = 0; base = Z + colt; ld = NZ; }
        else if (u.pn < 30) { kind = 1; base = Z + colt; ld = NZ; bias = b_alpha + (colt - ZA_GLA); }
        else { kind = 2; base = GT + (colt - NZ); ld = NGT; bias = b_gate + (colt - NZ); }
        f32x4 bv[2][2];
#pragma unroll
        for (int bj = 0; bj < 2; ++bj)
#pragma unroll
            for (int n = 0; n < 2; ++n) bv[bj][n] = bias ? *(const f32x4*)(bias + bj * HALF + 4 * n) : (f32x4){0.f, 0.f, 0.f, 0.f};
        float rsv[2][4];
#pragma unroll
        for (int ai = 0; ai < 2; ++ai)
#pragma unroll
            for (int m = 0; m < 4; ++m) rsv[ai][m] = rv[row0 + ai * HALF + m * 16];
#pragma unroll
        for (int ai = 0; ai < 2; ++ai)
#pragma unroll
            for (int m = 0; m < 4; ++m) { const int row = row0 + ai * HALF + m * 16; const float rs = rsv[ai][m]; bf16* rowp = base + (size_t)row * ld;
#pragma unroll
                for (int bj = 0; bj < 2; ++bj) { f32x4 v0 = acc[ai][bj][m][0] * rs + bv[bj][0], v1 = acc[ai][bj][m][1] * rs + bv[bj][1];
                    if (kind == 1) {
#pragma unroll
                        for (int e = 0; e < 4; ++e) { v0[e] = logsigmoidf_(v0[e]) * 0.0625f; v1[e] = logsigmoidf_(v1[e]) * 0.0625f; } }
                    else if (kind == 2) {
#pragma unroll
                        for (int e = 0; e < 4; ++e) { v0[e] = sigmoidf_(v0[e]); v1[e] = sigmoidf_(v1[e]); } }
                    u32x4 w; w.x = pk2(v0[0], v0[1]); w.y = pk2(v0[2], v0[3]); w.z = pk2(v1[0], v1[1]); w.w = pk2(v1[2], v1[3]);
                    *(u32x4*)(rowp + bj * HALF) = w; } }
    }
};
struct EpiG {
    static constexpr bool PERM = true, AFTER_DRAIN = false;
    bf16* GT; const float* rinvx; const float* b_gate;
    __device__ __forceinline__ void operator()(const Acc& acc, const Unit& u, int wr, int wc, int fr, int fq) const {
        const int row0 = u.pm * BM + wr * 64 + fr; const int colt = u.pn * BM + wc * 32 + 8 * fq;
        f32x4 bv[2][2];
#pragma unroll
        for (int bj = 0; bj < 2; ++bj)
#pragma unroll
            for (int n = 0; n < 2; ++n) bv[bj][n] = *(const f32x4*)(b_gate + colt + bj * HALF + 4 * n);
        float rsv[2][4];
#pragma unroll
        for (int ai = 0; ai < 2; ++ai)
#pragma unroll
            for (int m = 0; m < 4; ++m) rsv[ai][m] = rinvx[row0 + ai * HALF + m * 16] * (1.0f / 512.0f);
#pragma unroll
        for (int ai = 0; ai < 2; ++ai)
#pragma unroll
            for (int m = 0; m < 4; ++m) { const int row = row0 + ai * HALF + m * 16; const float rs = rsv[ai][m]; bf16* rowp = GT + (size_t)row * NGT + colt;
#pragma unroll
                for (int bj = 0; bj < 2; ++bj) { f32x4 v0 = acc[ai][bj][m][0] * rs + bv[bj][0], v1 = acc[ai][bj][m][1] * rs + bv[bj][1];
#pragma unroll
                    for (int e = 0; e < 4; ++e) { v0[e] = sigmoidf_(v0[e]); v1[e] = sigmoidf_(v1[e]); }
                    u32x4 w; w.x = pk2(v0[0], v0[1]); w.y = pk2(v0[2], v0[3]); w.z = pk2(v1[0], v1[1]); w.w = pk2(v1[2], v1[3]);
                    *(u32x4*)(rowp + bj * HALF) = w; } }
    }
};
struct Epi3 {
    static constexpr bool PERM = true, AFTER_DRAIN = false;
    const bf16* GT; bf16* MERGED;
    __device__ __forceinline__ void operator()(const Acc& acc, const Unit& u, int wr, int wc, int fr, int fq) const {
        const int row0 = u.pm * BM + wr * 64 + fr; const int col0 = u.pn * BM + wc * 32 + 8 * fq;
#pragma unroll
        for (int ai = 0; ai < 2; ++ai) {
            u32x4 g[4][2], p[4][2];
#pragma unroll
            for (int m = 0; m < 4; ++m)
#pragma unroll
                for (int bj = 0; bj < 2; ++bj) { const int row = row0 + ai * HALF + m * 16, col = col0 + bj * HALF;
                    g[m][bj] = *(const u32x4*)(GT + (size_t)row * NGT + u.sub * DM + col);
                    if (u.sub > 0) p[m][bj] = *(const u32x4*)(MERGED + (size_t)row * DM + col); else p[m][bj] = (u32x4){0u, 0u, 0u, 0u}; }
#pragma unroll
            for (int m = 0; m < 4; ++m)
#pragma unroll
                for (int bj = 0; bj < 2; ++bj) { const int row = row0 + ai * HALF + m * 16, col = col0 + bj * HALF; const u32x4 gg = g[m][bj], pp = p[m][bj];
                    const f32x4 a0 = acc[ai][bj][m][0], a1 = acc[ai][bj][m][1];
                    u32x4 w;
                    w.x = pk2(a0[0] * bflo(gg.x) + bflo(pp.x), a0[1] * bfhi(gg.x) + bfhi(pp.x)); w.y = pk2(a0[2] * bflo(gg.y) + bflo(pp.y), a0[3] * bfhi(gg.y) + bfhi(pp.y));
                    w.z = pk2(a1[0] * bflo(gg.z) + bflo(pp.z), a1[1] * bfhi(gg.z) + bfhi(pp.z)); w.w = pk2(a1[2] * bflo(gg.w) + bflo(pp.w), a1[3] * bfhi(gg.w) + bfhi(pp.w));
                    *(u32x4*)(MERGED + (size_t)row * DM + col) = w; }
            asm volatile("" ::: "memory");
        }
    }
};
struct Epi4 {
    static constexpr bool PERM = true, AFTER_DRAIN = true;
    const float* X; bf16* X1B; float* SS8;
    __device__ __forceinline__ void fused(Acc& acc, const Unit& u, int wr, int wc, int fr, int fq, LAS unsigned char* lds, int wid, int lane) const {
        LAS float* P = (LAS float*)lds;
        const int row0 = u.pm * BM + wr * 64 + fr; const int col0 = u.pn * BM + wc * 32 + 8 * fq;
#pragma unroll
        for (int ai = 0; ai < 2; ++ai)
#pragma unroll
            for (int mp = 0; mp < 2; ++mp) {
                f32x4 x0[2][2], x1[2][2];
#pragma unroll
                for (int mm = 0; mm < 2; ++mm)
#pragma unroll
                    for (int bj = 0; bj < 2; ++bj) { const size_t off = (size_t)(row0 + ai * HALF + (2 * mp + mm) * 16) * DM + col0 + bj * HALF; x0[mm][bj] = *(const f32x4*)(X + off); x1[mm][bj] = *(const f32x4*)(X + off + 4); }
#pragma unroll
                for (int mm = 0; mm < 2; ++mm) { const int m = 2 * mp + mm; float s = 0.f;
#pragma unroll
                    for (int bj = 0; bj < 2; ++bj) { const size_t off = (size_t)(row0 + ai * HALF + m * 16) * DM + col0 + bj * HALF;
                        const f32x4 v0 = acc[ai][bj][m][0] + x0[mm][bj], v1 = acc[ai][bj][m][1] + x1[mm][bj];
                        u32x4 w; w.x = pk2(v0[0], v0[1]); w.y = pk2(v0[2], v0[3]); w.z = pk2(v1[0], v1[1]); w.w = pk2(v1[2], v1[3]); *(u32x4*)(X1B + off) = w;
                        s += (v0[0] * v0[0] + v0[1] * v0[1]) + (v0[2] * v0[2] + v0[3] * v0[3]) + (v1[0] * v1[0] + v1[1] * v1[1]) + (v1[2] * v1[2] + v1[3] * v1[3]); }
                    s += __shfl_xor(s, 16); s += __shfl_xor(s, 32);
                    if (fq == 0) P[(ai * HALF + wr * 64 + m * 16 + fr) * 4 + wc] = s; }
                asm volatile("" ::: "memory");
            }
        LDS_WAIT(); __builtin_amdgcn_s_barrier(); asm volatile("" ::: "memory");
        const int t = wid * 64 + lane;
        if (t < 256) { const float s = (P[t * 4 + 0] + P[t * 4 + 1]) + (P[t * 4 + 2] + P[t * 4 + 3]); SS8[(size_t)(u.pm * BM + t) * 8 + u.pn] = s; }
    }
};
struct Epi5 {
    static constexpr bool PERM = true, AFTER_DRAIN = false;
    const float* SS8; bf16* ACT;
    __device__ __forceinline__ void operator()(const Acc& acc, const Unit& u, int wr, int wc, int fr, int fq) const {
        const int row0 = u.pm * BM + wr * 64 + fr; const int col0 = u.pn * HALF + wc * 32 + 8 * fq;
        float rsv[2][4];
#pragma unroll
        for (int ai = 0; ai < 2; ++ai)
#pragma unroll
            for (int m = 0; m < 4; ++m) { const int row = row0 + ai * HALF + m * 16;
                const f32x4 s0 = *(const f32x4*)(SS8 + (size_t)row * 8), s1 = *(const f32x4*)(SS8 + (size_t)row * 8 + 4);
                const float ss = ((s0[0] + s0[1]) + (s0[2] + s0[3])) + ((s1[0] + s1[1]) + (s1[2] + s1[3]));
                rsv[ai][m] = frsq(ss * (1.0f / DM) + NORM_EPS); }
#pragma unroll
        for (int ai = 0; ai < 2; ++ai)
#pragma unroll
            for (int m = 0; m < 4; ++m) { const int row = row0 + ai * HALF + m * 16; const float rs = rsv[ai][m];
                float o[8];
#pragma unroll
                for (int n = 0; n < 2; ++n)
#pragma unroll
                    for (int e = 0; e < 4; ++e) { const float g = acc[ai][0][m][n][e] * rs, up = acc[ai][1][m][n][e] * rs; o[4 * n + e] = g * sigmoidf_(g) * up; }
                u32x4 w; w.x = pk2(o[0], o[1]); w.y = pk2(o[2], o[3]); w.z = pk2(o[4], o[5]); w.w = pk2(o[6], o[7]);
                *(u32x4*)(ACT + (size_t)row * DFF + col0) = w; }
    }
};
struct Epi6 {
    static constexpr bool PERM = true, AFTER_DRAIN = false;
    const bf16* X1B; float* OUT;
    __device__ __forceinline__ void operator()(const Acc& acc, const Unit& u, int wr, int wc, int fr, int fq) const {
        const int row0 = u.pm * BM + wr * 64 + fr; const int col0 = u.pn * BM + wc * 32 + 8 * fq;
#pragma unroll
        for (int ai = 0; ai < 2; ++ai) {
            u32x4 xr[4][2];
#pragma unroll
            for (int m = 0; m < 4; ++m)
#pragma unroll
                for (int bj = 0; bj < 2; ++bj) xr[m][bj] = *(const u32x4*)(X1B + (size_t)(row0 + ai * HALF + m * 16) * DM + col0 + bj * HALF);
#pragma unroll
            for (int m = 0; m < 4; ++m)
#pragma unroll
                for (int bj = 0; bj < 2; ++bj) { float* p = OUT + (size_t)(row0 + ai * HALF + m * 16) * DM + col0 + bj * HALF; const u32x4 x = xr[m][bj];
                    *(f32x4*)p = (f32x4){bflo(x.x), bfhi(x.x), bflo(x.y), bfhi(x.y)} + acc[ai][bj][m][0]; *(f32x4*)(p + 4) = (f32x4){bflo(x.z), bfhi(x.z), bflo(x.w), bfhi(x.w)} + acc[ai][bj][m][1]; }
            asm volatile("" ::: "memory");
        }
    }
};

template <class Epi, class Sched, bool ALIGN_EPI, bool SP2>
__device__ __forceinline__ void gemm_phase(LAS unsigned char* lds, const int K, const Sched& S, const Epi& E) {
    const int tid = threadIdx.x, wid = __builtin_amdgcn_readfirstlane(tid >> 6), lane = tid & 63, wr = wid >> 2, wc = wid & 3, fr = lane & 15, fq = lane >> 4;
    const int nt = K / BK;
    unsigned voffA[2], voffB[2];
#pragma unroll
    for (int i = 0; i < 2; ++i) { int R, C; stage_rc(tid * 16 + i * 8192, R, C); const int Rb = Epi::PERM ? ((R & ~31) + perm32(R & 31)) : R;
        voffA[i] = (unsigned)(R * K + C) * 2u; voffB[i] = (unsigned)(Rb * K + C) * 2u; }
    const size_t kstep = (size_t)(BK * 2);
    const size_t hstep = (size_t)HALF * K * 2;
    const unsigned ldsw = (unsigned)wid * 1024u;
    const int aoff = lds_byte(wr * 64 + fr, fq * 8), boff = lds_byte(wc * 32 + fr, fq * 8);
#define PG8_SA(b, h) (((b) * 2 + (h)) * HTB)
#define PG8_SB(b, h) ((4 + (b) * 2 + (h)) * HTB)
#define PG8_STAGE(bufoff, gbase, voff) do { _Pragma("unroll") for (int _i = 0; _i < 2; ++_i) \
        __builtin_amdgcn_global_load_lds((const unsigned*)((const char*)(gbase) + (voff)[_i]), (LAS unsigned*)(lds + (bufoff) + ldsw + _i * 8192), 16, 0, 0); } while (0)
#define PG8_LDA(dst, b, h) do { _Pragma("unroll") for (int m = 0; m < 4; ++m) _Pragma("unroll") for (int k = 0; k < 2; ++k) dst[m][k] = *(const LAS bf16x8*)(lds + PG8_SA(b, h) + aoff + m * 2048 + k * 1024); } while (0)
#define PG8_LDB(dst, b, h) do { _Pragma("unroll") for (int n = 0; n < 2; ++n) _Pragma("unroll") for (int k = 0; k < 2; ++k) dst[n][k] = *(const LAS bf16x8*)(lds + PG8_SB(b, h) + boff + n * 2048 + k * 1024); } while (0)
#define PG8_MMA(ai, bj, At, Bt) do { __builtin_amdgcn_s_setprio(1); _Pragma("unroll") for (int m = 0; m < 4; ++m) _Pragma("unroll") for (int n = 0; n < 2; ++n) _Pragma("unroll") for (int k = 0; k < 2; ++k) \
        acc[ai][bj][m][n] = __builtin_amdgcn_mfma_f32_16x16x32_bf16(Bt[n][k], At[m][k], acc[ai][bj][m][n], 0, 0, 0); __builtin_amdgcn_s_setprio(0); } while (0)
#define PG8_WAIT_V(n) asm volatile("s_waitcnt vmcnt(" #n ")" ::: "memory")
#define PG8_WAIT_L(n) asm volatile("s_waitcnt lgkmcnt(" #n ")" ::: "memory")
#define PG8_BAR __builtin_amdgcn_s_barrier()
#define PG8_SCHED __builtin_amdgcn_sched_barrier(0)
    Unit cur, nxt; int ui = 0;
    if (!S.next(0, cur)) return;
    Acc acc;
#pragma unroll
    for (int a = 0; a < 2; ++a)
#pragma unroll
        for (int b = 0; b < 2; ++b)
#pragma unroll
            for (int m = 0; m < 4; ++m)
#pragma unroll
                for (int n = 0; n < 2; ++n) acc[a][b][m][n] = (f32x4){0.f, 0.f, 0.f, 0.f};
    bf16x8 At[4][2], B0[2][2], B1[2][2];
    const char* cA = S.aptr(cur); const char* cB = S.bptr(cur);
    if constexpr (SP2) {
        PG8_STAGE(PG8_SB(0, 0), cB, voffB); PG8_STAGE(PG8_SB(0, 1), cB + hstep, voffB); PG8_STAGE(PG8_SA(0, 0), cA, voffA); PG8_STAGE(PG8_SA(0, 1), cA + hstep, voffA);
        if (wr == 1) PG8_BAR;
        PG8_WAIT_V(2); PG8_BAR;
        PG8_STAGE(PG8_SB(1, 0), cB + kstep, voffB); PG8_STAGE(PG8_SA(1, 0), cA + kstep, voffA); PG8_STAGE(PG8_SB(1, 1), cB + hstep + kstep, voffB);
        PG8_WAIT_V(6); PG8_BAR;
    } else {
        PG8_STAGE(PG8_SB(0, 0), cB, voffB); PG8_STAGE(PG8_SA(0, 0), cA, voffA); PG8_STAGE(PG8_SB(0, 1), cB + hstep, voffB); PG8_STAGE(PG8_SA(0, 1), cA + hstep, voffA);
        if (wr == 1) PG8_BAR;
        PG8_WAIT_V(4); PG8_BAR;
        PG8_STAGE(PG8_SB(1, 0), cB + kstep, voffB); PG8_STAGE(PG8_SA(1, 0), cA + kstep, voffA); PG8_STAGE(PG8_SB(1, 1), cB + hstep + kstep, voffB);
        PG8_WAIT_V(6); PG8_BAR;
    }
    for (;;) {
        const bool has_next = S.next(ui + 1, nxt);
        const char* nA = has_next ? S.aptr(nxt) : cA; const char* nB = has_next ? S.bptr(nxt) : cB;
        for (int t = 0; t < nt; t += 2) {
            const bool last = (t == nt - 2);
            const char* a1 = cA + (size_t)(t + 1) * kstep;
            const char* a2 = last ? nA : cA + (size_t)(t + 2) * kstep; const char* b2 = last ? nB : cB + (size_t)(t + 2) * kstep;
            const char* a3 = a2 + kstep; const char* b3 = b2 + kstep;
            if constexpr (SP2) {
            PG8_LDB(B0, 0, 0); PG8_LDB(B1, 0, 1); PG8_SCHED; PG8_LDA(At, 0, 0); PG8_STAGE(PG8_SA(1, 1), a1 + hstep, voffA);
            PG8_WAIT_V(8); PG8_WAIT_L(0); PG8_BAR; PG8_MMA(0, 0, At, B0); PG8_MMA(0, 1, At, B1); PG8_BAR; PG8_SCHED;
            PG8_LDA(At, 0, 1); PG8_STAGE(PG8_SB(0, 0), b2, voffB); PG8_STAGE(PG8_SB(0, 1), b2 + hstep, voffB); PG8_STAGE(PG8_SA(0, 0), a2, voffA);
            PG8_WAIT_V(8); PG8_WAIT_L(0); PG8_BAR; PG8_MMA(1, 0, At, B0); PG8_MMA(1, 1, At, B1); PG8_BAR; PG8_SCHED;
            PG8_LDB(B0, 1, 0); PG8_LDB(B1, 1, 1); PG8_SCHED; PG8_LDA(At, 1, 0); PG8_STAGE(PG8_SA(0, 1), a2 + hstep, voffA);
            PG8_WAIT_V(8); PG8_WAIT_L(0); PG8_BAR; PG8_MMA(0, 0, At, B0); PG8_MMA(0, 1, At, B1); PG8_BAR; PG8_SCHED;
            PG8_LDA(At, 1, 1); PG8_STAGE(PG8_SB(1, 0), b3, voffB); PG8_STAGE(PG8_SB(1, 1), b3 + hstep, voffB); PG8_STAGE(PG8_SA(1, 0), a3, voffA);
            PG8_WAIT_V(8); PG8_WAIT_L(0); PG8_BAR; PG8_MMA(1, 0, At, B0); PG8_MMA(1, 1, At, B1); PG8_BAR; PG8_SCHED;
            } else {
            PG8_LDB(B0, 0, 0); PG8_SCHED; PG8_LDA(At, 0, 0); PG8_STAGE(PG8_SA(1, 1), a1 + hstep, voffA);
            PG8_WAIT_L(8); PG8_BAR; PG8_WAIT_L(0); PG8_MMA(0, 0, At, B0); PG8_BAR; PG8_SCHED;
            PG8_LDB(B1, 0, 1); PG8_STAGE(PG8_SB(0, 0), b2, voffB);
            PG8_BAR; PG8_WAIT_L(0); PG8_MMA(0, 1, At, B1); PG8_BAR;
            PG8_LDA(At, 0, 1); PG8_STAGE(PG8_SA(0, 0), a2, voffA);
            PG8_BAR; PG8_WAIT_L(0); PG8_MMA(1, 0, At, B0); PG8_BAR; PG8_SCHED;
            PG8_STAGE(PG8_SB(0, 1), b2 + hstep, voffB);
            PG8_WAIT_V(6); PG8_BAR; PG8_MMA(1, 1, At, B1); PG8_BAR;
            PG8_LDB(B0, 1, 0); PG8_SCHED; PG8_LDA(At, 1, 0); PG8_STAGE(PG8_SA(0, 1), a2 + hstep, voffA);
            PG8_WAIT_L(8); PG8_BAR; PG8_WAIT_L(0); PG8_MMA(0, 0, At, B0); PG8_BAR; PG8_SCHED;
            PG8_LDB(B1, 1, 1); PG8_STAGE(PG8_SB(1, 0), b3, voffB);
            PG8_BAR; PG8_WAIT_L(0); PG8_MMA(0, 1, At, B1); PG8_BAR;
            PG8_LDA(At, 1, 1); PG8_STAGE(PG8_SA(1, 0), a3, voffA);
            PG8_BAR; PG8_WAIT_L(0); PG8_MMA(1, 0, At, B0); PG8_BAR; PG8_SCHED;
            PG8_STAGE(PG8_SB(1, 1), b3 + hstep, voffB);
            PG8_WAIT_V(6); PG8_BAR; PG8_MMA(1, 1, At, B1); PG8_BAR;
            }
        }
        if constexpr (ALIGN_EPI) { if (wr == 0) PG8_BAR; }
        if constexpr (!Epi::AFTER_DRAIN) { E(acc, cur, wr, wc, fr, fq); }
        if (!has_next) break;
#pragma unroll
        for (int a = 0; a < 2; ++a)
#pragma unroll
            for (int b = 0; b < 2; ++b)
#pragma unroll
                for (int m = 0; m < 4; ++m)
#pragma unroll
                    for (int n = 0; n < 2; ++n) acc[a][b][m][n] = (f32x4){0.f, 0.f, 0.f, 0.f};
        cur = nxt; cA = nA; cB = nB; ++ui;
        if constexpr (ALIGN_EPI) { if (wr == 1) PG8_BAR; }
    }
    PG8_WAIT_V(0);
    if constexpr (!ALIGN_EPI) { if (wr == 0) PG8_BAR; }
    PG8_BAR;
    if constexpr (Epi::AFTER_DRAIN) { E.fused(acc, cur, wr, wc, fr, fq, lds, wid, lane); }
#undef PG8_SA
#undef PG8_SB
#undef PG8_STAGE
#undef PG8_LDA
#undef PG8_LDB
#undef PG8_MMA
#undef PG8_WAIT_V
#undef PG8_WAIT_L
#undef PG8_BAR
#undef PG8_SCHED
}
typedef int v8i_t __attribute__((ext_vector_type(8)));
typedef int v4i_t __attribute__((ext_vector_type(4)));
template <class Epi, class Sched, bool ALIGN_EPI, bool SP2>
__device__ __forceinline__ void gemm_phase8(LAS unsigned char* lds, const int K, const Sched& S, const Epi& E) {
    const int tid = threadIdx.x, wid = __builtin_amdgcn_readfirstlane(tid >> 6), lane = tid & 63, wr = wid >> 2, wc = wid & 3, fr = lane & 15, fq = lane >> 4;
    const int nt = K / BK;
    unsigned voffA[2], voffB[2];
#pragma unroll
    for (int i = 0; i < 2; ++i) { int R, C; stage_rc(tid * 16 + i * 8192, R, C); const int Rb = Epi::PERM ? ((R & ~31) + perm32(R & 31)) : R;
        voffA[i] = (unsigned)(R * K + C) * 2u; voffB[i] = (unsigned)(Rb * K + C) * 2u; }
    const size_t kstep = (size_t)(BK * 2);
    const size_t hstep = (size_t)HALF * K * 2;
    const unsigned ldsw = (unsigned)wid * 1024u;
    const int aoff = lds_byte(wr * 64 + fr, fq * 16), boff = lds_byte(wc * 32 + fr, fq * 16);
#define PG8_SA(b, h) (((b) * 2 + (h)) * HTB)
#define PG8_SB(b, h) ((4 + (b) * 2 + (h)) * HTB)
#define PG8_STAGE(bufoff, gbase, voff) do { _Pragma("unroll") for (int _i = 0; _i < 2; ++_i) \
        __builtin_amdgcn_global_load_lds((const unsigned*)((const char*)(gbase) + (voff)[_i]), (LAS unsigned*)(lds + (bufoff) + ldsw + _i * 8192), 16, 0, 0); } while (0)
#define PG8_LD32(p) __builtin_shufflevector(*(const LAS v4i_t*)(p), *(const LAS v4i_t*)((p) + 16), 0, 1, 2, 3, 4, 5, 6, 7)
#define PG8_LDA(dst, b, h) do { _Pragma("unroll") for (int m = 0; m < 4; ++m) dst[m] = PG8_LD32(lds + PG8_SA(b, h) + aoff + m * 2048); } while (0)
#define PG8_LDB(dst, b, h) do { _Pragma("unroll") for (int n = 0; n < 2; ++n) dst[n] = PG8_LD32(lds + PG8_SB(b, h) + boff + n * 2048); } while (0)
#define PG8_MMA(ai, bj, At, Bt) do { __builtin_amdgcn_s_setprio(1); _Pragma("unroll") for (int m = 0; m < 4; ++m) _Pragma("unroll") for (int n = 0; n < 2; ++n) \
        asm volatile("v_mfma_scale_f32_16x16x128_f8f6f4 %0, %1, %2, %0, %3, %3 op_sel_hi:[0,0,0]" : "+v"(acc[ai][bj][m][n]) : "v"(Bt[n]), "v"(At[m]), "v"(mxscale)); __builtin_amdgcn_s_setprio(0); } while (0)
#define PG8_WAIT_V(n) asm volatile("s_waitcnt vmcnt(" #n ")" ::: "memory")
#define PG8_WAIT_L(n) asm volatile("s_waitcnt lgkmcnt(" #n ")" ::: "memory")
#define PG8_BAR __builtin_amdgcn_s_barrier()
#define PG8_SCHED __builtin_amdgcn_sched_barrier(0)
    Unit cur, nxt; int ui = 0;
    if (!S.next(0, cur)) return;
    Acc acc;
#pragma unroll
    for (int a = 0; a < 2; ++a)
#pragma unroll
        for (int b = 0; b < 2; ++b)
#pragma unroll
            for (int m = 0; m < 4; ++m)
#pragma unroll
                for (int n = 0; n < 2; ++n) acc[a][b][m][n] = (f32x4){0.f, 0.f, 0.f, 0.f};
    v8i_t At[4], B0[2], B1[2]; int mxscale = 0x7f7f7f7f; asm volatile("" : "+v"(mxscale));
    const char* cA = S.aptr(cur); const char* cB = S.bptr(cur);
    if constexpr (SP2) {
        PG8_STAGE(PG8_SB(0, 0), cB, voffB); PG8_STAGE(PG8_SB(0, 1), cB + hstep, voffB); PG8_STAGE(PG8_SA(0, 0), cA, voffA); PG8_STAGE(PG8_SA(0, 1), cA + hstep, voffA);
        if (wr == 1) PG8_BAR;
        PG8_WAIT_V(2); PG8_BAR;
        PG8_STAGE(PG8_SB(1, 0), cB + kstep, voffB); PG8_STAGE(PG8_SA(1, 0), cA + kstep, voffA); PG8_STAGE(PG8_SB(1, 1), cB + hstep + kstep, voffB);
        PG8_WAIT_V(6); PG8_BAR;
    } else {
        PG8_STAGE(PG8_SB(0, 0), cB, voffB); PG8_STAGE(PG8_SA(0, 0), cA, voffA); PG8_STAGE(PG8_SB(0, 1), cB + hstep, voffB); PG8_STAGE(PG8_SA(0, 1), cA + hstep, voffA);
        if (wr == 1) PG8_BAR;
        PG8_WAIT_V(4); PG8_BAR;
        PG8_STAGE(PG8_SB(1, 0), cB + kstep, voffB); PG8_STAGE(PG8_SA(1, 0), cA + kstep, voffA); PG8_STAGE(PG8_SB(1, 1), cB + hstep + kstep, voffB);
        PG8_WAIT_V(6); PG8_BAR;
    }
    for (;;) {
        const bool has_next = S.next(ui + 1, nxt);
        const char* nA = has_next ? S.aptr(nxt) : cA; const char* nB = has_next ? S.bptr(nxt) : cB;
        for (int t = 0; t < nt; t += 2) {
            const bool last = (t == nt - 2);
            const char* a1 = cA + (size_t)(t + 1) * kstep;
            const char* a2 = last ? nA : cA + (size_t)(t + 2) * kstep; const char* b2 = last ? nB : cB + (size_t)(t + 2) * kstep;
            const char* a3 = a2 + kstep; const char* b3 = b2 + kstep;
            if constexpr (SP2) {
            PG8_LDB(B0, 0, 0); PG8_LDB(B1, 0, 1); PG8_SCHED; PG8_LDA(At, 0, 0); PG8_STAGE(PG8_SA(1, 1), a1 + hstep, voffA);
            PG8_WAIT_V(8); PG8_WAIT_L(0); PG8_BAR; PG8_MMA(0, 0, At, B0); PG8_MMA(0, 1, At, B1); PG8_BAR; PG8_SCHED;
            PG8_LDA(At, 0, 1); PG8_STAGE(PG8_SB(0, 0), b2, voffB); PG8_STAGE(PG8_SB(0, 1), b2 + hstep, voffB); PG8_STAGE(PG8_SA(0, 0), a2, voffA);
            PG8_WAIT_V(8); PG8_WAIT_L(0); PG8_BAR; PG8_MMA(1, 0, At, B0); PG8_MMA(1, 1, At, B1); PG8_BAR; PG8_SCHED;
            PG8_LDB(B0, 1, 0); PG8_LDB(B1, 1, 1); PG8_SCHED; PG8_LDA(At, 1, 0); PG8_STAGE(PG8_SA(0, 1), a2 + hstep, voffA);
            PG8_WAIT_V(8); PG8_WAIT_L(0); PG8_BAR; PG8_MMA(0, 0, At, B0); PG8_MMA(0, 1, At, B1); PG8_BAR; PG8_SCHED;
            PG8_LDA(At, 1, 1); PG8_STAGE(PG8_SB(1, 0), b3, voffB); PG8_STAGE(PG8_SB(1, 1), b3 + hstep, voffB); PG8_STAGE(PG8_SA(1, 0), a3, voffA);
            PG8_WAIT_V(8); PG8_WAIT_L(0); PG8_BAR; PG8_MMA(1, 0, At, B0); PG8_MMA(1, 1, At, B1); PG8_BAR; PG8_SCHED;
            } else {
            PG8_LDB(B0, 0, 0); PG8_SCHED; PG8_LDA(At, 0, 0); PG8_STAGE(PG8_SA(1, 1), a1 + hstep, voffA);
            PG8_WAIT_L(8); PG8_BAR; PG8_WAIT_L(0); PG8_MMA(0, 0, At, B0); PG8_BAR; PG8_SCHED;
            PG8_LDB(B1, 0, 1); PG8_STAGE(PG8_SB(0, 0), b2, voffB);
            PG8_BAR; PG8_WAIT_L(0); PG8_MMA(0, 1, At, B1); PG8_BAR;
            PG8_LDA(At, 0, 1); PG8_STAGE(PG8_SA(0, 0), a2, voffA);
            PG8_BAR; PG8_WAIT_L(0); PG8_MMA(1, 0, At, B0); PG8_BAR; PG8_SCHED;
            PG8_STAGE(PG8_SB(0, 1), b2 + hstep, voffB);
            PG8_WAIT_V(6); PG8_BAR; PG8_MMA(1, 1, At, B1); PG8_BAR;
            PG8_LDB(B0, 1, 0); PG8_SCHED; PG8_LDA(At, 1, 0); PG8_STAGE(PG8_SA(0, 1), a2 + hstep, voffA);
            PG8_WAIT_L(8); PG8_BAR; PG8_WAIT_L(0); PG8_MMA(0, 0, At, B0); PG8_BAR; PG8_SCHED;
            PG8_LDB(B1, 1, 1); PG8_STAGE(PG8_SB(1, 0), b3, voffB);
            PG8_BAR; PG8_WAIT_L(0); PG8_MMA(0, 1, At, B1); PG8_BAR;
            PG8_LDA(At, 1, 1); PG8_STAGE(PG8_SA(1, 0), a3, voffA);
            PG8_BAR; PG8_WAIT_L(0); PG8_MMA(1, 0, At, B0); PG8_BAR; PG8_SCHED;
            PG8_STAGE(PG8_SB(1, 1), b3 + hstep, voffB);
            PG8_WAIT_V(6); PG8_BAR; PG8_MMA(1, 1, At, B1); PG8_BAR;
            }
        }
        if constexpr (ALIGN_EPI) { if (wr == 0) PG8_BAR; }
        asm volatile("s_nop 15\n\ts_nop 7" ::: "memory");
        if constexpr (!Epi::AFTER_DRAIN) { E(acc, cur, wr, wc, fr, fq); }
        if (!has_next) break;
#pragma unroll
        for (int a = 0; a < 2; ++a)
#pragma unroll
            for (int b = 0; b < 2; ++b)
#pragma unroll
                for (int m = 0; m < 4; ++m)
#pragma unroll
                    for (int n = 0; n < 2; ++n) acc[a][b][m][n] = (f32x4){0.f, 0.f, 0.f, 0.f};
        cur = nxt; cA = nA; cB = nB; ++ui;
        if constexpr (ALIGN_EPI) { if (wr == 1) PG8_BAR; }
    }
    PG8_WAIT_V(0);
    if constexpr (!ALIGN_EPI) { if (wr == 0) PG8_BAR; }
    PG8_BAR;
    if constexpr (Epi::AFTER_DRAIN) { E.fused(acc, cur, wr, wc, fr, fq, lds, wid, lane); }
#undef PG8_SA
#undef PG8_SB
#undef PG8_STAGE
#undef PG8_LDA
#undef PG8_LDB
#undef PG8_MMA
#undef PG8_LD32
#undef PG8_WAIT_V
#undef PG8_WAIT_L
#undef PG8_BAR
#undef PG8_SCHED
}
}

#define XB_TMO      128
#define XB_XCNT(j)  (256  + 64 * (j))
#define XB_XSUB(j)  (1280 + 64 * (j))
#define XB_XGEN(j)  (2304 + 64 * (j))
#define XB_TOP      3328
#define XB_TOPGEN   3392
#define XCD_BAR_WORDS 3456
#define XB_SPIN_CAP (1u << 20)
__device__ __forceinline__ unsigned xb_ld(unsigned* p)              { return __hip_atomic_load(p, __ATOMIC_RELAXED, __HIP_MEMORY_SCOPE_AGENT); }
__device__ __forceinline__ unsigned xb_add(unsigned* p, unsigned v) { return __hip_atomic_fetch_add(p, v, __ATOMIC_RELAXED, __HIP_MEMORY_SCOPE_AGENT); }
__device__ __forceinline__ unsigned xb_xcc_id() { return (unsigned)__builtin_amdgcn_s_getreg((3 << 11) | 20) & 0xFu; }
#define XB_SPIN(cond, bar) do { unsigned _sp = 0; while (cond) { __builtin_amdgcn_s_sleep(1); \
    if ((++_sp & 255u) == 0u) { if (xb_ld(&(bar)[XB_TMO])) break; if (_sp > XB_SPIN_CAP) { atomicAdd(&(bar)[XB_TMO], 1u); break; } } } } while (0)
struct XcdBarrier { unsigned* bar; unsigned x; volatile LAS unsigned* st; };
__device__ __forceinline__ XcdBarrier xcd_barrier_post(unsigned* bar, volatile LAS unsigned* st) {
    XcdBarrier b; b.bar = bar; b.x = xb_xcc_id(); b.st = st;
    if (threadIdx.x == 0) (void)xb_add(&bar[XB_XCNT(b.x)], 1u);
    return b;
}
__device__ __forceinline__ void xcd_barrier_complete(unsigned* bar, unsigned x, unsigned& nloc, unsigned& nx) {
    const unsigned G = gridDim.x * gridDim.y * gridDim.z;
    unsigned sum, cnt, mine, sp = 0u;
    for (;;) {
        sum = 0u; cnt = 0u; mine = 0u;
#pragma unroll
        for (unsigned j = 0; j < 16; ++j) { const unsigned c = xb_ld(&bar[XB_XCNT(j)]); sum += c; cnt += (c > 0u) ? 1u : 0u; mine = (j == x) ? c : mine; }
        if (sum == G) break;
        __builtin_amdgcn_s_sleep(1);
        if ((++sp & 255u) == 0u) { if (xb_ld(&bar[XB_TMO])) break; if (sp > XB_SPIN_CAP) { atomicAdd(&bar[XB_TMO], 1u); break; } }
    }
    nloc = mine > 0u ? mine : 1u; nx = cnt > 0u ? cnt : 1u;
}
__device__ __forceinline__ void xcd_barrier(const XcdBarrier& b) {
    asm volatile("s_waitcnt vmcnt(0)" ::: "memory");
    __syncthreads();
    if (threadIdx.x == 0) {
        unsigned* bar = b.bar;
        __builtin_amdgcn_s_waitcnt(0);
        unsigned nloc = b.st[0], nx = b.st[1];
        if (nloc == 0u) { xcd_barrier_complete(bar, b.x, nloc, nx); b.st[0] = nloc; b.st[1] = nx; }
        const unsigned old = xb_add(&bar[XB_XSUB(b.x)], 1u);
        const unsigned gen = old / nloc;
        if (old + 1u == (gen + 1u) * nloc) {
            __builtin_amdgcn_fence(__ATOMIC_RELEASE, "agent");
            asm volatile("s_waitcnt vmcnt(0)" ::: "memory");
            const unsigned og = xb_add(&bar[XB_TOP], 1u);
            const unsigned tg = og / nx;
            if (og + 1u == (tg + 1u) * nx) xb_add(&bar[XB_TOPGEN], 1u);
            else XB_SPIN(xb_ld(&bar[XB_TOPGEN]) == tg, bar);
            __builtin_amdgcn_fence(__ATOMIC_ACQUIRE, "agent");
            xb_add(&bar[XB_XGEN(b.x)], 1u);
            asm volatile("s_waitcnt vmcnt(0)" ::: "memory");
        } else {
            XB_SPIN(xb_ld(&bar[XB_XGEN(b.x)]) == gen, bar);
            __builtin_amdgcn_fence(__ATOMIC_ACQUIRE, "agent");
            asm volatile("s_waitcnt vmcnt(0)" ::: "memory");
        }
    }
    __syncthreads();
}

struct Frame {
    LAS unsigned char* lds;
    int tid, lane, wave, vcu, G;
    const float* in[25]; float* out; unsigned char* ws;
};
#define WSP(T, off) ((T*)(F.ws + (off)))

struct TrItem { const float* src; const float* gain; bf16* dst; int ldw, K, f8; };
__device__ __forceinline__ unsigned pk4_fp8(float a, float b, float c, float d) { int p = 0; p = __builtin_amdgcn_cvt_pk_fp8_f32(a, b, p, false); p = __builtin_amdgcn_cvt_pk_fp8_f32(c, d, p, true); return (unsigned)p; }
__device__ __forceinline__ void tr_load(f32x4 (&v)[8], const TrItem& t, int lane) {
    const float* p = t.src + (size_t)(8 * (lane & 7)) * t.ldw + 4 * (lane >> 3);
#pragma unroll
    for (int j = 0; j < 8; ++j) v[j] = __builtin_nontemporal_load((const f32x4*)(p + (size_t)j * t.ldw));
}
__device__ __forceinline__ void tr_store(const f32x4 (&v)[8], const TrItem& t, int lane) {
    float g[8];
    if (t.gain) { const f32x4 g0 = *(const f32x4*)(t.gain + 8 * (lane & 7)), g1 = *(const f32x4*)(t.gain + 8 * (lane & 7) + 4);
        g[0] = g0[0]; g[1] = g0[1]; g[2] = g0[2]; g[3] = g0[3]; g[4] = g1[0]; g[5] = g1[1]; g[6] = g1[2]; g[7] = g1[3]; }
    else {
#pragma unroll
        for (int j = 0; j < 8; ++j) g[j] = 1.0f; }
    if (t.f8) {
        unsigned char* d8 = (unsigned char*)t.dst + (size_t)(4 * (lane >> 3)) * t.K + 8 * (lane & 7);
#pragma unroll
        for (int i = 0; i < 4; ++i) { u32x2 o; o.x = pk4_fp8(v[0][i] * g[0] * 64.f, v[1][i] * g[1] * 64.f, v[2][i] * g[2] * 64.f, v[3][i] * g[3] * 64.f);
            o.y = pk4_fp8(v[4][i] * g[4] * 64.f, v[5][i] * g[5] * 64.f, v[6][i] * g[6] * 64.f, v[7][i] * g[7] * 64.f);
            *(GAS u32x2*)(d8 + (size_t)i * t.K) = o; }
        return; }
    bf16* d = t.dst + (size_t)(4 * (lane >> 3)) * t.K + 8 * (lane & 7);
#pragma unroll
    for (int i = 0; i < 4; ++i) { u32x4 o; o.x = pk2(v[0][i] * g[0], v[1][i] * g[1]); o.y = pk2(v[2][i] * g[2], v[3][i] * g[3]); o.z = pk2(v[4][i] * g[4], v[5][i] * g[5]); o.w = pk2(v[6][i] * g[6], v[7][i] * g[7]);
        *(GAS u32x4*)(d + (size_t)i * t.K) = o; }
}
__device__ __forceinline__ void tr_alpha(const float* win, const float* wup, const float* gain, bf16* dst, int k0, int n0, int lane) {
    const int lk = lane & 7, ln = lane >> 3;
    f32x4 wu[16];
#pragma unroll
    for (int r = 0; r < 16; ++r) wu[r] = *(const f32x4*)(wup + r * 512 + n0 + 4 * ln);
    f32x4 v[8];
#pragma unroll
    for (int j = 0; j < 8; ++j) { const float* a = win + (size_t)(k0 + 8 * lk + j) * WIN_LD + 3072; f32x4 acc = {0.f, 0.f, 0.f, 0.f};
#pragma unroll
        for (int r4 = 0; r4 < 4; ++r4) { const f32x4 av = *(const f32x4*)(a + 4 * r4); acc += wu[4 * r4] * av[0] + wu[4 * r4 + 1] * av[1] + wu[4 * r4 + 2] * av[2] + wu[4 * r4 + 3] * av[3]; }
        v[j] = acc; }
    TrItem t; t.f8 = 0; t.src = nullptr; t.gain = gain + k0; t.dst = dst + (size_t)n0 * DM + k0; t.ldw = 0; t.K = DM;
    tr_store(v, t, lane);
}
__device__ __forceinline__ void row_to_bf16(const float* xrow, bf16* orow, float* rinv, int lane, unsigned* qrow = nullptr) {
    const GAS f32x4* xr = (const GAS f32x4*)xrow + lane;
    f32x4 v[8]; float s = 0.f;
#pragma unroll
    for (int j = 0; j < 8; ++j) { v[j] = __builtin_nontemporal_load(xr + 64 * j); s += (v[j].x * v[j].x + v[j].y * v[j].y) + (v[j].z * v[j].z + v[j].w * v[j].w); }
    s = wave_sum(s);
    if (lane == 0) *rinv = 1.0f / sqrtf(s * (1.0f / DM) + NORM_EPS);
    GAS u32x2* o8 = (GAS u32x2*)orow + lane;
#pragma unroll
    for (int j = 0; j < 8; ++j) { u32x2 w; w.x = pk2(v[j].x, v[j].y); w.y = pk2(v[j].z, v[j].w); o8[64 * j] = w; }
    if (qrow) {
#pragma unroll
        for (int j = 0; j < 8; ++j) ((GAS unsigned*)qrow)[lane + 64 * j] = pk4_fp8(v[j].x * 8.f, v[j].y * 8.f, v[j].z * 8.f, v[j].w * 8.f); }
}

__device__ __forceinline__ TrItem p0_item(Frame& F, int r) {
    constexpr int I_A = 32 * 96, I_B = 32 * 128, I_G = 32 * 192;
    const float* w_in = F.in[4]; const float* g_mix = F.in[2]; bf16* W1T = WSP(bf16, WS_W1T);
    TrItem t; t.f8 = 0;
    if (r < I_A) { const int kb = r / 96, nb = r % 96; t.src = w_in + (size_t)(64 * kb) * WIN_LD + 32 * nb; t.ldw = WIN_LD; t.gain = g_mix + 64 * kb; t.dst = W1T + (size_t)(32 * nb) * DM + 64 * kb; t.K = DM; return t; } r -= I_A;
    if (r < I_B) { const int kb = r / 128, nb = r % 128; t.src = w_in + (size_t)(64 * kb) * WIN_LD + 3088 + 32 * nb; t.ldw = WIN_LD; t.gain = g_mix + 64 * kb; t.dst = W1T + (size_t)(3072 + 32 * nb) * DM + 64 * kb; t.K = DM; return t; } r -= I_B;
    if (r < I_G) { const int kb = r / 192, nb = r % 192; t.src = F.in[19] + (size_t)(64 * kb) * NGT + 32 * nb; t.ldw = NGT; t.gain = g_mix + 64 * kb; t.dst = (bf16*)(F.ws + WS_WG8 + (size_t)(32 * nb) * DM + 64 * kb); t.K = DM; t.f8 = 1; return t; } r -= I_G;
    { const int kb = r / 64, nb = r % 64; t.src = F.in[17] + (size_t)(64 * kb) * 2048 + 32 * nb; t.ldw = 2048; t.gain = F.in[3] + 64 * kb; t.dst = WSP(bf16, WS_WKVT) + (size_t)(32 * nb) * DM + 64 * kb; t.K = DM; return t; }
}
__device__ __forceinline__ TrItem p1t_item(Frame& F, int r) {
    constexpr int I_BR = 3 * 16 * 64;
    TrItem t; t.f8 = 0;
    if (r < I_BR) { const int br = r / 1024, q = r % 1024, kb = q / 64, nb = q % 64;
        t.src = F.in[18] + (size_t)br * 1024 * 2048 + (size_t)(64 * kb) * 2048 + 32 * nb; t.ldw = 2048; t.gain = nullptr; t.dst = WSP(bf16, WS_WBT) + (size_t)br * 2048 * 1024 + (size_t)(32 * nb) * 1024 + 64 * kb; t.K = 1024; return t; } r -= I_BR;
    { const int kb = r / 64, nb = r % 64; t.src = F.in[21] + (size_t)(64 * kb) * 2048 + 32 * nb; t.ldw = 2048; t.gain = nullptr; t.dst = WSP(bf16, WS_WOT) + (size_t)(32 * nb) * DM + 64 * kb; t.K = DM; return t; }
}
__device__ __forceinline__ TrItem p2_item(Frame& F, int r) {
    TrItem t; t.f8 = 0;
    { const int kb = r / 352, nb = r % 352; const int j0 = 32 * nb; const int drow = (j0 < DFF) ? (256 * (j0 / 128) + (j0 % 128)) : (256 * ((j0 - DFF) / 128) + 128 + ((j0 - DFF) % 128));
        t.src = F.in[23] + (size_t)(64 * kb) * (2 * DFF) + j0; t.ldw = 2 * DFF; t.gain = F.in[22] + 64 * kb; t.dst = WSP(bf16, WS_WFIT) + (size_t)drow * DM + 64 * kb; t.K = DM; return t; }
}
__device__ __forceinline__ TrItem p5t_item(Frame& F, int r) {
    TrItem t; t.f8 = 0;
    { const int kb = r / 64, nb = r % 64; t.src = F.in[24] + (size_t)(64 * kb) * DM + 32 * nb; t.ldw = DM; t.gain = nullptr; t.dst = WSP(bf16, WS_WFDT) + (size_t)(32 * nb) * DFF + 64 * kb; t.K = DFF; return t; }
}
#define TR_RUN(DECODE, NITEMS) do { \
    for (int it = gw; it < (NITEMS); it += 4 * NGW) { const int it2 = it + NGW, it3 = it + 2 * NGW, it4 = it + 3 * NGW; const bool two = it2 < (NITEMS), three = it3 < (NITEMS), four = it4 < (NITEMS); \
        const TrItem ta = DECODE(F, it); const TrItem tb = DECODE(F, two ? it2 : it); const TrItem tc = DECODE(F, three ? it3 : it); const TrItem td = DECODE(F, four ? it4 : it); \
        f32x4 va[8], vb[8], vc[8], vd[8]; tr_load(va, ta, F.lane); if (two) tr_load(vb, tb, F.lane); if (three) tr_load(vc, tc, F.lane); if (four) tr_load(vd, td, F.lane); \
        tr_store(va, ta, F.lane); if (two) tr_store(vb, tb, F.lane); if (three) tr_store(vc, tc, F.lane); if (four) tr_store(vd, td, F.lane); } } while (0)

__device__ __forceinline__ void p0_prologue(Frame& F) {
    const int gw = F.vcu * NWAVES + F.wave, NGW = F.G * NWAVES;
    constexpr int NITEMS = 32 * 96 + 32 * 128 + 32 * 192 + 32 * 64;
    TR_RUN(p0_item, NITEMS);
    for (int it = gw; it < 32 * 16; it += NGW) { const int kb = it / 16, nb = it % 16; tr_alpha(F.in[4], F.in[5], F.in[2], WSP(bf16, WS_W1T) + (size_t)ZA_GLA * DM, 64 * kb, 32 * nb, F.lane); }
    for (int m = gw; m < TOK; m += NGW) row_to_bf16(F.in[0] + (size_t)m * DM, WSP(bf16, WS_XB) + (size_t)m * DM, WSP(float, WS_RINVX) + m, F.lane, (unsigned*)(F.ws + WS_XQ + (size_t)m * DM));
    for (int m = gw; m < MEMROWS; m += NGW) row_to_bf16(F.in[1] + (size_t)m * DM, WSP(bf16, WS_MEMB) + (size_t)m * DM, WSP(float, WS_RINVM) + m, F.lane);
    if (gw == 0) {
        const int l = F.lane;
        float d1 = F.in[10][l] * F.in[11][l] + F.in[10][l + 64] * F.in[11][l + 64];
        float d2 = F.in[12][l] * F.in[13][l] + F.in[12][l + 64] * F.in[13][l + 64];
        d1 = wave_sum(d1); d2 = wave_sum(d2);
        const float gq = wave_max(fmaxf(fabsf(F.in[8][l]), fabsf(F.in[8][l + 64]))), gk = wave_max(fmaxf(fabsf(F.in[9][l]), fabsf(F.in[9][l + 64])));
        const float mq = wave_max(fmaxf(fmaxf(fabsf(F.in[15][l]), fabsf(F.in[15][l + 64])), fmaxf(fabsf(F.in[15][l + 128]), fabsf(F.in[15][l + 192]))));
        const float mk = wave_max(fmaxf(fmaxf(fabsf(F.in[16][l]), fabsf(F.in[16][l + 64])), fmaxf(fabsf(F.in[16][l + 128]), fabsf(F.in[16][l + 192]))));
        if (l == 0) { float* sc = WSP(float, WS_SC); sc[0] = expf(d1) - expf(d2) + LAM_INIT; sc[1] = 11.313708499f * gq * gk * LOG2E; sc[2] = 16.0f * mq * mk * LOG2E; }
    }
}
__device__ __forceinline__ void p2_convert(Frame& F) {
    const int gw = F.vcu * NWAVES + F.wave, NGW = F.G * NWAVES;
    TR_RUN(p2_item, 32 * 352);
}
template <int DH>
__device__ __forceinline__ void knorm8(bf16* base  , size_t ld, const float* gain, int lane) {
    constexpr int NCH = DH / 64;
    bf16* p = base + (size_t)(lane >> 3) * ld + (lane & 7) * 8;
    u32x4 v[NCH]; float ss = 0.f;
#pragma unroll
    for (int i = 0; i < NCH; ++i) { v[i] = *(const u32x4*)(p + 64 * i);
        const float a0 = bflo(v[i].x), a1 = bfhi(v[i].x), a2 = bflo(v[i].y), a3 = bfhi(v[i].y), a4 = bflo(v[i].z), a5 = bfhi(v[i].z), a6 = bflo(v[i].w), a7 = bfhi(v[i].w);
        ss += (a0 * a0 + a1 * a1) + (a2 * a2 + a3 * a3) + (a4 * a4 + a5 * a5) + (a6 * a6 + a7 * a7); }
    ss += __shfl_xor(ss, 1); ss += __shfl_xor(ss, 2); ss += __shfl_xor(ss, 4);
    const float rn = frsq(ss * (1.0f / DH) + NORM_EPS);
#pragma unroll
    for (int i = 0; i < NCH; ++i) { const float* g = gain + ((lane & 7) + 8 * i) * 8; const f32x4 g0 = *(const f32x4*)g, g1 = *(const f32x4*)(g + 4);
        u32x4 w;
        w.x = pk2(bflo(v[i].x) * rn * g0[0], bfhi(v[i].x) * rn * g0[1]); w.y = pk2(bflo(v[i].y) * rn * g0[2], bfhi(v[i].y) * rn * g0[3]);
        w.z = pk2(bflo(v[i].z) * rn * g1[0], bfhi(v[i].z) * rn * g1[1]); w.w = pk2(bflo(v[i].w) * rn * g1[2], bfhi(v[i].w) * rn * g1[3]);
        *(u32x4*)(p + 64 * i) = w; }
}

__device__ __forceinline__ void p1_tail_convert(Frame& F, int first, int nw) {
    const int gw = ((int)blockIdx.x - first) * NWAVES + F.wave, NGW = nw * NWAVES;
    TR_RUN(p1t_item, 3 * 16 * 64 + 32 * 64);
}
__device__ __forceinline__ void p5_tail_convert(Frame& F, int first, int nw) {
    const int gw = ((int)blockIdx.x - first) * NWAVES + F.wave, NGW = nw * NWAVES;
    TR_RUN(p5t_item, 88 * 64);
}

constexpr int BG_NH = 2 * 32 * 352;
template <bool V> struct BoolT { static constexpr bool value = V; };
struct BgConv { const float* src; const float* gain; bf16* dst; int h, step; };
__device__ __forceinline__ void bg_load(const BgConv& B, f32x4 (&v)[4], f32x4& gv, int lane) {
    const int hh = (B.h < BG_NH) ? B.h : BG_NH - 1;
    const int r = hh >> 1, half = hh & 1, kb = r / 352, nb = r % 352;
    const float* p = B.src + (size_t)(64 * kb + 4 * half + 8 * (lane & 7)) * (2 * DFF) + 32 * nb + 4 * (lane >> 3);
#pragma unroll
    for (int j = 0; j < 4; ++j) v[j] = __builtin_nontemporal_load((const f32x4*)(p + (size_t)j * (2 * DFF)));
    gv = *(const f32x4*)(B.gain + 64 * kb + 4 * half + 8 * (lane & 7));
}
__device__ __forceinline__ void bg_store(const BgConv& B, const f32x4 (&v)[4], const f32x4& gv, int lane) {
    const int r = B.h >> 1, half = B.h & 1, kb = r / 352, nb = r % 352; const int j0 = 32 * nb;
    const int drow = (j0 < DFF) ? (256 * (j0 / 128) + (j0 % 128)) : (256 * ((j0 - DFF) / 128) + 128 + ((j0 - DFF) % 128));
    bf16* d = B.dst + (size_t)(drow + 4 * (lane >> 3)) * DM + 64 * kb + 4 * half + 8 * (lane & 7);
#pragma unroll
    for (int i = 0; i < 4; ++i) { u32x2 o; o.x = pk2(v[0][i] * gv[0], v[1][i] * gv[1]); o.y = pk2(v[2][i] * gv[2], v[3][i] * gv[3]); *(GAS u32x2*)(d + (size_t)i * DM) = o; }
}

constexpr int AT_K = 0, AT_V = 34816, AT_P = AT_V + 36864, AT_G = AT_P + 18432, AT_L = AT_G + 2048, AT_R = AT_L + 1024, AT_END = AT_R + 1024;
static_assert(AT_END <= RING_BYTES, "attention LDS");
constexpr int VST = 576, PST = 144;

__device__ __forceinline__ void tile_load(u32x4 (&r)[4], const bf16* base, int ld, int tid) {
    const bf16* p = base + (size_t)(tid >> 3) * ld + (tid & 7) * 8;
#pragma unroll
    for (int i = 0; i < 4; ++i) r[i] = *(const u32x4*)(p + 64 * i);
}
__device__ __forceinline__ void tile_store_raw(const u32x4 (&r)[4], LAS unsigned char* buf, int tid) {
#pragma unroll
    for (int i = 0; i < 4; ++i) *(LAS u32x4*)(buf + (tid >> 3) * VST + ((tid & 7) + 8 * i) * 16) = r[i];
}
template <int DH, int NCOMP>
__device__ __forceinline__ void tile_store_norm(const u32x4 (&r)[4], LAS unsigned char* buf, const LAS float* gain, float scale, int tid) {
    constexpr int KST = DH * 2 + 16, CPR = DH / 8;
    float ss[2] = {0.f, 0.f};
#pragma unroll
    for (int i = 0; i < 4; ++i) { const int c = (NCOMP == 2) ? (i >> 1) : 0;
        const float a0 = bflo(r[i].x), a1 = bfhi(r[i].x), a2 = bflo(r[i].y), a3 = bfhi(r[i].y), a4 = bflo(r[i].z), a5 = bfhi(r[i].z), a6 = bflo(r[i].w), a7 = bfhi(r[i].w);
        ss[c] += (a0 * a0 + a1 * a1) + (a2 * a2 + a3 * a3) + (a4 * a4 + a5 * a5) + (a6 * a6 + a7 * a7); }
#pragma unroll
    for (int c = 0; c < NCOMP; ++c) { ss[c] += __shfl_xor(ss[c], 1); ss[c] += __shfl_xor(ss[c], 2); ss[c] += __shfl_xor(ss[c], 4); ss[c] = frsq(ss[c] * (1.0f / DH) + NORM_EPS) * scale; }
#pragma unroll
    for (int i = 0; i < 4; ++i) { const int c = (NCOMP == 2) ? (i >> 1) : 0; const int chunk = (tid & 7) + 8 * i, dch = chunk % CPR; const float rn = ss[c];
        const f32x4 g0 = *(const LAS f32x4*)(gain + dch * 8), g1 = *(const LAS f32x4*)(gain + dch * 8 + 4);
        u32x4 w;
        w.x = pk2(bflo(r[i].x) * rn * g0[0], bfhi(r[i].x) * rn * g0[1]); w.y = pk2(bflo(r[i].y) * rn * g0[2], bfhi(r[i].y) * rn * g0[3]);
        w.z = pk2(bflo(r[i].z) * rn * g1[0], bfhi(r[i].z) * rn * g1[1]); w.w = pk2(bflo(r[i].w) * rn * g1[2], bfhi(r[i].w) * rn * g1[3]);
        *(LAS u32x4*)(buf + ((tid >> 3) * NCOMP + c) * KST + dch * 16) = w; }
}

template <int DH, int NCOMP>
__device__ __forceinline__ void tile_store_k(const u32x4 (&r)[4], LAS unsigned char* buf, int tid) {
    constexpr int KST = DH * 2 + 16, CPR = DH / 8;
#pragma unroll
    for (int i = 0; i < 4; ++i) { const int c = (NCOMP == 2) ? (i >> 1) : 0; const int chunk = (tid & 7) + 8 * i, dch = chunk % CPR;
        *(LAS u32x4*)(buf + ((tid >> 3) * NCOMP + c) * KST + dch * 16) = r[i]; }
}
template <int DH, int NCOMP, int NRB>
struct AttnUnit {
    static constexpr int NDV = 8 / NRB, DVW = 256 / NDV, NBLK = DVW / 32, KS = DH / 16, KST = DH * 2 + 16;
    const bf16* Q; int ldq; const bf16* K; int ldk; const bf16* V; int ldv; int ntiles; const float* qg; float m2;
    template <bool BG = false>
    __device__ __forceinline__ void run(LAS unsigned char* lds, f32x16 (&O)[NCOMP][NBLK], BgConv* bg = nullptr) const {
        int tid = threadIdx.x; asm volatile("" : "+v"(tid));
        const int lane = tid & 63, wid = __builtin_amdgcn_readfirstlane(tid >> 6), r = lane & 31, h = lane >> 5;
        const int kh = wid & 1, compA = (wid >> 1) % NCOMP, rbA = wid / (2 * NCOMP);
        const int dvp = wid % NDV, rbB = wid / NDV;
        const int b16 = (lane >> 4) & 1, q4 = (lane & 15) >> 2, p4 = lane & 3;
        LAS unsigned char* kbuf = lds + AT_K; LAS unsigned char* vbuf = lds + AT_V; LAS unsigned char* pbuf = lds + AT_P;
        LAS float* gq = (LAS float*)(lds + AT_G); LAS float* lbuf = (LAS float*)(lds + AT_L);
        if (tid < DH) gq[tid] = qg[tid];
        __syncthreads();
        bf16x8 qf[KS];
        const float qscale = ((DH == 128) ? 0.08838834764831845f : 0.0625f) * LOG2E;
#pragma unroll
        for (int pass = 0; pass < NRB / 2; ++pass) {
            u32x4 qr[4]; tile_load(qr, Q + (size_t)(64 * pass) * ldq, ldq, tid);
            tile_store_norm<DH, NCOMP>(qr, kbuf, gq, qscale, tid);
            __syncthreads();
            if (rbA / 2 == pass) {
#pragma unroll
                for (int s = 0; s < KS; ++s) qf[s] = *(const LAS bf16x8*)(kbuf + ((32 * (rbA & 1) + r) * NCOMP + compA) * KST + (16 * s + 8 * h) * 2);
            }
            __syncthreads();
        }
        u32x4 kreg[4], vreg[4];
        tile_load(kreg, K, ldk, tid); tile_load(vreg, V, ldv, tid);
        tile_store_k<DH, NCOMP>(kreg, kbuf, tid);
#pragma unroll
        for (int c = 0; c < NCOMP; ++c)
#pragma unroll
            for (int b = 0; b < NBLK; ++b)
#pragma unroll
                for (int i = 0; i < 16; ++i) O[c][b][i] = 0.f;
        float lsum = 0.f;
        f32x4 bgv[4], bgg;
        __syncthreads();
        auto body = [&](const int t, auto moret, auto bgt) {
            constexpr bool more = decltype(moret)::value, BGI = decltype(bgt)::value;
            if (more) tile_load(kreg, K + (size_t)(64 * (t + 1)) * ldk, ldk, tid);
            f32x16 st;
#pragma unroll
            for (int i = 0; i < 16; ++i) st[i] = 0.f;
            if (DH == 128) {
                bf16x8 kfa[KS];
#pragma unroll
                for (int s = 0; s < KS; ++s) kfa[s] = *(const LAS bf16x8*)(kbuf + ((32 * kh + r) * NCOMP + compA) * KST + (16 * s + 8 * h) * 2);
                asm volatile("" ::: "memory");
                tile_store_raw(vreg, vbuf, tid);
#pragma unroll
                for (int s = 0; s < KS; ++s) st = MFMA32(kfa[s], qf[s], st);
            } else {
            tile_store_raw(vreg, vbuf, tid);
#pragma unroll
            for (int s = 0; s < KS; ++s) { const bf16x8 kf = *(const LAS bf16x8*)(kbuf + ((32 * kh + r) * NCOMP + compA) * KST + (16 * s + 8 * h) * 2); st = MFMA32(kf, qf[s], st);
                if ((s & 3) == 3) asm volatile("" ::: "memory"); }
            }
            float pe[16];
#pragma unroll
            for (int i = 0; i < 16; ++i) { pe[i] = fexp2(st[i] - m2); lsum += pe[i]; }
#pragma unroll
            for (int g = 0; g < 4; ++g) { u32x2 w; w.x = pk2(pe[4 * g], pe[4 * g + 1]); w.y = pk2(pe[4 * g + 2], pe[4 * g + 3]);
                *(LAS u32x2*)(pbuf + ((compA * NRB + rbA) * 32 + r) * PST + (32 * kh + 8 * g + 4 * h) * 2) = w; }
            __syncthreads();
            if (more) tile_load(vreg, V + (size_t)(64 * (t + 1)) * ldv, ldv, tid);
#pragma unroll
            for (int s = 0; s < 4; ++s) {
                bf16x8 pf[NCOMP];
#pragma unroll
                for (int c = 0; c < NCOMP; ++c) pf[c] = *(const LAS bf16x8*)(pbuf + ((c * NRB + rbB) * 32 + r) * PST + (16 * s + 8 * h) * 2);
#pragma unroll
                for (int b = 0; b < NBLK; ++b) {
                    const bf16x8 vf = trfrag(vbuf + (16 * s + 8 * h + q4) * VST + (DVW * dvp + 32 * b + 16 * b16 + 4 * p4) * 2, 4 * VST);
#pragma unroll
                    for (int c = 0; c < NCOMP; ++c) O[c][b] = MFMA32(pf[c], vf, O[c][b]);
                }
                asm volatile("" ::: "memory");
                if (DH == 128 && s == 1) { if (more) tile_store_k<DH, NCOMP>(kreg, kbuf, tid); }
            }
            if (DH != 128) { if (more) tile_store_k<DH, NCOMP>(kreg, kbuf, tid); }
            if constexpr (BGI) { bg_store(*bg, bgv, bgg, lane); bg->h += bg->step; bg_load(*bg, bgv, bgg, lane); }
            __syncthreads();
        };
        int t = 0;
        if constexpr (BG) {
            int n = 0; if (bg->h < BG_NH) { n = (BG_NH - 1 - bg->h) / bg->step + 1; const int fit = (ntiles - 1) / 2; n = (n < fit) ? n : fit; }
            if (n > 0) { bg_load(*bg, bgv, bgg, lane);
#pragma unroll 1
                for (int g = 0; g < n; ++g, t += 2) { body(t, BoolT<true>{}, BoolT<false>{}); body(t + 1, BoolT<true>{}, BoolT<true>{}); } } }
        for (; t < ntiles - 1; ++t) body(t, BoolT<true>{}, BoolT<false>{});
        body(ntiles - 1, BoolT<false>{}, BoolT<false>{});
        lsum += __shfl_xor(lsum, 32);
        if (h == 0) lbuf[((compA * NRB + rbA) * 2 + kh) * 32 + r] = lsum;
        __syncthreads();
    }
};

template <bool BG = false>
__device__ __forceinline__ void diff_unit(Frame& F, int bh, int c, BgConv* bg = nullptr) {
    typedef AttnUnit<128, 2, 2> AU;
    const int b = bh >> 2, hd = bh & 3;
    const bf16* Z = WSP(bf16, WS_Z); const float* sc = WSP(float, WS_SC);
    AU u; u.Q = Z + (size_t)(b * SEQ + 64 * c) * NZ + ZQ_DIFF + hd * 256; u.ldq = NZ; u.K = Z + (size_t)(b * SEQ) * NZ + ZK_DIFF + hd * 256; u.ldk = NZ;
    u.V = Z + (size_t)(b * SEQ) * NZ + ZV_DIFF + hd * 256; u.ldv = NZ; u.ntiles = c + 1; u.qg = F.in[8]; u.m2 = sc[1];
    f32x16 O[2][2];
    u.template run<BG>(F.lds, O, bg);
    int tid = F.tid; asm volatile("" : "+v"(tid));
    const int lane = tid & 63, wid = F.wave, r = lane & 31, h = lane >> 5, dvp = wid & 3, rbB = wid >> 2;
    LAS unsigned char* lds = F.lds;
    const LAS float* lbuf = (const LAS float*)(lds + AT_L);
    const float lam = sc[0];
    if (tid < 256) ((LAS float*)(lds + AT_G + 1024))[tid] = F.in[14][tid] * (1.0f - LAM_INIT);
#pragma unroll
    for (int i = 0; i < 16; ++i) { const int q = crow(i, h);
        const float l1 = lbuf[((0 * 2 + rbB) * 2 + 0) * 32 + q] + lbuf[((0 * 2 + rbB) * 2 + 1) * 32 + q];
        const float l2 = lbuf[((1 * 2 + rbB) * 2 + 0) * 32 + q] + lbuf[((1 * 2 + rbB) * 2 + 1) * 32 + q];
        const float i1 = frcp(l1), i2 = lam * frcp(l2);
        LAS unsigned char* orow = lds + (32 * rbB + q) * 1024; const int sw = (q & 1) << 4;
        *(LAS float*)(orow + (((64 * dvp + r) * 4) ^ sw)) = O[0][0][i] * i1 - O[1][0][i] * i2;
        *(LAS float*)(orow + (((64 * dvp + 32 + r) * 4) ^ sw)) = O[0][1][i] * i1 - O[1][1][i] * i2; }
    __syncthreads();
    { const int l = tid >> 3, sw = (l & 1) << 4;
      const LAS unsigned char* orow = lds + l * 1024;
      const LAS f32x4* gnt = (const LAS f32x4*)(lds + AT_G + 1024);
      f32x4 o[4][2]; float ss = 0.f;
#pragma unroll
      for (int i = 0; i < 4; ++i) { const int ch = (tid & 7) + 8 * i;
          o[i][0] = *(const LAS f32x4*)(orow + ((ch * 32) ^ sw)); o[i][1] = *(const LAS f32x4*)(orow + ((ch * 32 + 16) ^ sw));
#pragma unroll
          for (int e = 0; e < 4; ++e) ss += o[i][0][e] * o[i][0][e] + o[i][1][e] * o[i][1][e]; }
      ss += __shfl_xor(ss, 1); ss += __shfl_xor(ss, 2); ss += __shfl_xor(ss, 4);
      const float rn = frsq(ss * (1.0f / 256.0f) + NORM_EPS);
      bf16* Y = (bf16*)F.out + (size_t)TOK * 1024 + (size_t)(b * SEQ + 64 * c + l) * 1024 + hd * 256 + (tid & 7) * 8;
#pragma unroll
      for (int i = 0; i < 4; ++i) { const int ch = (tid & 7) + 8 * i;
          const f32x4 g0 = gnt[2 * ch], g1 = gnt[2 * ch + 1];
          u32x4 w;
          w.x = pk2(o[i][0][0] * rn * g0[0], o[i][0][1] * rn * g0[1]); w.y = pk2(o[i][0][2] * rn * g0[2], o[i][0][3] * rn * g0[3]);
          w.z = pk2(o[i][1][0] * rn * g1[0], o[i][1][1] * rn * g1[1]); w.w = pk2(o[i][1][2] * rn * g1[2], o[i][1][3] * rn * g1[3]);
          *(u32x4*)(Y + 64 * i) = w; } }
    __syncthreads();
}
__device__ __forceinline__ void mem_unit(Frame& F, int b, int hd, int qb) {
    typedef AttnUnit<256, 1, 4> AU;
    const bf16* Z = WSP(bf16, WS_Z); const bf16* KVM = WSP(bf16, WS_KVM); const float* sc = WSP(float, WS_SC);
    AU u; u.Q = Z + (size_t)(b * SEQ + 128 * qb) * NZ + ZQ_MEM + hd * 256; u.ldq = NZ; u.K = KVM + (size_t)(b * NMEM) * 2048 + hd * 256; u.ldk = 2048;
    u.V = KVM + (size_t)(b * NMEM) * 2048 + 1024 + hd * 256; u.ldv = 2048; u.ntiles = 4; u.qg = F.in[15]; u.m2 = sc[2];
    f32x16 O[1][4];
    u.run(F.lds, O);
    const int lane = F.lane, wid = F.wave, r = lane & 31, h = lane >> 5, dvp = wid & 1, rbB = wid >> 1;
    const LAS float* lbuf = (const LAS float*)(F.lds + AT_L);
    bf16* Y = (bf16*)F.out + (size_t)2 * TOK * 1024;
#pragma unroll
    for (int i = 0; i < 16; ++i) { const int q = crow(i, h);
        const float il = frcp(lbuf[(rbB * 2 + 0) * 32 + q] + lbuf[(rbB * 2 + 1) * 32 + q]);
        bf16* yp = Y + (size_t)(b * SEQ + 128 * qb + 32 * rbB + q) * 1024 + hd * 256 + 128 * dvp + r;
#pragma unroll
        for (int blk = 0; blk < 4; ++blk) yp[32 * blk] = (bf16)(pk2(O[0][blk][i] * il, 0.f) & 0xffffu); }
    __syncthreads();
}

constexpr int GL_LA = 0;
constexpr int GL_VT = 32768;
constexpr int GL_KT = GL_VT + 36864;
constexpr int GL_KD = GL_KT + 20480;
constexpr int GL_ATT = GL_KD + 17408;
constexpr int GL_RED = GL_ATT + 9216;
constexpr int GL_SEG = GL_RED + 2048;
constexpr int GL_GY = GL_SEG + 2048;
static_assert(GL_GY + 32768 <= LDSCTL_OFF, "GLA LDS");
__device__ __forceinline__ void gla_load_la(LAS unsigned char* lds, const bf16* src, int tid) {
    const bf16* p = src + (size_t)(tid >> 3) * NZ + (tid & 7) * 8;
#pragma unroll
    for (int i = 0; i < 2; ++i) { const u32x4 v = *(const u32x4*)(p + 64 * i); LAS float* d = (LAS float*)(lds + GL_LA) + (tid >> 3) * 128 + ((tid & 7) + 8 * i) * 8;
        *(LAS f32x4*)d = (f32x4){bflo(v.x), bfhi(v.x), bflo(v.y), bfhi(v.y)}; *(LAS f32x4*)(d + 4) = (f32x4){bflo(v.z), bfhi(v.z), bflo(v.w), bfhi(v.w)}; }
}
__device__ __forceinline__ void gla_cumsum(LAS unsigned char* lds, int tid) {
    LAS float* la = (LAS float*)(lds + GL_LA) + (tid >> 7) * 16 * 128 + (tid & 127); LAS float* seg = (LAS float*)(lds + GL_SEG);
    float v[16];
#pragma unroll
    for (int i = 0; i < 16; ++i) v[i] = la[i * 128];
#pragma unroll
    for (int i = 1; i < 16; ++i) v[i] += v[i - 1];
    seg[tid] = v[15];
    __syncthreads();
    float off = 0.f;
#pragma unroll
    for (int sgi = 0; sgi < 3; ++sgi) off += (sgi < (tid >> 7)) ? seg[sgi * 128 + (tid & 127)] : 0.f;
#pragma unroll
    for (int i = 0; i < 16; ++i) la[i * 128] = v[i] + off;
}
__device__ __forceinline__ void gla_inc_unit(Frame& F, int bh, int n) {
    int tid = F.tid; asm volatile("" : "+v"(tid));
    const int lane = tid & 63, wid = F.wave, h = lane >> 5, b16 = (lane >> 4) & 1, q4 = (lane & 15) >> 2, p4 = lane & 3;
    const int b = bh >> 2, hd = bh & 3;
    const bf16* zrow = WSP(bf16, WS_Z) + (size_t)(b * SEQ + 64 * n) * NZ;
    LAS unsigned char* lds = F.lds;
    gla_load_la(lds, zrow + ZA_GLA + hd * 128, tid);
    u32x4 kr[2]; { const bf16* p = zrow + ZK_GLA + hd * 128 + (size_t)(tid >> 3) * NZ + (tid & 7) * 8; kr[0] = *(const u32x4*)p; kr[1] = *(const u32x4*)(p + 64); }
    { u32x4 vr[4]; tile_load(vr, zrow + ZV_GLA + hd * 256, NZ, tid); tile_store_raw(vr, lds + GL_VT, tid); }
    __syncthreads();
    gla_cumsum(lds, tid);
    __syncthreads();
    const LAS float* la = (const LAS float*)(lds + GL_LA);
#pragma unroll
    for (int i = 0; i < 2; ++i) { const int l = tid >> 3, d0 = ((tid & 7) + 8 * i) * 8;
        const f32x4 e0 = *(const LAS f32x4*)(la + 63 * 128 + d0), e1 = *(const LAS f32x4*)(la + 63 * 128 + d0 + 4), c0 = *(const LAS f32x4*)(la + l * 128 + d0), c1 = *(const LAS f32x4*)(la + l * 128 + d0 + 4);
        u32x4 w;
        w.x = pk2(bflo(kr[i].x) * fexp(e0[0] - c0[0]), bfhi(kr[i].x) * fexp(e0[1] - c0[1])); w.y = pk2(bflo(kr[i].y) * fexp(e0[2] - c0[2]), bfhi(kr[i].y) * fexp(e0[3] - c0[3]));
        w.z = pk2(bflo(kr[i].z) * fexp(e1[0] - c1[0]), bfhi(kr[i].z) * fexp(e1[1] - c1[1])); w.w = pk2(bflo(kr[i].w) * fexp(e1[2] - c1[2]), bfhi(kr[i].w) * fexp(e1[3] - c1[3]));
        *(LAS u32x4*)(lds + GL_KT + l * 320 + d0 * 2) = w; }
    if (tid < 128) WSP(float, WS_DEC)[(size_t)(bh * 64 + n) * 128 + tid] = fexp(la[63 * 128 + tid]);
    __syncthreads();
    f32x16 acc[4];
#pragma unroll
    for (int c = 0; c < 4; ++c)
#pragma unroll
        for (int i = 0; i < 16; ++i) acc[c][i] = 0.f;
#pragma unroll
    for (int s = 0; s < 4; ++s) {
        const bf16x8 af = trfrag(lds + GL_VT + (16 * s + 8 * h + q4) * VST + (32 * wid + 16 * b16 + 4 * p4) * 2, 4 * VST);
#pragma unroll
        for (int c = 0; c < 4; ++c) { const bf16x8 bf = trfrag(lds + GL_KT + (16 * s + 8 * h + q4) * 320 + (32 * c + 16 * b16 + 4 * p4) * 2, 4 * 320); acc[c] = MFMA32(af, bf, acc[c]); }
    }
    bf16* sb = WSP(bf16, WS_SB) + (size_t)(bh * 64 + n) * 256 * 128;
#pragma unroll
    for (int c = 0; c < 4; ++c)
#pragma unroll
        for (int i = 0; i < 16; ++i) sb[(size_t)(32 * wid + crow(i, h)) * 128 + 32 * c + (lane & 31)] = (bf16)(pk2(acc[c][i], 0.f) & 0xffffu);
    __syncthreads();
}
__device__ __forceinline__ void gla_scan(Frame& F) {
    const int NT = F.G * 512;
    for (int e = F.vcu * 512 + F.tid; e < 8 * 256 * 64; e += NT) {
        const int bh = e >> 14, rem = e & 16383, dv = rem >> 6, dk = (rem & 63) * 2;
        unsigned* sb = (unsigned*)(WSP(bf16, WS_SB) + (size_t)bh * 64 * 256 * 128 + (size_t)dv * 128 + dk);
        const float* dec = WSP(float, WS_DEC) + (size_t)bh * 64 * 128 + dk;
        float s0 = 0.f, s1 = 0.f;
#pragma unroll 8
        for (int n = 0; n < 64; ++n) { const unsigned inc = sb[(size_t)n * 256 * 64]; const f32x2 d = *(const f32x2*)(dec + n * 128);
            sb[(size_t)n * 256 * 64] = pk2(s0, s1); s0 = d.x * s0 + bflo(inc); s1 = d.y * s1 + bfhi(inc); }
    }
}
__device__ __forceinline__ void gla_out_unit(Frame& F, int bh, int n) {
    int tid = F.tid; asm volatile("" : "+v"(tid));
    const int lane = tid & 63, wid = F.wave, r = lane & 31, h = lane >> 5, b16 = (lane >> 4) & 1, q4 = (lane & 15) >> 2, p4 = lane & 3;
    const int b = bh >> 2, hd = bh & 3;
    const bf16* zrow = WSP(bf16, WS_Z) + (size_t)(b * SEQ + 64 * n) * NZ;
    LAS unsigned char* lds = F.lds;
    const bf16* sb = WSP(bf16, WS_SB) + (size_t)(bh * 64 + n) * 256 * 128 + (size_t)(32 * wid + r) * 128 + 8 * h;
    bf16x8 sf[8];
#pragma unroll
    for (int s = 0; s < 8; ++s) sf[s] = *(const bf16x8*)(sb + 16 * s);
    gla_load_la(lds, zrow + ZA_GLA + hd * 128, tid);
    u32x4 qr[2], kr[2];
    { const bf16* p = zrow + ZQ_GLA + hd * 128 + (size_t)(tid >> 3) * NZ + (tid & 7) * 8; qr[0] = *(const u32x4*)p; qr[1] = *(const u32x4*)(p + 64); }
    { const bf16* p = zrow + ZK_GLA + hd * 128 + (size_t)(tid >> 3) * NZ + (tid & 7) * 8; kr[0] = *(const u32x4*)p; kr[1] = *(const u32x4*)(p + 64); }
    { u32x4 vr[4]; tile_load(vr, zrow + ZV_GLA + hd * 256, NZ, tid); tile_store_raw(vr, lds + GL_VT, tid); }
    u32x4 gr[4]; tile_load(gr, zrow + ZG_GLA + hd * 256, NZ, tid);
    if (tid < 256) ((LAS float*)(lds + GL_RED))[tid] = F.in[7][tid];
    __syncthreads();
    gla_cumsum(lds, tid);
    __syncthreads();
    const LAS float* la = (const LAS float*)(lds + GL_LA);
    const float qs = 0.08838834764831845f;
#pragma unroll
    for (int i = 0; i < 2; ++i) { const int l = tid >> 3, d0 = ((tid & 7) + 8 * i) * 8;
        const f32x4 c0 = *(const LAS f32x4*)(la + l * 128 + d0), c1 = *(const LAS f32x4*)(la + l * 128 + d0 + 4);
        float ep[8], en[8];
#pragma unroll
        for (int e = 0; e < 4; ++e) { ep[e] = fexp(c0[e]); en[e] = fexp(-c0[e]); ep[4 + e] = fexp(c1[e]); en[4 + e] = fexp(-c1[e]); }
        u32x4 wq, wk;
        wq.x = pk2(bflo(qr[i].x) * qs * ep[0], bfhi(qr[i].x) * qs * ep[1]); wq.y = pk2(bflo(qr[i].y) * qs * ep[2], bfhi(qr[i].y) * qs * ep[3]);
        wq.z = pk2(bflo(qr[i].z) * qs * ep[4], bfhi(qr[i].z) * qs * ep[5]); wq.w = pk2(bflo(qr[i].w) * qs * ep[6], bfhi(qr[i].w) * qs * ep[7]);
        wk.x = pk2(bflo(kr[i].x) * en[0], bfhi(kr[i].x) * en[1]); wk.y = pk2(bflo(kr[i].y) * en[2], bfhi(kr[i].y) * en[3]);
        wk.z = pk2(bflo(kr[i].z) * en[4], bfhi(kr[i].z) * en[5]); wk.w = pk2(bflo(kr[i].w) * en[6], bfhi(kr[i].w) * en[7]);
        *(LAS u32x4*)(lds + GL_KT + l * 272 + d0 * 2) = wq; *(LAS u32x4*)(lds + GL_KD + l * 272 + d0 * 2) = wk; }
    __syncthreads();
    if (wid < 4) { const int mb = wid >> 1, lb = wid & 1; f32x16 st;
#pragma unroll
        for (int i = 0; i < 16; ++i) st[i] = 0.f;
#pragma unroll
        for (int s = 0; s < 8; ++s) { const bf16x8 kf = *(const LAS bf16x8*)(lds + GL_KD + (32 * mb + r) * 272 + (16 * s + 8 * h) * 2), qf = *(const LAS bf16x8*)(lds + GL_KT + (32 * lb + r) * 272 + (16 * s + 8 * h) * 2);
            st = MFMA32(kf, qf, st); }
        const int lrow = 32 * lb + r;
#pragma unroll
        for (int g = 0; g < 4; ++g) { float v[4];
#pragma unroll
            for (int e = 0; e < 4; ++e) { const int m = 32 * mb + 8 * g + 4 * h + e; v[e] = (m <= lrow) ? st[4 * g + e] : 0.f; }
            u32x2 w; w.x = pk2(v[0], v[1]); w.y = pk2(v[2], v[3]);
            *(LAS u32x2*)(lds + GL_ATT + lrow * PST + (32 * mb + 8 * g + 4 * h) * 2) = w; } }
    f32x16 acc[2];
#pragma unroll
    for (int lb = 0; lb < 2; ++lb)
#pragma unroll
        for (int i = 0; i < 16; ++i) acc[lb][i] = 0.f;
#pragma unroll
    for (int s = 0; s < 8; ++s)
#pragma unroll
        for (int lb = 0; lb < 2; ++lb) { const bf16x8 qf = *(const LAS bf16x8*)(lds + GL_KT + (32 * lb + r) * 272 + (16 * s + 8 * h) * 2); acc[lb] = MFMA32(qf, sf[s], acc[lb]); }
    __syncthreads();
#pragma unroll
    for (int s = 0; s < 4; ++s) { const bf16x8 vf = trfrag(lds + GL_VT + (16 * s + 8 * h + q4) * VST + (32 * wid + 16 * b16 + 4 * p4) * 2, 4 * VST);
#pragma unroll
        for (int lb = 0; lb < 2; ++lb) { const bf16x8 af = *(const LAS bf16x8*)(lds + GL_ATT + (32 * lb + r) * PST + (16 * s + 8 * h) * 2); acc[lb] = MFMA32(af, vf, acc[lb]); } }
#pragma unroll
    for (int lb = 0; lb < 2; ++lb)
#pragma unroll
        for (int i = 0; i < 16; ++i) { const int lr = crow(i, h);
            *(LAS float*)(lds + (lb ? GL_GY : GL_LA) + lr * 1024 + (((32 * wid + r) * 4) ^ ((lr & 1) << 4))) = acc[lb][i]; }
    __syncthreads();
    { const int l = tid >> 3, sw = (l & 1) << 4;
      const LAS unsigned char* orow = lds + ((l & 32) ? GL_GY : GL_LA) + (l & 31) * 1024;
      const LAS f32x4* gnt = (const LAS f32x4*)(lds + GL_RED);
      f32x4 o[4][2]; float ss = 0.f;
#pragma unroll
      for (int i = 0; i < 4; ++i) { const int c = (tid & 7) + 8 * i;
          o[i][0] = *(const LAS f32x4*)(orow + ((c * 32) ^ sw)); o[i][1] = *(const LAS f32x4*)(orow + ((c * 32 + 16) ^ sw));
#pragma unroll
          for (int e = 0; e < 4; ++e) ss += o[i][0][e] * o[i][0][e] + o[i][1][e] * o[i][1][e]; }
      ss += __shfl_xor(ss, 1); ss += __shfl_xor(ss, 2); ss += __shfl_xor(ss, 4);
      const float rn = frsq(ss * (1.0f / 256.0f) + NORM_EPS);
      bf16* Y = (bf16*)F.out + (size_t)(b * SEQ + 64 * n + l) * 1024 + hd * 256 + (tid & 7) * 8;
#pragma unroll
      for (int i = 0; i < 4; ++i) { const int c = (tid & 7) + 8 * i;
          const f32x4 g0 = gnt[2 * c], g1 = gnt[2 * c + 1];
          const unsigned gw[4] = {gr[i].x, gr[i].y, gr[i].z, gr[i].w};
          float y[8];
#pragma unroll
          for (int e = 0; e < 4; ++e) { const float ga = bflo(gw[e]), gb = bfhi(gw[e]);
              const float oa = (e < 2) ? o[i][0][2 * e] : o[i][1][2 * e - 4], ob = (e < 2) ? o[i][0][2 * e + 1] : o[i][1][2 * e - 3];
              const float na = (e < 2) ? g0[2 * e] : g1[2 * e - 4], nb = (e < 2) ? g0[2 * e + 1] : g1[2 * e - 3];
              y[2 * e] = oa * rn * na * (ga * sigmoidf_(ga)); y[2 * e + 1] = ob * rn * nb * (gb * sigmoidf_(gb)); }
          u32x4 w; w.x = pk2(y[0], y[1]); w.y = pk2(y[2], y[3]); w.z = pk2(y[4], y[5]); w.w = pk2(y[6], y[7]);
          *(u32x4*)(Y + 64 * i) = w; } }
    __syncthreads();
}

constexpr int N_PHASES = 9;
struct Args { const float* in[25]; float* out; unsigned char* ws; int ph_lo, ph_hi, li, pad; };
__global__ void __launch_bounds__(NWAVES * 64, 2) mk_fwd(Args args) {
    extern __shared__ __attribute__((aligned(16))) unsigned char lds_raw[];
    Frame F;
    F.lds = (LAS unsigned char*)lds_raw;
    F.tid = threadIdx.x; F.lane = F.tid & 63; F.wave = __builtin_amdgcn_readfirstlane(F.tid >> 6);
    F.G = gridDim.x; { const int bx = blockIdx.x; F.vcu = (F.G % 8 == 0) ? (bx % 8) * (F.G / 8) + bx / 8 : bx; }
#pragma unroll
    for (int i = 0; i < 25; ++i) F.in[i] = args.in[i];
    F.out = args.out; F.ws = args.ws;
    volatile LAS unsigned* MISC = (volatile LAS unsigned*)(F.lds + MISC_OFF);
    for (int u = F.tid; u < (LDS_BYTES - LDSCTL_OFF) / 4; u += NWAVES * 64) ((LAS unsigned*)(F.lds + LDSCTL_OFF))[u] = 0u;
    __syncthreads();
    gu32* ctl = (gu32*)(F.ws + WS_CTL);
    XcdBarrier bar; bar.bar = (unsigned*)(ctl + CW_BAR); bar.x = 0; bar.st = nullptr;
    if (MK_N_LAUNCHES == 1) bar = xcd_barrier_post((unsigned*)(ctl + CW_BAR), MISC + 8);
#define GRID_BAR() do { if (MK_N_LAUNCHES == 1) xcd_barrier(bar); } while (0)
    const int lo = args.ph_lo, hi = args.ph_hi;
#ifndef PHMASK
#define PHMASK 0x1ff
#endif
#define IN(k) (((PHMASK >> (k)) & 1) && lo <= (k) && (k) < hi)
#define BOTH(k) (IN(k) && IN((k) + 1))
#ifndef REPMASK
#define REPMASK 0
#endif
#define NREP(k) ((((REPMASK) >> (k)) & 1) ? rt2 : 1)
    const int G = F.G; const int rt2 = 1 + (args.ph_hi > 0);

    if (IN(0)) { for (int rep = 0; rep < NREP(0); ++rep) { p0_prologue(F); __syncthreads(); } if (BOTH(0)) GRID_BAR(); }
    if (IN(1)) {
        pg8::SchedP1 S; S.tm.init(TOK, NZ, WGM_P1); S.G = G; S.c = (int)blockIdx.x; S.A = (const char*)WSP(bf16, WS_XB); S.B = (const char*)WSP(bf16, WS_W1T);
        S.A2 = (const char*)WSP(bf16, WS_MEMB); S.B2 = (const char*)WSP(bf16, WS_WKVT); S.tstep = (size_t)256 * DM * 2;
        pg8::Epi1 E{WSP(bf16, WS_Z), WSP(bf16, WS_GATES), WSP(bf16, WS_KVM), WSP(float, WS_RINVX), WSP(float, WS_RINVM), F.in[6], F.in[20]};
#ifndef ONLY8
        for (int rep = 0; rep < NREP(1); ++rep) pg8::gemm_phase<pg8::Epi1, pg8::SchedP1, true, true>(F.lds, DM, S, E);
#endif
        { const int nfull = (S.tm.nwg + 16) % G;
          if (nfull > 0 && (int)blockIdx.x >= nfull) p1_tail_convert(F, nfull, G - nfull); else if (nfull == 0) p1_tail_convert(F, 0, G); }
        { pg8::SchedPlain S8; S8.tm.init(TOK, NGT, WGM_P1); S8.G = G; S8.c = (int)blockIdx.x; S8.A = (const char*)(F.ws + WS_XQ); S8.B = (const char*)(F.ws + WS_WG8); S8.tstep = (size_t)256 * DM;
          pg8::EpiG EG{WSP(bf16, WS_GATES), WSP(float, WS_RINVX), F.in[20]};
#ifndef NO8
          pg8::gemm_phase8<pg8::EpiG, pg8::SchedPlain, true, true>(F.lds, DM / 2, S8, EG);
#endif
        }
        if (BOTH(1)) GRID_BAR();
    }
    if (IN(2)) {
        { const int gw = F.vcu * NWAVES + F.wave, NGW = G * NWAVES;
            for (int it = gw; it < (MEMROWS / 8) * 4; it += NGW) knorm8<256>(WSP(bf16, WS_KVM) + (size_t)((it >> 2) * 8) * 2048 + (it & 3) * 256, 2048, F.in[16], F.lane);
            for (int it = gw; it < (TOK / 8) * 8; it += NGW) knorm8<128>(WSP(bf16, WS_Z) + (size_t)((it >> 3) * 8) * NZ + ZK_DIFF + (it & 7) * 128, NZ, F.in[9], F.lane); }
        for (int rep = 0; rep < NREP(2); ++rep) for (int u = F.vcu; u < 512; u += G) gla_inc_unit(F, u >> 6, u & 63);
        if (BOTH(2)) GRID_BAR();
    }
    if (IN(3)) { gla_scan(F); for (int rep = 0; rep < NREP(4); ++rep) for (int u = F.vcu; u < 256; u += G) mem_unit(F, u >> 7, (u >> 5) & 3, u & 31); if (BOTH(3)) GRID_BAR(); }
    if (IN(4)) {
#ifndef NO_GLAOUT
        for (int rep = 0; rep < NREP(6); ++rep) for (int u = F.vcu; u < 512; u += G) gla_out_unit(F, u >> 6, u & 63);
#endif
#ifndef NO_DIFF
        { BgConv bg; bg.src = F.in[23]; bg.gain = F.in[22]; bg.dst = WSP(bf16, WS_WFIT); bg.h = F.vcu * NWAVES + F.wave; bg.step = G * NWAVES;
          for (int rep = 0; rep < NREP(5); ++rep) for (int u = F.vcu; u < 256; u += G) { const int bh = u >> 5, c = u & 31; diff_unit<true>(F, bh, 63 - c, &bg); diff_unit<true>(F, bh, c, &bg); }
          for (; bg.h < BG_NH; bg.h += bg.step) { f32x4 v[4], gv; bg_load(bg, v, gv, F.lane); bg_store(bg, v, gv, F.lane); } }
#endif
        if (BOTH(4)) GRID_BAR();
    }
    if (IN(5)) {
        pg8::SchedP3 S; S.tm.init(TOK, DM, WGM_P3); S.G = G; S.c = (int)blockIdx.x; S.A = (const char*)F.out; S.B = (const char*)WSP(bf16, WS_WBT);
        S.tstep = (size_t)256 * 1024 * 2; S.astride = (size_t)TOK * 1024 * 2; S.bstride = (size_t)DM * 1024 * 2;
        pg8::Epi3 E{WSP(bf16, WS_GATES), WSP(bf16, WS_MERGED)};
        for (int rep = 0; rep < NREP(7); ++rep) pg8::gemm_phase<pg8::Epi3, pg8::SchedP3, true, true>(F.lds, 1024, S, E);
        if (BOTH(5)) GRID_BAR();
    }
    if (IN(6)) {
        pg8::SchedPlain S; S.tm.init(TOK, DM, WGM_P4); S.G = G; S.c = (int)blockIdx.x; S.A = (const char*)WSP(bf16, WS_MERGED); S.B = (const char*)WSP(bf16, WS_WOT); S.tstep = (size_t)256 * DM * 2;
        pg8::Epi4 E{F.in[0], WSP(bf16, WS_X1B), WSP(float, WS_SS8)};
        for (int rep = 0; rep < NREP(8); ++rep) pg8::gemm_phase<pg8::Epi4, pg8::SchedPlain, false, true>(F.lds, DM, S, E);
        if (BOTH(6)) GRID_BAR();
    }
    if (IN(7)) {
        pg8::SchedPlain S; S.tm.init(TOK, 2 * DFF, WGM_P5); S.G = G; S.c = (int)blockIdx.x; S.A = (const char*)WSP(bf16, WS_X1B); S.B = (const char*)WSP(bf16, WS_WFIT); S.tstep = (size_t)256 * DM * 2;
        pg8::Epi5 E{WSP(float, WS_SS8), WSP(bf16, WS_ACT)};
        { const int nfull = S.tm.nwg % G;
          if (nfull > 0 && (int)blockIdx.x >= nfull) p5_tail_convert(F, nfull, G - nfull); else if (nfull == 0) p5_tail_convert(F, 0, G); }
        for (int rep = 0; rep < NREP(9); ++rep) pg8::gemm_phase<pg8::Epi5, pg8::SchedPlain, true, true>(F.lds, DM, S, E);
        if (BOTH(7)) GRID_BAR();
    }
    if (IN(8)) {
        pg8::SchedPlain S; S.tm.init(TOK, DM, WGM_P6); S.G = G; S.c = (int)blockIdx.x; S.A = (const char*)WSP(bf16, WS_ACT); S.B = (const char*)WSP(bf16, WS_WFDT); S.tstep = (size_t)256 * DFF * 2;
        pg8::Epi6 E{WSP(bf16, WS_X1B), F.out};
        pg8::gemm_phase<pg8::Epi6, pg8::SchedPlain, true, true>(F.lds, DFF, S, E);
    }
#undef IN
#undef BOTH
}

extern "C" void kernel_launch(void* const* d_in, const int* in_sizes, int n_in, void* d_out, int out_size, void* d_ws, size_t ws_size, hipStream_t stream) {
    static int grid = 0;
    if (grid == 0) {
        if (n_in != 25 || in_sizes[0] != TOK * DM || out_size != TOK * DM || ws_size < WS_END) {
            fprintf(stderr, "kernel_launch: unexpected problem: n_in %d in0 %d out %d ws %zu (need %zu)\n", n_in, n_in > 0 ? in_sizes[0] : -1, out_size, ws_size, (size_t)WS_END); grid = -1; return; }
        int dev = 0, cus = 0, per_cu = 0;
        if (hipGetDevice(&dev) != hipSuccess || hipDeviceGetAttribute(&cus, hipDeviceAttributeMultiprocessorCount, dev) != hipSuccess) { grid = -1; return; }
        if (hipFuncSetAttribute((const void*)mk_fwd, hipFuncAttributeMaxDynamicSharedMemorySize, LDS_BYTES) != hipSuccess) { fprintf(stderr, "kernel_launch: hipFuncSetAttribute failed\n"); grid = -1; return; }
        if (hipOccupancyMaxActiveBlocksPerMultiprocessor(&per_cu, (const void*)mk_fwd, NWAVES * 64, LDS_BYTES) != hipSuccess || per_cu < 1) { fprintf(stderr, "kernel_launch: occupancy query says %d\n", per_cu); per_cu = 1; }
        (void)hipGetLastError();
        grid = cus;
        if (grid != 256) fprintf(stderr, "kernel_launch: note: %d CUs (P4's epilogue expects 256 workgroups)\n", grid);
    }
    if (grid < 0) return;
    (void)hipMemsetAsync((char*)d_ws + WS_CTL, 0, CTL_ZERO_BYTES, stream);
    Args a{};
    for (int i = 0; i < 25; ++i) a.in[i] = (const float*)d_in[i];
    a.out = (float*)d_out; a.ws = (unsigned char*)d_ws;
    if (MK_N_LAUNCHES == 1) {
        a.ph_lo = 0; a.ph_hi = N_PHASES; a.li = 0;
        hipLaunchKernelGGL(mk_fwd, dim3(grid), dim3(NWAVES * 64), LDS_BYTES, stream, a);
    } else {
        for (int li = 0; li < N_PHASES; ++li) { a.ph_lo = li; a.ph_hi = li + 1; a.li = li; hipLaunchKernelGGL(mk_fwd, dim3(grid), dim3(NWAVES * 64), LDS_BYTES, stream, a); }
    }
}
```

```cpp
#include <hip/hip_runtime.h>
#include <cstdio>
#include <cstdint>

#ifndef MK_N_LAUNCHES
#define MK_N_LAUNCHES 1
#endif

#define WGM_P1 3
#define WGM_P3 3
#define WGM_P4 3
#define WGM_P5 3
#define WGM_P6 3
#define LAS __attribute__((address_space(3)))
#define GAS __attribute__((address_space(1)))
typedef unsigned short bf16;
typedef short bf16x8 __attribute__((ext_vector_type(8)));
typedef short s16x4 __attribute__((ext_vector_type(4)));
typedef float f32x2 __attribute__((ext_vector_type(2)));
typedef float f32x4 __attribute__((ext_vector_type(4)));
typedef float f32x16 __attribute__((ext_vector_type(16)));
typedef unsigned u32x2 __attribute__((ext_vector_type(2)));
typedef unsigned u32x4 __attribute__((ext_vector_type(4)));
typedef __bf16 bf16x2_t __attribute__((ext_vector_type(2)));
typedef GAS unsigned gu32;

constexpr int BATCH = 2, SEQ = 4096, DM = 2048, TOK = BATCH * SEQ;
constexpr int NMEM = 256, MEMROWS = BATCH * NMEM;
constexpr int DFF = 5632;
constexpr int NZ = 7680;
constexpr int NGT = 6144;
constexpr int N1 = NZ + NGT;
constexpr int ZQ_GLA = 0, ZK_GLA = 512, ZV_GLA = 1024, ZG_GLA = 2048, ZQ_DIFF = 3072, ZK_DIFF = 4096, ZV_DIFF = 5120, ZQ_MEM = 6144, ZA_GLA = 7168;
constexpr int WIN_LD = 7184;
constexpr float NORM_EPS = 1e-6f;
constexpr float LAM_INIT = 0.2f;
constexpr float LOG2E = 1.4426950408889634f;

constexpr size_t MiB = 1u << 20;
constexpr size_t WS_CTL = 0, CTL_ZERO_BYTES = 32768;
constexpr size_t WS_RINVX = 1 * MiB;
constexpr size_t WS_RINVM = WS_RINVX + 32768;
constexpr size_t WS_SC = WS_RINVM + 4096;
constexpr size_t WS_SS8 = WS_SC + 4096;
constexpr size_t WS_DEC = WS_SS8 + 262144;
static_assert(WS_DEC + 262144 <= 2 * MiB, "small region");
constexpr size_t WS_WOT = 2 * MiB;
constexpr size_t WS_WBT = 10 * MiB;
constexpr size_t WS_KVM = 22 * MiB;
constexpr size_t WS_RA = 24 * MiB;
constexpr size_t WS_W1T = WS_RA;
constexpr size_t WS_WG8 = WS_RA + 30 * MiB;
constexpr size_t WS_XQ = WS_RA + 42 * MiB;
constexpr size_t WS_YMEM = WS_RA + 44 * MiB;
constexpr size_t OUT_XB = 32 * MiB;
constexpr size_t WS_WKVT = WS_RA + 90 * MiB;
constexpr size_t WS_MEMB = WS_RA + 98 * MiB;
constexpr size_t WS_WFIT = WS_RA;
constexpr size_t WS_WFDT = WS_RA + 44 * MiB;
constexpr size_t WS_SB = WS_RA + 66 * MiB;
constexpr size_t WS_RZ = 128 * MiB;
constexpr size_t WS_Z = WS_RZ;
constexpr size_t WS_PART = WS_RZ;
constexpr size_t WS_MERGED = WS_RZ + 64 * MiB;
constexpr size_t WS_ACT = WS_RZ;
constexpr size_t WS_RG = 248 * MiB;
constexpr size_t WS_GATES = WS_RG;
constexpr size_t WS_X1B = WS_RG;
constexpr size_t WS_END = 344 * MiB;
constexpr int CW_TMO = 0, CW_BAR = 4096;

constexpr int RING_BYTES = 131072;
constexpr int LDS_BYTES = 163840;
constexpr int LDSCTL_OFF = LDS_BYTES - 1024, MISC_OFF = LDSCTL_OFF + 320;
constexpr int NWAVES = 8;

#define LDS_WAIT() asm volatile("s_waitcnt lgkmcnt(0)" ::: "memory")
#define VM_WAIT() asm volatile("s_waitcnt vmcnt(0)" ::: "memory")
#define RLX_AGENT __ATOMIC_RELAXED, __HIP_MEMORY_SCOPE_AGENT
__device__ __forceinline__ unsigned pk2(float lo, float hi) { f32x2 v = {lo, hi}; bf16x2_t b = __builtin_convertvector(v, bf16x2_t); return __builtin_bit_cast(unsigned, b); }
__device__ __forceinline__ float bflo(unsigned u) { return __uint_as_float(u << 16); }
__device__ __forceinline__ float bfhi(unsigned u) { return __uint_as_float(u & 0xffff0000u); }
__device__ __forceinline__ float bf1(bf16 v) { return __uint_as_float((unsigned)v << 16); }
__device__ __forceinline__ float fexp2(float x) { return __builtin_amdgcn_exp2f(x); }
__device__ __forceinline__ float fexp(float x) { return __builtin_amdgcn_exp2f(x * LOG2E); }
__device__ __forceinline__ float flog(float x) { return __builtin_amdgcn_logf(x) * 0.6931471805599453f; }
__device__ __forceinline__ float frcp(float x) { return __builtin_amdgcn_rcpf(x); }
__device__ __forceinline__ float frsq(float x) { return __builtin_amdgcn_rsqf(x); }
__device__ __forceinline__ float sigmoidf_(float x) { return frcp(1.0f + fexp(-x)); }
__device__ __forceinline__ float logsigmoidf_(float x) { return fminf(x, 0.f) - flog(1.0f + fexp(-fabsf(x))); }
__device__ __forceinline__ float wave_sum(float v) {
#pragma unroll
    for (int o = 1; o < 64; o <<= 1) v += __shfl_xor(v, o);
    return v;
}
__device__ __forceinline__ float wave_max(float v) {
#pragma unroll
    for (int o = 1; o < 64; o <<= 1) v = fmaxf(v, __shfl_xor(v, o));
    return v;
}
typedef short v4i16_t __attribute__((ext_vector_type(4)));
__device__ __forceinline__ s16x4 ldtr(LAS const unsigned char* p) { return __builtin_bit_cast(s16x4, __builtin_amdgcn_ds_read_tr16_b64_v4i16((LAS v4i16_t*)p)); }
__device__ __forceinline__ bf16x8 trfrag(LAS const unsigned char* p, int four_rows) {
    const s16x4 lo = ldtr(p), hi = ldtr(p + four_rows);
    return (bf16x8){lo[0], lo[1], lo[2], lo[3], hi[0], hi[1], hi[2], hi[3]};
}
__device__ __forceinline__ int crow(int r, int hi) { return (r & 3) + 8 * (r >> 2) + 4 * hi; }
#define MFMA32(a, b, c) __builtin_amdgcn_mfma_f32_32x32x16_bf16((a), (b), (c), 0, 0, 0)

namespace pg8 {
constexpr int BM = 256, BK = 64, HALF = 128, HTB = HALF * BK * 2, STAGE_BYTES = 8 * HTB, NXCD = 8, WGM = 8;
__host__ __device__ __forceinline__ int lds_byte(int r, int c) { const int st = (r >> 4) * 2 + (c >> 5), rr = r & 15, cc = c & 31, ob = rr * 64 + cc * 2; return st * 1024 + (ob ^ (((ob >> 9) & 1) << 5)); }
__host__ __device__ __forceinline__ void stage_rc(int b, int& R, int& C) { const int st = b / 1024, sb = b % 1024, swz = sb ^ (((sb >> 9) & 1) << 5); R = (st >> 1) * 16 + swz / 64; C = (st & 1) * 32 + (swz % 64) / 2; }
__host__ __device__ __forceinline__ int perm32(int rho) { const int n = rho >> 4, i = rho & 15; return 8 * (i >> 2) + 4 * n + (i & 3); }

struct Unit { int pm, pn, sub; };
struct TileMap {
    int nM, nN, nwg, wgm;
    __device__ __forceinline__ void init(int M, int N, int wgm_) { nM = M / BM; nN = N / BM; nwg = nM * nN; wgm = wgm_; }
    __device__ __forceinline__ void map(int L, int& pm, int& pn) const {
        int wgid = L; { const int q = nwg / NXCD, r = nwg % NXCD, xcd = wgid % NXCD, off = wgid / NXCD; wgid = (xcd < r ? xcd * (q + 1) : r * (q + 1) + (xcd - r) * q) + off; }
        const int nig = wgm * nN, gid = wgid / nig, fm = gid * wgm, gsz = (nM - fm) < wgm ? (nM - fm) : wgm;
        pm = fm + ((wgid % nig) % gsz); pn = (wgid % nig) / gsz;
    }
};
struct SchedPlain {
    TileMap tm; int G, c; const char* A; const char* B; size_t tstep;
    __device__ __forceinline__ bool next(int i, Unit& u) const { const long L = (long)i * G + c; if (L >= tm.nwg) return false; tm.map((int)L, u.pm, u.pn); u.sub = 0; return true; }
    __device__ __forceinline__ const char* aptr(const Unit& u) const { return A + (size_t)u.pm * tstep; }
    __device__ __forceinline__ const char* bptr(const Unit& u) const { return B + (size_t)u.pn * tstep; }
};
struct SchedP1 {
    TileMap tm; int G, c; const char* A; const char* B; const char* A2; const char* B2; size_t tstep;
    __device__ __forceinline__ bool next(int i, Unit& u) const {
        long L = (long)i * G + c; if (L < tm.nwg) { tm.map((int)L, u.pm, u.pn); u.sub = 0; return true; }
        L -= tm.nwg; if (L < 16) { u.pm = (int)(L & 1); u.pn = (int)(L >> 1); u.sub = 1; return true; } return false; }
    __device__ __forceinline__ const char* aptr(const Unit& u) const { return (u.sub ? A2 : A) + (size_t)u.pm * tstep; }
    __device__ __forceinline__ const char* bptr(const Unit& u) const { return (u.sub ? B2 : B) + (size_t)u.pn * tstep; }
};
struct SchedP3 {
    TileMap tm; int G, c; const char* A; const char* A2; const char* B; size_t tstep, astride, bstride;
    __device__ __forceinline__ bool next(int i, Unit& u) const { const int t = i / 3; const long L = (long)t * G + c; if (L >= tm.nwg) return false; tm.map((int)L, u.pm, u.pn); u.sub = i - 3 * t; return true; }
    __device__ __forceinline__ const char* aptr(const Unit& u) const { return (u.sub == 2 ? A2 : A + (size_t)u.sub * astride) + (size_t)u.pm * tstep; }
    __device__ __forceinline__ const char* bptr(const Unit& u) const { return B + (size_t)u.sub * bstride + (size_t)u.pn * tstep; }
};

typedef f32x4 Acc[2][2][4][2];

struct Epi1 {
    static constexpr bool PERM = true, AFTER_DRAIN = false;
    bf16* Z; bf16* GT; bf16* KVM; const float* rinvx; const float* rinvm; const float* b_alpha; const float* b_gate;
    __device__ __forceinline__ void operator()(const Acc& acc, const Unit& u, int wr, int wc, int fr, int fq) const {
        const int row0 = u.pm * BM + wr * 64 + fr; const int colt = u.pn * BM + wc * 32 + 8 * fq;
        int kind; bf16* base; int ld; const float* bias = nullptr; const float* rv = rinvx;
        if (u.sub) { kind = 0; base = KVM + colt; ld = 2048; rv = rinvm; }
        else if (u.pn < 28) { kind = 0; base = Z + colt; ld = NZ; }
        else if (u.pn < 30) { kind = 1; base = Z + colt; ld = NZ; bias = b_alpha + (colt - ZA_GLA); }
        else { kind = 2; base = GT + (colt - NZ); ld = NGT; bias = b_gate + (colt - NZ); }
        f32x4 bv[2][2];
#pragma unroll
        for (int bj = 0; bj < 2; ++bj)
#pragma unroll
            for (int n = 0; n < 2; ++n) bv[bj][n] = bias ? *(const f32x4*)(bias + bj * HALF + 4 * n) : (f32x4){0.f, 0.f, 0.f, 0.f};
        float rsv[2][4];
#pragma unroll
        for (int ai = 0; ai < 2; ++ai)
#pragma unroll
            for (int m = 0; m < 4; ++m) rsv[ai][m] = rv[row0 + ai * HALF + m * 16];
#pragma unroll
        for (int ai = 0; ai < 2; ++ai)
#pragma unroll
            for (int m = 0; m < 4; ++m) { const int row = row0 + ai * HALF + m * 16; const float rs = rsv[ai][m]; bf16* rowp = base + (size_t)row * ld;
#pragma unroll
                for (int bj = 0; bj < 2; ++bj) { f32x4 v0 = acc[ai][bj][m][0] * rs + bv[bj][0], v1 = acc[ai][bj][m][1] * rs + bv[bj][1];
                    if (kind == 1) {
#pragma unroll
                        for (int e = 0; e < 4; ++e) { v0[e] = logsigmoidf_(v0[e]) * 0.0625f; v1[e] = logsigmoidf_(v1[e]) * 0.0625f; } }
                    else if (kind == 2) {
#pragma unroll
                        for (int e = 0; e < 4; ++e) { v0[e] = sigmoidf_(v0[e]); v1[e] = sigmoidf_(v1[e]); } }
                    u32x4 w; w.x = pk2(v0[0], v0[1]); w.y = pk2(v0[2], v0[3]); w.z = pk2(v1[0], v1[1]); w.w = pk2(v1[2], v1[3]);
                    *(u32x4*)(rowp + bj * HALF) = w; } }
    }
};
struct EpiG {
    static constexpr bool PERM = true, AFTER_DRAIN = false;
    bf16* GT; const float* rinvx; const float* b_gate;
    __device__ __forceinline__ void operator()(const Acc& acc, const Unit& u, int wr, int wc, int fr, int fq) const {
        const int row0 = u.pm * BM + wr * 64 + fr; const int colt = u.pn * BM + wc * 32 + 8 * fq;
        f32x4 bv[2][2];
#pragma unroll
        for (int bj = 0; bj < 2; ++bj)
#pragma unroll
            for (int n = 0; n < 2; ++n) bv[bj][n] = *(const f32x4*)(b_gate + colt + bj * HALF + 4 * n);
        float rsv[2][4];
#pragma unroll
        for (int ai = 0; ai < 2; ++ai)
#pragma unroll
            for (int m = 0; m < 4; ++m) rsv[ai][m] = rinvx[row0 + ai * HALF + m * 16] * (1.0f / 512.0f);
#pragma unroll
        for (int ai = 0; ai < 2; ++ai)
#pragma unroll
            for (int m = 0; m < 4; ++m) { const int row = row0 + ai * HALF + m * 16; const float rs = rsv[ai][m]; bf16* rowp = GT + (size_t)row * NGT + colt;
#pragma unroll
                for (int bj = 0; bj < 2; ++bj) { f32x4 v0 = acc[ai][bj][m][0] * rs + bv[bj][0], v1 = acc[ai][bj][m][1] * rs + bv[bj][1];
#pragma unroll
                    for (int e = 0; e < 4; ++e) { v0[e] = sigmoidf_(v0[e]); v1[e] = sigmoidf_(v1[e]); }
                    u32x4 w; w.x = pk2(v0[0], v0[1]); w.y = pk2(v0[2], v0[3]); w.z = pk2(v1[0], v1[1]); w.w = pk2(v1[2], v1[3]);
                    *(u32x4*)(rowp + bj * HALF) = w; } }
    }
};
struct Epi3 {
    static constexpr bool PERM = true, AFTER_DRAIN = false;
    const bf16* GT; bf16* MERGED;
    __device__ __forceinline__ void operator()(const Acc& acc, const Unit& u, int wr, int wc, int fr, int fq) const {
        const int row0 = u.pm * BM + wr * 64 + fr; const int col0 = u.pn * BM + wc * 32 + 8 * fq;
#pragma unroll
        for (int ai = 0; ai < 2; ++ai) {
            u32x4 g[4][2], p[4][2];
#pragma unroll
            for (int m = 0; m < 4; ++m)
#pragma unroll
                for (int bj = 0; bj < 2; ++bj) { const int row = row0 + ai * HALF + m * 16, col = col0 + bj * HALF;
                    g[m][bj] = *(const u32x4*)(GT + (size_t)row * NGT + u.sub * DM + col);
                    if (u.sub > 0) p[m][bj] = *(const u32x4*)(MERGED + (size_t)row * DM + col); else p[m][bj] = (u32x4){0u, 0u, 0u, 0u}; }
#pragma unroll
            for (int m = 0; m < 4; ++m)
#pragma unroll
                for (int bj = 0; bj < 2; ++bj) { const int row = row0 + ai * HALF + m * 16, col = col0 + bj * HALF; const u32x4 gg = g[m][bj], pp = p[m][bj];
                    const f32x4 a0 = acc[ai][bj][m][0], a1 = acc[ai][bj][m][1];
                    u32x4 w;
                    w.x = pk2(a0[0] * bflo(gg.x) + bflo(pp.x), a0[1] * bfhi(gg.x) + bfhi(pp.x)); w.y = pk2(a0[2] * bflo(gg.y) + bflo(pp.y), a0[3] * bfhi(gg.y) + bfhi(pp.y));
                    w.z = pk2(a1[0] * bflo(gg.z) + bflo(pp.z), a1[1] * bfhi(gg.z) + bfhi(pp.z)); w.w = pk2(a1[2] * bflo(gg.w) + bflo(pp.w), a1[3] * bfhi(gg.w) + bfhi(pp.w));
                    *(u32x4*)(MERGED + (size_t)row * DM + col) = w; }
            asm volatile("" ::: "memory");
        }
    }
};
struct Epi4 {
    static constexpr bool PERM = true, AFTER_DRAIN = true;
    const bf16* X; bf16* X1B; float* SS8;
    __device__ __forceinline__ void fused(Acc& acc, const Unit& u, int wr, int wc, int fr, int fq, LAS unsigned char* lds, int wid, int lane) const {
        LAS float* P = (LAS float*)lds;
        const int row0 = u.pm * BM + wr * 64 + fr; const int col0 = u.pn * BM + wc * 32 + 8 * fq;
#pragma unroll
        for (int ai = 0; ai < 2; ++ai)
#pragma unroll
            for (int mp = 0; mp < 2; ++mp) {
                u32x4 xr[2][2];
#pragma unroll
                for (int mm = 0; mm < 2; ++mm)
#pragma unroll
                    for (int bj = 0; bj < 2; ++bj) { const size_t off = (size_t)(row0 + ai * HALF + (2 * mp + mm) * 16) * DM + col0 + bj * HALF; xr[mm][bj] = *(const u32x4*)(X + off); }
#pragma unroll
                for (int mm = 0; mm < 2; ++mm) { const int m = 2 * mp + mm; float s = 0.f;
#pragma unroll
                    for (int bj = 0; bj < 2; ++bj) { const size_t off = (size_t)(row0 + ai * HALF + m * 16) * DM + col0 + bj * HALF;
                        const u32x4 x = xr[mm][bj];
                        const f32x4 v0 = acc[ai][bj][m][0] + (f32x4){bflo(x.x), bfhi(x.x), bflo(x.y), bfhi(x.y)}, v1 = acc[ai][bj][m][1] + (f32x4){bflo(x.z), bfhi(x.z), bflo(x.w), bfhi(x.w)};
                        u32x4 w; w.x = pk2(v0[0], v0[1]); w.y = pk2(v0[2], v0[3]); w.z = pk2(v1[0], v1[1]); w.w = pk2(v1[2], v1[3]); *(u32x4*)(X1B + off) = w;
                        s += (v0[0] * v0[0] + v0[1] * v0[1]) + (v0[2] * v0[2] + v0[3] * v0[3]) + (v1[0] * v1[0] + v1[1] * v1[1]) + (v1[2] * v1[2] + v1[3] * v1[3]); }
                    s += __shfl_xor(s, 16); s += __shfl_xor(s, 32);
                    if (fq == 0) P[(ai * HALF + wr * 64 + m * 16 + fr) * 4 + wc] = s; }
                asm volatile("" ::: "memory");
            }
        LDS_WAIT(); __builtin_amdgcn_s_barrier(); asm volatile("" ::: "memory");
        const int t = wid * 64 + lane;
        if (t < 256) { const float s = (P[t * 4 + 0] + P[t * 4 + 1]) + (P[t * 4 + 2] + P[t * 4 + 3]); SS8[(size_t)(u.pm * BM + t) * 8 + u.pn] = s; }
    }
};
struct Epi5 {
    static constexpr bool PERM = true, AFTER_DRAIN = false;
    const float* SS8; bf16* ACT;
    __device__ __forceinline__ void operator()(const Acc& acc, const Unit& u, int wr, int wc, int fr, int fq) const {
        const int row0 = u.pm * BM + wr * 64 + fr; const int col0 = u.pn * HALF + wc * 32 + 8 * fq;
        float rsv[2][4];
#pragma unroll
        for (int ai = 0; ai < 2; ++ai)
#pragma unroll
            for (int m = 0; m < 4; ++m) { const int row = row0 + ai * HALF + m * 16;
                const f32x4 s0 = *(const f32x4*)(SS8 + (size_t)row * 8), s1 = *(const f32x4*)(SS8 + (size_t)row * 8 + 4);
                const float ss = ((s0[0] + s0[1]) + (s0[2] + s0[3])) + ((s1[0] + s1[1]) + (s1[2] + s1[3]));
                rsv[ai][m] = frsq(ss * (1.0f / DM) + NORM_EPS); }
#pragma unroll
        for (int ai = 0; ai < 2; ++ai)
#pragma unroll
            for (int m = 0; m < 4; ++m) { const int row = row0 + ai * HALF + m * 16; const float rs = rsv[ai][m];
                float o[8];
#pragma unroll
                for (int n = 0; n < 2; ++n)
#pragma unroll
                    for (int e = 0; e < 4; ++e) { const float g = acc[ai][0][m][n][e] * rs, up = acc[ai][1][m][n][e] * rs; o[4 * n + e] = g * sigmoidf_(g) * up; }
                u32x4 w; w.x = pk2(o[0], o[1]); w.y = pk2(o[2], o[3]); w.z = pk2(o[4], o[5]); w.w = pk2(o[6], o[7]);
                *(u32x4*)(ACT + (size_t)row * DFF + col0) = w; }
    }
};
struct Epi6 {
    static constexpr bool PERM = true, AFTER_DRAIN = false;
    const bf16* X1B; float* OUT;
    __device__ __forceinline__ void operator()(const Acc& acc, const Unit& u, int wr, int wc, int fr, int fq) const {
        const int row0 = u.pm * BM + wr * 64 + fr; const int col0 = u.pn * BM + wc * 32 + 8 * fq;
#pragma unroll
        for (int ai = 0; ai < 2; ++ai) {
            u32x4 xr[4][2];
#pragma unroll
            for (int m = 0; m < 4; ++m)
#pragma unroll
                for (int bj = 0; bj < 2; ++bj) xr[m][bj] = *(const u32x4*)(X1B + (size_t)(row0 + ai * HALF + m * 16) * DM + col0 + bj * HALF);
#pragma unroll
            for (int m = 0; m < 4; ++m)
#pragma unroll
                for (int bj = 0; bj < 2; ++bj) { float* p = OUT + (size_t)(row0 + ai * HALF + m * 16) * DM + col0 + bj * HALF; const u32x4 x = xr[m][bj];
                    *(f32x4*)p = (f32x4){bflo(x.x), bfhi(x.x), bflo(x.y), bfhi(x.y)} + acc[ai][bj][m][0]; *(f32x4*)(p + 4) = (f32x4){bflo(x.z), bfhi(x.z), bflo(x.w), bfhi(x.w)} + acc[ai][bj][m][1]; }
            asm volatile("" ::: "memory");
        }
    }
};

template <class Epi, class Sched, bool ALIGN_EPI, bool SP2>
__device__ __forceinline__ void gemm_phase(LAS unsigned char* lds, const int K, const Sched& S, const Epi& E) {
    const int tid = threadIdx.x, wid = __builtin_amdgcn_readfirstlane(tid >> 6), lane = tid & 63, wr = wid >> 2, wc = wid & 3, fr = lane & 15, fq = lane >> 4;
    const int nt = K / BK;
    unsigned voffA[2], voffB[2];
#pragma unroll
    for (int i = 0; i < 2; ++i) { int R, C; stage_rc(tid * 16 + i * 8192, R, C); const int Rb = Epi::PERM ? ((R & ~31) + perm32(R & 31)) : R;
        voffA[i] = (unsigned)(R * K + C) * 2u; voffB[i] = (unsigned)(Rb * K + C) * 2u; }
    const size_t kstep = (size_t)(BK * 2);
    const size_t hstep = (size_t)HALF * K * 2;
    const unsigned ldsw = (unsigned)wid * 1024u;
    const int aoff = lds_byte(wr * 64 + fr, fq * 8), boff = lds_byte(wc * 32 + fr, fq * 8);
#define PG8_SA(b, h) (((b) * 2 + (h)) * HTB)
#define PG8_SB(b, h) ((4 + (b) * 2 + (h)) * HTB)
#define PG8_STAGE(bufoff, gbase, voff) do { _Pragma("unroll") for (int _i = 0; _i < 2; ++_i) \
        __builtin_amdgcn_global_load_lds((const unsigned*)((const char*)(gbase) + (voff)[_i]), (LAS unsigned*)(lds + (bufoff) + ldsw + _i * 8192), 16, 0, 0); } while (0)
#define PG8_LDA(dst, b, h) do { _Pragma("unroll") for (int m = 0; m < 4; ++m) _Pragma("unroll") for (int k = 0; k < 2; ++k) dst[m][k] = *(const LAS bf16x8*)(lds + PG8_SA(b, h) + aoff + m * 2048 + k * 1024); } while (0)
#define PG8_LDB(dst, b, h) do { _Pragma("unroll") for (int n = 0; n < 2; ++n) _Pragma("unroll") for (int k = 0; k < 2; ++k) dst[n][k] = *(const LAS bf16x8*)(lds + PG8_SB(b, h) + boff + n * 2048 + k * 1024); } while (0)
#define PG8_MMA(ai, bj, At, Bt) do { __builtin_amdgcn_s_setprio(1); _Pragma("unroll") for (int m = 0; m < 4; ++m) _Pragma("unroll") for (int n = 0; n < 2; ++n) _Pragma("unroll") for (int k = 0; k < 2; ++k) \
        acc[ai][bj][m][n] = __builtin_amdgcn_mfma_f32_16x16x32_bf16(Bt[n][k], At[m][k], acc[ai][bj][m][n], 0, 0, 0); __builtin_amdgcn_s_setprio(0); } while (0)
#define PG8_WAIT_V(n) asm volatile("s_waitcnt vmcnt(" #n ")" ::: "memory")
#define PG8_WAIT_L(n) asm volatile("s_waitcnt lgkmcnt(" #n ")" ::: "memory")
#define PG8_BAR __builtin_amdgcn_s_barrier()
#define PG8_SCHED __builtin_amdgcn_sched_barrier(0)
    Unit cur, nxt; int ui = 0;
    if (!S.next(0, cur)) return;
    Acc acc;
#pragma unroll
    for (int a = 0; a < 2; ++a)
#pragma unroll
        for (int b = 0; b < 2; ++b)
#pragma unroll
            for (int m = 0; m < 4; ++m)
#pragma unroll
                for (int n = 0; n < 2; ++n) acc[a][b][m][n] = (f32x4){0.f, 0.f, 0.f, 0.f};
    bf16x8 At[4][2], B0[2][2], B1[2][2];
    const char* cA = S.aptr(cur); const char* cB = S.bptr(cur);
    if constexpr (SP2) {
        PG8_STAGE(PG8_SB(0, 0), cB, voffB); PG8_STAGE(PG8_SB(0, 1), cB + hstep, voffB); PG8_STAGE(PG8_SA(0, 0), cA, voffA); PG8_STAGE(PG8_SA(0, 1), cA + hstep, voffA);
        if (wr == 1) PG8_BAR;
        PG8_WAIT_V(2); PG8_BAR;
        PG8_STAGE(PG8_SB(1, 0), cB + kstep, voffB); PG8_STAGE(PG8_SA(1, 0), cA + kstep, voffA); PG8_STAGE(PG8_SB(1, 1), cB + hstep + kstep, voffB);
        PG8_WAIT_V(6); PG8_BAR;
    } else {
        PG8_STAGE(PG8_SB(0, 0), cB, voffB); PG8_STAGE(PG8_SA(0, 0), cA, voffA); PG8_STAGE(PG8_SB(0, 1), cB + hstep, voffB); PG8_STAGE(PG8_SA(0, 1), cA + hstep, voffA);
        if (wr == 1) PG8_BAR;
        PG8_WAIT_V(4); PG8_BAR;
        PG8_STAGE(PG8_SB(1, 0), cB + kstep, voffB); PG8_STAGE(PG8_SA(1, 0), cA + kstep, voffA); PG8_STAGE(PG8_SB(1, 1), cB + hstep + kstep, voffB);
        PG8_WAIT_V(6); PG8_BAR;
    }
    for (;;) {
        const bool has_next = S.next(ui + 1, nxt);
        const char* nA = has_next ? S.aptr(nxt) : cA; const char* nB = has_next ? S.bptr(nxt) : cB;
        for (int t = 0; t < nt; t += 2) {
            const bool last = (t == nt - 2);
            const char* a1 = cA + (size_t)(t + 1) * kstep;
            const char* a2 = last ? nA : cA + (size_t)(t + 2) * kstep; const char* b2 = last ? nB : cB + (size_t)(t + 2) * kstep;
            const char* a3 = a2 + kstep; const char* b3 = b2 + kstep;
            if constexpr (SP2) {
            PG8_LDB(B0, 0, 0); PG8_LDB(B1, 0, 1); PG8_SCHED; PG8_LDA(At, 0, 0); PG8_STAGE(PG8_SA(1, 1), a1 + hstep, voffA);
            PG8_WAIT_V(8); PG8_WAIT_L(0); PG8_BAR; PG8_MMA(0, 0, At, B0); PG8_MMA(0, 1, At, B1); PG8_BAR; PG8_SCHED;
            PG8_LDA(At, 0, 1); PG8_STAGE(PG8_SB(0, 0), b2, voffB); PG8_STAGE(PG8_SB(0, 1), b2 + hstep, voffB); PG8_STAGE(PG8_SA(0, 0), a2, voffA);
            PG8_WAIT_V(8); PG8_WAIT_L(0); PG8_BAR; PG8_MMA(1, 0, At, B0); PG8_MMA(1, 1, At, B1); PG8_BAR; PG8_SCHED;
            PG8_LDB(B0, 1, 0); PG8_LDB(B1, 1, 1); PG8_SCHED; PG8_LDA(At, 1, 0); PG8_STAGE(PG8_SA(0, 1), a2 + hstep, voffA);
            PG8_WAIT_V(8); PG8_WAIT_L(0); PG8_BAR; PG8_MMA(0, 0, At, B0); PG8_MMA(0, 1, At, B1); PG8_BAR; PG8_SCHED;
            PG8_LDA(At, 1, 1); PG8_STAGE(PG8_SB(1, 0), b3, voffB); PG8_STAGE(PG8_SB(1, 1), b3 + hstep, voffB); PG8_STAGE(PG8_SA(1, 0), a3, voffA);
            PG8_WAIT_V(8); PG8_WAIT_L(0); PG8_BAR; PG8_MMA(1, 0, At, B0); PG8_MMA(1, 1, At, B1); PG8_BAR; PG8_SCHED;
            } else {
            PG8_LDB(B0, 0, 0); PG8_SCHED; PG8_LDA(At, 0, 0); PG8_STAGE(PG8_SA(1, 1), a1 + hstep, voffA);
            PG8_WAIT_L(8); PG8_BAR; PG8_WAIT_L(0); PG8_MMA(0, 0, At, B0); PG8_BAR; PG8_SCHED;
            PG8_LDB(B1, 0, 1); PG8_STAGE(PG8_SB(0, 0), b2, voffB);
            PG8_BAR; PG8_WAIT_L(0); PG8_MMA(0, 1, At, B1); PG8_BAR;
            PG8_LDA(At, 0, 1); PG8_STAGE(PG8_SA(0, 0), a2, voffA);
            PG8_BAR; PG8_WAIT_L(0); PG8_MMA(1, 0, At, B0); PG8_BAR; PG8_SCHED;
            PG8_STAGE(PG8_SB(0, 1), b2 + hstep, voffB);
            PG8_WAIT_V(6); PG8_BAR; PG8_MMA(1, 1, At, B1); PG8_BAR;
            PG8_LDB(B0, 1, 0); PG8_SCHED; PG8_LDA(At, 1, 0); PG8_STAGE(PG8_SA(0, 1), a2 + hstep, voffA);
            PG8_WAIT_L(8); PG8_BAR; PG8_WAIT_L(0); PG8_MMA(0, 0, At, B0); PG8_BAR; PG8_SCHED;
            PG8_LDB(B1, 1, 1); PG8_STAGE(PG8_SB(1, 0), b3, voffB);
            PG8_BAR; PG8_WAIT_L(0); PG8_MMA(0, 1, At, B1); PG8_BAR;
            PG8_LDA(At, 1, 1); PG8_STAGE(PG8_SA(1, 0), a3, voffA);
            PG8_BAR; PG8_WAIT_L(0); PG8_MMA(1, 0, At, B0); PG8_BAR; PG8_SCHED;
            PG8_STAGE(PG8_SB(1, 1), b3 + hstep, voffB);
            PG8_WAIT_V(6); PG8_BAR; PG8_MMA(1, 1, At, B1); PG8_BAR;
            }
        }
        if constexpr (ALIGN_EPI) { if (wr == 0) PG8_BAR; }
        if constexpr (!Epi::AFTER_DRAIN) { E(acc, cur, wr, wc, fr, fq); }
        if (!has_next) break;
#pragma unroll
        for (int a = 0; a < 2; ++a)
#pragma unroll
            for (int b = 0; b < 2; ++b)
#pragma unroll
                for (int m = 0; m < 4; ++m)
#pragma unroll
                    for (int n = 0; n < 2; ++n) acc[a][b][m][n] = (f32x4){0.f, 0.f, 0.f, 0.f};
        cur = nxt; cA = nA; cB = nB; ++ui;
        if constexpr (ALIGN_EPI) { if (wr == 1) PG8_BAR; }
    }
    PG8_WAIT_V(0);
    if constexpr (!ALIGN_EPI) { if (wr == 0) PG8_BAR; }
    PG8_BAR;
    if constexpr (Epi::AFTER_DRAIN) { E.fused(acc, cur, wr, wc, fr, fq, lds, wid, lane); }
#undef PG8_SA
#undef PG8_SB
#undef PG8_STAGE
#undef PG8_LDA
#undef PG8_LDB
#undef PG8_MMA
#undef PG8_WAIT_V
#undef PG8_WAIT_L
#undef PG8_BAR
#undef PG8_SCHED
}
typedef int v8i_t __attribute__((ext_vector_type(8)));
typedef int v4i_t __attribute__((ext_vector_type(4)));
template <class Epi, class Sched, bool ALIGN_EPI, bool SP2>
__device__ __forceinline__ void gemm_phase8(LAS unsigned char* lds, const int K, const Sched& S, const Epi& E) {
    const int tid = threadIdx.x, wid = __builtin_amdgcn_readfirstlane(tid >> 6), lane = tid & 63, wr = wid >> 2, wc = wid & 3, fr = lane & 15, fq = lane >> 4;
    const int nt = K / BK;
    unsigned voffA[2], voffB[2];
#pragma unroll
    for (int i = 0; i < 2; ++i) { int R, C; stage_rc(tid * 16 + i * 8192, R, C); const int Rb = Epi::PERM ? ((R & ~31) + perm32(R & 31)) : R;
        voffA[i] = (unsigned)(R * K + C) * 2u; voffB[i] = (unsigned)(Rb * K + C) * 2u; }
    const size_t kstep = (size_t)(BK * 2);
    const size_t hstep = (size_t)HALF * K * 2;
    const unsigned ldsw = (unsigned)wid * 1024u;
    const int aoff = lds_byte(wr * 64 + fr, fq * 16), boff = lds_byte(wc * 32 + fr, fq * 16);
#define PG8_SA(b, h) (((b) * 2 + (h)) * HTB)
#define PG8_SB(b, h) ((4 + (b) * 2 + (h)) * HTB)
#define PG8_STAGE(bufoff, gbase, voff) do { _Pragma("unroll") for (int _i = 0; _i < 2; ++_i) \
        __builtin_amdgcn_global_load_lds((const unsigned*)((const char*)(gbase) + (voff)[_i]), (LAS unsigned*)(lds + (bufoff) + ldsw + _i * 8192), 16, 0, 0); } while (0)
#define PG8_LD32(p) __builtin_shufflevector(*(const LAS v4i_t*)(p), *(const LAS v4i_t*)((p) + 16), 0, 1, 2, 3, 4, 5, 6, 7)
#define PG8_LDA(dst, b, h) do { _Pragma("unroll") for (int m = 0; m < 4; ++m) dst[m] = PG8_LD32(lds + PG8_SA(b, h) + aoff + m * 2048); } while (0)
#define PG8_LDB(dst, b, h) do { _Pragma("unroll") for (int n = 0; n < 2; ++n) dst[n] = PG8_LD32(lds + PG8_SB(b, h) + boff + n * 2048); } while (0)
#define PG8_MMA(ai, bj, At, Bt) do { __builtin_amdgcn_s_setprio(1); _Pragma("unroll") for (int m = 0; m < 4; ++m) _Pragma("unroll") for (int n = 0; n < 2; ++n) \
        asm volatile("v_mfma_scale_f32_16x16x128_f8f6f4 %0, %1, %2, %0, %3, %3 op_sel_hi:[0,0,0]" : "+v"(acc[ai][bj][m][n]) : "v"(Bt[n]), "v"(At[m]), "v"(mxscale)); __builtin_amdgcn_s_setprio(0); } while (0)
#define PG8_WAIT_V(n) asm volatile("s_waitcnt vmcnt(" #n ")" ::: "memory")
#define PG8_WAIT_L(n) asm volatile("s_waitcnt lgkmcnt(" #n ")" ::: "memory")
#define PG8_BAR __builtin_amdgcn_s_barrier()
#define PG8_SCHED __builtin_amdgcn_sched_barrier(0)
    Unit cur, nxt; int ui = 0;
    if (!S.next(0, cur)) return;
    Acc acc;
#pragma unroll
    for (int a = 0; a < 2; ++a)
#pragma unroll
        for (int b = 0; b < 2; ++b)
#pragma unroll
            for (int m = 0; m < 4; ++m)
#pragma unroll
                for (int n = 0; n < 2; ++n) acc[a][b][m][n] = (f32x4){0.f, 0.f, 0.f, 0.f};
    v8i_t At[4], B0[2], B1[2]; int mxscale = 0x7f7f7f7f; asm volatile("" : "+v"(mxscale));
    const char* cA = S.aptr(cur); const char* cB = S.bptr(cur);
    if constexpr (SP2) {
        PG8_STAGE(PG8_SB(0, 0), cB, voffB); PG8_STAGE(PG8_SB(0, 1), cB + hstep, voffB); PG8_STAGE(PG8_SA(0, 0), cA, voffA); PG8_STAGE(PG8_SA(0, 1), cA + hstep, voffA);
        if (wr == 1) PG8_BAR;
        PG8_WAIT_V(2); PG8_BAR;
        PG8_STAGE(PG8_SB(1, 0), cB + kstep, voffB); PG8_STAGE(PG8_SA(1, 0), cA + kstep, voffA); PG8_STAGE(PG8_SB(1, 1), cB + hstep + kstep, voffB);
        PG8_WAIT_V(6); PG8_BAR;
    } else {
        PG8_STAGE(PG8_SB(0, 0), cB, voffB); PG8_STAGE(PG8_SA(0, 0), cA, voffA); PG8_STAGE(PG8_SB(0, 1), cB + hstep, voffB); PG8_STAGE(PG8_SA(0, 1), cA + hstep, voffA);
        if (wr == 1) PG8_BAR;
        PG8_WAIT_V(4); PG8_BAR;
        PG8_STAGE(PG8_SB(1, 0), cB + kstep, voffB); PG8_STAGE(PG8_SA(1, 0), cA + kstep, voffA); PG8_STAGE(PG8_SB(1, 1), cB + hstep + kstep, voffB);
        PG8_WAIT_V(6); PG8_BAR;
    }
    for (;;) {
        const bool has_next = S.next(ui + 1, nxt);
        const char* nA = has_next ? S.aptr(nxt) : cA; const char* nB = has_next ? S.bptr(nxt) : cB;
        for (int t = 0; t < nt; t += 2) {
            const bool last = (t == nt - 2);
            const char* a1 = cA + (size_t)(t + 1) * kstep;
            const char* a2 = last ? nA : cA + (size_t)(t + 2) * kstep; const char* b2 = last ? nB : cB + (size_t)(t + 2) * kstep;
            const char* a3 = a2 + kstep; const char* b3 = b2 + kstep;
            if constexpr (SP2) {
            PG8_LDB(B0, 0, 0); PG8_LDB(B1, 0, 1); PG8_SCHED; PG8_LDA(At, 0, 0); PG8_STAGE(PG8_SA(1, 1), a1 + hstep, voffA);
            PG8_WAIT_V(8); PG8_WAIT_L(0); PG8_BAR; PG8_MMA(0, 0, At, B0); PG8_MMA(0, 1, At, B1); PG8_BAR; PG8_SCHED;
            PG8_LDA(At, 0, 1); PG8_STAGE(PG8_SB(0, 0), b2, voffB); PG8_STAGE(PG8_SB(0, 1), b2 + hstep, voffB); PG8_STAGE(PG8_SA(0, 0), a2, voffA);
            PG8_WAIT_V(8); PG8_WAIT_L(0); PG8_BAR; PG8_MMA(1, 0, At, B0); PG8_MMA(1, 1, At, B1); PG8_BAR; PG8_SCHED;
            PG8_LDB(B0, 1, 0); PG8_LDB(B1, 1, 1); PG8_SCHED; PG8_LDA(At, 1, 0); PG8_STAGE(PG8_SA(0, 1), a2 + hstep, voffA);
            PG8_WAIT_V(8); PG8_WAIT_L(0); PG8_BAR; PG8_MMA(0, 0, At, B0); PG8_MMA(0, 1, At, B1); PG8_BAR; PG8_SCHED;
            PG8_LDA(At, 1, 1); PG8_STAGE(PG8_SB(1, 0), b3, voffB); PG8_STAGE(PG8_SB(1, 1), b3 + hstep, voffB); PG8_STAGE(PG8_SA(1, 0), a3, voffA);
            PG8_WAIT_V(8); PG8_WAIT_L(0); PG8_BAR; PG8_MMA(1, 0, At, B0); PG8_MMA(1, 1, At, B1); PG8_BAR; PG8_SCHED;
            } else {
            PG8_LDB(B0, 0, 0); PG8_SCHED; PG8_LDA(At, 0, 0); PG8_STAGE(PG8_SA(1, 1), a1 + hstep, voffA);
            PG8_WAIT_L(8); PG8_BAR; PG8_WAIT_L(0); PG8_MMA(0, 0, At, B0); PG8_BAR; PG8_SCHED;
            PG8_LDB(B1, 0, 1); PG8_STAGE(PG8_SB(0, 0), b2, voffB);
            PG8_BAR; PG8_WAIT_L(0); PG8_MMA(0, 1, At, B1); PG8_BAR;
            PG8_LDA(At, 0, 1); PG8_STAGE(PG8_SA(0, 0), a2, voffA);
            PG8_BAR; PG8_WAIT_L(0); PG8_MMA(1, 0, At, B0); PG8_BAR; PG8_SCHED;
            PG8_STAGE(PG8_SB(0, 1), b2 + hstep, voffB);
            PG8_WAIT_V(6); PG8_BAR; PG8_MMA(1, 1, At, B1); PG8_BAR;
            PG8_LDB(B0, 1, 0); PG8_SCHED; PG8_LDA(At, 1, 0); PG8_STAGE(PG8_SA(0, 1), a2 + hstep, voffA);
            PG8_WAIT_L(8); PG8_BAR; PG8_WAIT_L(0); PG8_MMA(0, 0, At, B0); PG8_BAR; PG8_SCHED;
            PG8_LDB(B1, 1, 1); PG8_STAGE(PG8_SB(1, 0), b3, voffB);
            PG8_BAR; PG8_WAIT_L(0); PG8_MMA(0, 1, At, B1); PG8_BAR;
            PG8_LDA(At, 1, 1); PG8_STAGE(PG8_SA(1, 0), a3, voffA);
            PG8_BAR; PG8_WAIT_L(0); PG8_MMA(1, 0, At, B0); PG8_BAR; PG8_SCHED;
            PG8_STAGE(PG8_SB(1, 1), b3 + hstep, voffB);
            PG8_WAIT_V(6); PG8_BAR; PG8_MMA(1, 1, At, B1); PG8_BAR;
            }
        }
        if constexpr (ALIGN_EPI) { if (wr == 0) PG8_BAR; }
        asm volatile("s_nop 15\n\ts_nop 7" ::: "memory");
        if constexpr (!Epi::AFTER_DRAIN) { E(acc, cur, wr, wc, fr, fq); }
        if (!has_next) break;
#pragma unroll
        for (int a = 0; a < 2; ++a)
#pragma unroll
            for (int b = 0; b < 2; ++b)
#pragma unroll
                for (int m = 0; m < 4; ++m)
#pragma unroll
                    for (int n = 0; n < 2; ++n) acc[a][b][m][n] = (f32x4){0.f, 0.f, 0.f, 0.f};
        cur = nxt; cA = nA; cB = nB; ++ui;
        if constexpr (ALIGN_EPI) { if (wr == 1) PG8_BAR; }
    }
    PG8_WAIT_V(0);
    if constexpr (!ALIGN_EPI) { if (wr == 0) PG8_BAR; }
    PG8_BAR;
    if constexpr (Epi::AFTER_DRAIN) { E.fused(acc, cur, wr, wc, fr, fq, lds, wid, lane); }
#undef PG8_SA
#undef PG8_SB
#undef PG8_STAGE
#undef PG8_LDA
#undef PG8_LDB
#undef PG8_MMA
#undef PG8_LD32
#undef PG8_WAIT_V
#undef PG8_WAIT_L
#undef PG8_BAR
#undef PG8_SCHED
}
}

#define XB_TMO      128
#define XB_XCNT(j)  (256  + 64 * (j))
#define XB_XSUB(j)  (1280 + 64 * (j))
#define XB_XGEN(j)  (2304 + 64 * (j))
#define XB_TOP      3328
#define XB_TOPGEN   3392
#define XCD_BAR_WORDS 3456
#define XB_SPIN_CAP (1u << 20)
__device__ __forceinline__ unsigned xb_ld(unsigned* p)              { return __hip_atomic_load(p, __ATOMIC_RELAXED, __HIP_MEMORY_SCOPE_AGENT); }
__device__ __forceinline__ unsigned xb_add(unsigned* p, unsigned v) { return __hip_atomic_fetch_add(p, v, __ATOMIC_RELAXED, __HIP_MEMORY_SCOPE_AGENT); }
__device__ __forceinline__ unsigned xb_xcc_id() { return (unsigned)__builtin_amdgcn_s_getreg((3 << 11) | 20) & 0xFu; }
#define XB_SPIN(cond, bar) do { unsigned _sp = 0; while (cond) { __builtin_amdgcn_s_sleep(1); \
    if ((++_sp & 255u) == 0u) { if (xb_ld(&(bar)[XB_TMO])) break; if (_sp > XB_SPIN_CAP) { atomicAdd(&(bar)[XB_TMO], 1u); break; } } } } while (0)
struct XcdBarrier { unsigned* bar; unsigned x; volatile LAS unsigned* st; };
__device__ __forceinline__ XcdBarrier xcd_barrier_post(unsigned* bar, volatile LAS unsigned* st) {
    XcdBarrier b; b.bar = bar; b.x = xb_xcc_id(); b.st = st;
    if (threadIdx.x == 0) (void)xb_add(&bar[XB_XCNT(b.x)], 1u);
    return b;
}
__device__ __forceinline__ void xcd_barrier_complete(unsigned* bar, unsigned x, unsigned& nloc, unsigned& nx) {
    const unsigned G = gridDim.x * gridDim.y * gridDim.z;
    unsigned sum, cnt, mine, sp = 0u;
    for (;;) {
        sum = 0u; cnt = 0u; mine = 0u;
#pragma unroll
        for (unsigned j = 0; j < 16; ++j) { const unsigned c = xb_ld(&bar[XB_XCNT(j)]); sum += c; cnt += (c > 0u) ? 1u : 0u; mine = (j == x) ? c : mine; }
        if (sum == G) break;
        __builtin_amdgcn_s_sleep(1);
        if ((++sp & 255u) == 0u) { if (xb_ld(&bar[XB_TMO])) break; if (sp > XB_SPIN_CAP) { atomicAdd(&bar[XB_TMO], 1u); break; } }
    }
    nloc = mine > 0u ? mine : 1u; nx = cnt > 0u ? cnt : 1u;
}
__device__ __forceinline__ void xcd_barrier(const XcdBarrier& b) {
    asm volatile("s_waitcnt vmcnt(0)" ::: "memory");
    __syncthreads();
    if (threadIdx.x == 0) {
        unsigned* bar = b.bar;
        __builtin_amdgcn_s_waitcnt(0);
        unsigned nloc = b.st[0], nx = b.st[1];
        if (nloc == 0u) { xcd_barrier_complete(bar, b.x, nloc, nx); b.st[0] = nloc; b.st[1] = nx; }
        const unsigned old = xb_add(&bar[XB_XSUB(b.x)], 1u);
        const unsigned gen = old / nloc;
        if (old + 1u == (gen + 1u) * nloc) {
            __builtin_amdgcn_fence(__ATOMIC_RELEASE, "agent");
            asm volatile("s_waitcnt vmcnt(0)" ::: "memory");
            const unsigned og = xb_add(&bar[XB_TOP], 1u);
            const unsigned tg = og / nx;
            if (og + 1u == (tg + 1u) * nx) xb_add(&bar[XB_TOPGEN], 1u);
            else XB_SPIN(xb_ld(&bar[XB_TOPGEN]) == tg, bar);
            __builtin_amdgcn_fence(__ATOMIC_ACQUIRE, "agent");
            xb_add(&bar[XB_XGEN(b.x)], 1u);
            asm volatile("s_waitcnt vmcnt(0)" ::: "memory");
        } else {
            XB_SPIN(xb_ld(&bar[XB_XGEN(b.x)]) == gen, bar);
            __builtin_amdgcn_fence(__ATOMIC_ACQUIRE, "agent");
            asm volatile("s_waitcnt vmcnt(0)" ::: "memory");
        }
    }
    __syncthreads();
}

struct Frame {
    LAS unsigned char* lds;
    int tid, lane, wave, vcu, G;
    const float* in[25]; float* out; unsigned char* ws;
};
#define WSP(T, off) ((T*)(F.ws + (off)))
#define XBP ((bf16*)((unsigned char*)F.out + OUT_XB))

struct TrItem { const float* src; const float* gain; bf16* dst; int ldw, K, f8; };
__device__ __forceinline__ unsigned pk4_fp8(float a, float b, float c, float d) { int p = 0; p = __builtin_amdgcn_cvt_pk_fp8_f32(a, b, p, false); p = __builtin_amdgcn_cvt_pk_fp8_f32(c, d, p, true); return (unsigned)p; }
__device__ __forceinline__ void tr_load(f32x4 (&v)[8], const TrItem& t, int lane) {
    const float* p = t.src + (size_t)(8 * (lane & 7)) * t.ldw + 4 * (lane >> 3);
#pragma unroll
    for (int j = 0; j < 8; ++j) v[j] = __builtin_nontemporal_load((const f32x4*)(p + (size_t)j * t.ldw));
}
__device__ __forceinline__ void tr_store(const f32x4 (&v)[8], const TrItem& t, int lane) {
    float g[8];
    if (t.gain) { const f32x4 g0 = *(const f32x4*)(t.gain + 8 * (lane & 7)), g1 = *(const f32x4*)(t.gain + 8 * (lane & 7) + 4);
        g[0] = g0[0]; g[1] = g0[1]; g[2] = g0[2]; g[3] = g0[3]; g[4] = g1[0]; g[5] = g1[1]; g[6] = g1[2]; g[7] = g1[3]; }
    else {
#pragma unroll
        for (int j = 0; j < 8; ++j) g[j] = 1.0f; }
    if (t.f8) {
        unsigned char* d8 = (unsigned char*)t.dst + (size_t)(4 * (lane >> 3)) * t.K + 8 * (lane & 7);
#pragma unroll
        for (int i = 0; i < 4; ++i) { u32x2 o; o.x = pk4_fp8(v[0][i] * g[0] * 64.f, v[1][i] * g[1] * 64.f, v[2][i] * g[2] * 64.f, v[3][i] * g[3] * 64.f);
            o.y = pk4_fp8(v[4][i] * g[4] * 64.f, v[5][i] * g[5] * 64.f, v[6][i] * g[6] * 64.f, v[7][i] * g[7] * 64.f);
            *(GAS u32x2*)(d8 + (size_t)i * t.K) = o; }
        return; }
    bf16* d = t.dst + (size_t)(4 * (lane >> 3)) * t.K + 8 * (lane & 7);
#pragma unroll
    for (int i = 0; i < 4; ++i) { u32x4 o; o.x = pk2(v[0][i] * g[0], v[1][i] * g[1]); o.y = pk2(v[2][i] * g[2], v[3][i] * g[3]); o.z = pk2(v[4][i] * g[4], v[5][i] * g[5]); o.w = pk2(v[6][i] * g[6], v[7][i] * g[7]);
        *(GAS u32x4*)(d + (size_t)i * t.K) = o; }
}
__device__ __forceinline__ void tr_alpha(const float* win, const float* wup, const float* gain, bf16* dst, int k0, int n0, int lane) {
    const int lk = lane & 7, ln = lane >> 3;
    f32x4 wu[16];
#pragma unroll
    for (int r = 0; r < 16; ++r) wu[r] = *(const f32x4*)(wup + r * 512 + n0 + 4 * ln);
    f32x4 v[8];
#pragma unroll
    for (int j = 0; j < 8; ++j) { const float* a = win + (size_t)(k0 + 8 * lk + j) * WIN_LD + 3072; f32x4 acc = {0.f, 0.f, 0.f, 0.f};
#pragma unroll
        for (int r4 = 0; r4 < 4; ++r4) { const f32x4 av = *(const f32x4*)(a + 4 * r4); acc += wu[4 * r4] * av[0] + wu[4 * r4 + 1] * av[1] + wu[4 * r4 + 2] * av[2] + wu[4 * r4 + 3] * av[3]; }
        v[j] = acc; }
    TrItem t; t.f8 = 0; t.src = nullptr; t.gain = gain + k0; t.dst = dst + (size_t)n0 * DM + k0; t.ldw = 0; t.K = DM;
    tr_store(v, t, lane);
}
__device__ __forceinline__ void row_to_bf16(const float* xrow, bf16* orow, float* rinv, int lane, unsigned* qrow = nullptr) {
    const GAS f32x4* xr = (const GAS f32x4*)xrow + lane;
    f32x4 v[8]; float s = 0.f;
#pragma unroll
    for (int j = 0; j < 8; ++j) { v[j] = __builtin_nontemporal_load(xr + 64 * j); s += (v[j].x * v[j].x + v[j].y * v[j].y) + (v[j].z * v[j].z + v[j].w * v[j].w); }
    s = wave_sum(s);
    if (lane == 0) *rinv = 1.0f / sqrtf(s * (1.0f / DM) + NORM_EPS);
    GAS u32x2* o8 = (GAS u32x2*)orow + lane;
#pragma unroll
    for (int j = 0; j < 8; ++j) { u32x2 w; w.x = pk2(v[j].x, v[j].y); w.y = pk2(v[j].z, v[j].w); o8[64 * j] = w; }
    if (qrow) {
#pragma unroll
        for (int j = 0; j < 8; ++j) ((GAS unsigned*)qrow)[lane + 64 * j] = pk4_fp8(v[j].x * 8.f, v[j].y * 8.f, v[j].z * 8.f, v[j].w * 8.f); }
}

__device__ __forceinline__ TrItem p0_item(Frame& F, int r) {
    constexpr int I_A = 32 * 96, I_B = 32 * 128, I_G = 32 * 192;
    const float* w_in = F.in[4]; const float* g_mix = F.in[2]; bf16* W1T = WSP(bf16, WS_W1T);
    TrItem t; t.f8 = 0;
    if (r < I_A) { const int kb = r / 96, nb = r % 96; t.src = w_in + (size_t)(64 * kb) * WIN_LD + 32 * nb; t.ldw = WIN_LD; t.gain = g_mix + 64 * kb; t.dst = W1T + (size_t)(32 * nb) * DM + 64 * kb; t.K = DM; return t; } r -= I_A;
    if (r < I_B) { const int kb = r / 128, nb = r % 128; t.src = w_in + (size_t)(64 * kb) * WIN_LD + 3088 + 32 * nb; t.ldw = WIN_LD; t.gain = g_mix + 64 * kb; t.dst = W1T + (size_t)(3072 + 32 * nb) * DM + 64 * kb; t.K = DM; return t; } r -= I_B;
    if (r < I_G) { const int kb = r / 192, nb = r % 192; t.src = F.in[19] + (size_t)(64 * kb) * NGT + 32 * nb; t.ldw = NGT; t.gain = g_mix + 64 * kb; t.dst = (bf16*)(F.ws + WS_WG8 + (size_t)(32 * nb) * DM + 64 * kb); t.K = DM; t.f8 = 1; return t; } r -= I_G;
    { const int kb = r / 64, nb = r % 64; t.src = F.in[17] + (size_t)(64 * kb) * 2048 + 32 * nb; t.ldw = 2048; t.gain = F.in[3] + 64 * kb; t.dst = WSP(bf16, WS_WKVT) + (size_t)(32 * nb) * DM + 64 * kb; t.K = DM; return t; }
}
__device__ __forceinline__ TrItem p1t_item(Frame& F, int r) {
    constexpr int I_BR = 3 * 16 * 64;
    TrItem t; t.f8 = 0;
    if (r < I_BR) { const int br = r / 1024, q = r % 1024, kb = q / 64, nb = q % 64;
        t.src = F.in[18] + (size_t)br * 1024 * 2048 + (size_t)(64 * kb) * 2048 + 32 * nb; t.ldw = 2048; t.gain = nullptr; t.dst = WSP(bf16, WS_WBT) + (size_t)br * 2048 * 1024 + (size_t)(32 * nb) * 1024 + 64 * kb; t.K = 1024; return t; } r -= I_BR;
    { const int kb = r / 64, nb = r % 64; t.src = F.in[21] + (size_t)(64 * kb) * 2048 + 32 * nb; t.ldw = 2048; t.gain = nullptr; t.dst = WSP(bf16, WS_WOT) + (size_t)(32 * nb) * DM + 64 * kb; t.K = DM; return t; }
}
__device__ __forceinline__ TrItem p2_item(Frame& F, int r) {
    TrItem t; t.f8 = 0;
    { const int kb = r / 352, nb = r % 352; const int j0 = 32 * nb; const int drow = (j0 < DFF) ? (256 * (j0 / 128) + (j0 % 128)) : (256 * ((j0 - DFF) / 128) + 128 + ((j0 - DFF) % 128));
        t.src = F.in[23] + (size_t)(64 * kb) * (2 * DFF) + j0; t.ldw = 2 * DFF; t.gain = F.in[22] + 64 * kb; t.dst = WSP(bf16, WS_WFIT) + (size_t)drow * DM + 64 * kb; t.K = DM; return t; }
}
__device__ __forceinline__ TrItem p5t_item(Frame& F, int r) {
    TrItem t; t.f8 = 0;
    { const int kb = r / 64, nb = r % 64; t.src = F.in[24] + (size_t)(64 * kb) * DM + 32 * nb; t.ldw = DM; t.gain = nullptr; t.dst = WSP(bf16, WS_WFDT) + (size_t)(32 * nb) * DFF + 64 * kb; t.K = DFF; return t; }
}
#define TR_RUN(DECODE, NITEMS) do { \
    for (int it = gw; it < (NITEMS); it += 4 * NGW) { const int it2 = it + NGW, it3 = it + 2 * NGW, it4 = it + 3 * NGW; const bool two = it2 < (NITEMS), three = it3 < (NITEMS), four = it4 < (NITEMS); \
        const TrItem ta = DECODE(F, it); const TrItem tb = DECODE(F, two ? it2 : it); const TrItem tc = DECODE(F, three ? it3 : it); const TrItem td = DECODE(F, four ? it4 : it); \
        f32x4 va[8], vb[8], vc[8], vd[8]; tr_load(va, ta, F.lane); if (two) tr_load(vb, tb, F.lane); if (three) tr_load(vc, tc, F.lane); if (four) tr_load(vd, td, F.lane); \
        tr_store(va, ta, F.lane); if (two) tr_store(vb, tb, F.lane); if (three) tr_store(vc, tc, F.lane); if (four) tr_store(vd, td, F.lane); } } while (0)

__device__ __forceinline__ void p0_prologue(Frame& F) {
    const int gw = F.vcu * NWAVES + F.wave, NGW = F.G * NWAVES;
    constexpr int NITEMS = 32 * 96 + 32 * 128 + 32 * 192 + 32 * 64;
    TR_RUN(p0_item, NITEMS);
    for (int it = gw; it < 32 * 16; it += NGW) { const int kb = it / 16, nb = it % 16; tr_alpha(F.in[4], F.in[5], F.in[2], WSP(bf16, WS_W1T) + (size_t)ZA_GLA * DM, 64 * kb, 32 * nb, F.lane); }
    for (int m = gw; m < TOK; m += NGW) row_to_bf16(F.in[0] + (size_t)m * DM, XBP + (size_t)m * DM, WSP(float, WS_RINVX) + m, F.lane, (unsigned*)(F.ws + WS_XQ + (size_t)m * DM));
    for (int m = gw; m < MEMROWS; m += NGW) row_to_bf16(F.in[1] + (size_t)m * DM, WSP(bf16, WS_MEMB) + (size_t)m * DM, WSP(float, WS_RINVM) + m, F.lane);
    if (gw == 0) {
        const int l = F.lane;
        float d1 = F.in[10][l] * F.in[11][l] + F.in[10][l + 64] * F.in[11][l + 64];
        float d2 = F.in[12][l] * F.in[13][l] + F.in[12][l + 64] * F.in[13][l + 64];
        d1 = wave_sum(d1); d2 = wave_sum(d2);
        const float gq = wave_max(fmaxf(fabsf(F.in[8][l]), fabsf(F.in[8][l + 64]))), gk = wave_max(fmaxf(fabsf(F.in[9][l]), fabsf(F.in[9][l + 64])));
        const float mq = wave_max(fmaxf(fmaxf(fabsf(F.in[15][l]), fabsf(F.in[15][l + 64])), fmaxf(fabsf(F.in[15][l + 128]), fabsf(F.in[15][l + 192]))));
        const float mk = wave_max(fmaxf(fmaxf(fabsf(F.in[16][l]), fabsf(F.in[16][l + 64])), fmaxf(fabsf(F.in[16][l + 128]), fabsf(F.in[16][l + 192]))));
        if (l == 0) { float* sc = WSP(float, WS_SC); sc[0] = expf(d1) - expf(d2) + LAM_INIT; sc[1] = 11.313708499f * gq * gk * LOG2E; sc[2] = 16.0f * mq * mk * LOG2E; }
    }
}
__device__ __forceinline__ void p2_convert(Frame& F) {
    const int gw = F.vcu * NWAVES + F.wave, NGW = F.G * NWAVES;
    TR_RUN(p2_item, 32 * 352);
}
template <int DH>
__device__ __forceinline__ void knorm8(bf16* base  , size_t ld, const float* gain, int lane) {
    constexpr int NCH = DH / 64;
    bf16* p = base + (size_t)(lane >> 3) * ld + (lane & 7) * 8;
    u32x4 v[NCH]; float ss = 0.f;
#pragma unroll
    for (int i = 0; i < NCH; ++i) { v[i] = *(const u32x4*)(p + 64 * i);
        const float a0 = bflo(v[i].x), a1 = bfhi(v[i].x), a2 = bflo(v[i].y), a3 = bfhi(v[i].y), a4 = bflo(v[i].z), a5 = bfhi(v[i].z), a6 = bflo(v[i].w), a7 = bfhi(v[i].w);
        ss += (a0 * a0 + a1 * a1) + (a2 * a2 + a3 * a3) + (a4 * a4 + a5 * a5) + (a6 * a6 + a7 * a7); }
    ss += __shfl_xor(ss, 1); ss += __shfl_xor(ss, 2); ss += __shfl_xor(ss, 4);
    const float rn = frsq(ss * (1.0f / DH) + NORM_EPS);
#pragma unroll
    for (int i = 0; i < NCH; ++i) { const float* g = gain + ((lane & 7) + 8 * i) * 8; const f32x4 g0 = *(const f32x4*)g, g1 = *(const f32x4*)(g + 4);
        u32x4 w;
        w.x = pk2(bflo(v[i].x) * rn * g0[0], bfhi(v[i].x) * rn * g0[1]); w.y = pk2(bflo(v[i].y) * rn * g0[2], bfhi(v[i].y) * rn * g0[3]);
        w.z = pk2(bflo(v[i].z) * rn * g1[0], bfhi(v[i].z) * rn * g1[1]); w.w = pk2(bflo(v[i].w) * rn * g1[2], bfhi(v[i].w) * rn * g1[3]);
        *(u32x4*)(p + 64 * i) = w; }
}

__device__ __forceinline__ void p1_tail_convert(Frame& F, int first, int nw) {
    const int gw = ((int)blockIdx.x - first) * NWAVES + F.wave, NGW = nw * NWAVES;
    TR_RUN(p1t_item, 3 * 16 * 64 + 32 * 64);
}
__device__ __forceinline__ void p5_tail_convert(Frame& F, int first, int nw) {
    const int gw = ((int)blockIdx.x - first) * NWAVES + F.wave, NGW = nw * NWAVES;
    TR_RUN(p5t_item, 88 * 64);
}

constexpr int BG_NH = 2 * 32 * 352;
template <bool V> struct BoolT { static constexpr bool value = V; };
struct BgConv { const float* src; const float* gain; bf16* dst; int h, step; };
__device__ __forceinline__ void bg_load(const BgConv& B, f32x4 (&v)[4], f32x4& gv, int lane) {
    const int hh = (B.h < BG_NH) ? B.h : BG_NH - 1;
    const int r = hh >> 1, half = hh & 1, kb = r / 352, nb = r % 352;
    const float* p = B.src + (size_t)(64 * kb + 4 * half + 8 * (lane & 7)) * (2 * DFF) + 32 * nb + 4 * (lane >> 3);
#pragma unroll
    for (int j = 0; j < 4; ++j) v[j] = __builtin_nontemporal_load((const f32x4*)(p + (size_t)j * (2 * DFF)));
    gv = *(const f32x4*)(B.gain + 64 * kb + 4 * half + 8 * (lane & 7));
}
__device__ __forceinline__ void bg_store(const BgConv& B, const f32x4 (&v)[4], const f32x4& gv, int lane) {
    const int r = B.h >> 1, half = B.h & 1, kb = r / 352, nb = r % 352; const int j0 = 32 * nb;
    const int drow = (j0 < DFF) ? (256 * (j0 / 128) + (j0 % 128)) : (256 * ((j0 - DFF) / 128) + 128 + ((j0 - DFF) % 128));
    bf16* d = B.dst + (size_t)(drow + 4 * (lane >> 3)) * DM + 64 * kb + 4 * half + 8 * (lane & 7);
#pragma unroll
    for (int i = 0; i < 4; ++i) { u32x2 o; o.x = pk2(v[0][i] * gv[0], v[1][i] * gv[1]); o.y = pk2(v[2][i] * gv[2], v[3][i] * gv[3]); *(GAS u32x2*)(d + (size_t)i * DM) = o; }
}

constexpr int AT_K = 0, AT_V = 34816, AT_P = AT_V + 36864, AT_G = AT_P + 18432, AT_L = AT_G + 2048, AT_R = AT_L + 1024, AT_END = AT_R + 1024;
static_assert(AT_END <= RING_BYTES, "attention LDS");
constexpr int VST = 576, PST = 144;

__device__ __forceinline__ void tile_load(u32x4 (&r)[4], const bf16* base, int ld, int tid) {
    const bf16* p = base + (size_t)(tid >> 3) * ld + (tid & 7) * 8;
#pragma unroll
    for (int i = 0; i < 4; ++i) r[i] = *(const u32x4*)(p + 64 * i);
}
__device__ __forceinline__ void tile_store_raw(const u32x4 (&r)[4], LAS unsigned char* buf, int tid) {
#pragma unroll
    for (int i = 0; i < 4; ++i) *(LAS u32x4*)(buf + (tid >> 3) * VST + ((tid & 7) + 8 * i) * 16) = r[i];
}
template <int DH, int NCOMP>
__device__ __forceinline__ void tile_store_norm(const u32x4 (&r)[4], LAS unsigned char* buf, const LAS float* gain, float scale, int tid) {
    constexpr int KST = DH * 2 + 16, CPR = DH / 8;
    float ss[2] = {0.f, 0.f};
#pragma unroll
    for (int i = 0; i < 4; ++i) { const int c = (NCOMP == 2) ? (i >> 1) : 0;
        const float a0 = bflo(r[i].x), a1 = bfhi(r[i].x), a2 = bflo(r[i].y), a3 = bfhi(r[i].y), a4 = bflo(r[i].z), a5 = bfhi(r[i].z), a6 = bflo(r[i].w), a7 = bfhi(r[i].w);
        ss[c] += (a0 * a0 + a1 * a1) + (a2 * a2 + a3 * a3) + (a4 * a4 + a5 * a5) + (a6 * a6 + a7 * a7); }
#pragma unroll
    for (int c = 0; c < NCOMP; ++c) { ss[c] += __shfl_xor(ss[c], 1); ss[c] += __shfl_xor(ss[c], 2); ss[c] += __shfl_xor(ss[c], 4); ss[c] = frsq(ss[c] * (1.0f / DH) + NORM_EPS) * scale; }
#pragma unroll
    for (int i = 0; i < 4; ++i) { const int c = (NCOMP == 2) ? (i >> 1) : 0; const int chunk = (tid & 7) + 8 * i, dch = chunk % CPR; const float rn = ss[c];
        const f32x4 g0 = *(const LAS f32x4*)(gain + dch * 8), g1 = *(const LAS f32x4*)(gain + dch * 8 + 4);
        u32x4 w;
        w.x = pk2(bflo(r[i].x) * rn * g0[0], bfhi(r[i].x) * rn * g0[1]); w.y = pk2(bflo(r[i].y) * rn * g0[2], bfhi(r[i].y) * rn * g0[3]);
        w.z = pk2(bflo(r[i].z) * rn * g1[0], bfhi(r[i].z) * rn * g1[1]); w.w = pk2(bflo(r[i].w) * rn * g1[2], bfhi(r[i].w) * rn * g1[3]);
        *(LAS u32x4*)(buf + ((tid >> 3) * NCOMP + c) * KST + dch * 16) = w; }
}

template <int DH, int NCOMP>
__device__ __forceinline__ void tile_store_k(const u32x4 (&r)[4], LAS unsigned char* buf, int tid) {
    constexpr int KST = DH * 2 + 16, CPR = DH / 8;
#pragma unroll
    for (int i = 0; i < 4; ++i) { const int c = (NCOMP == 2) ? (i >> 1) : 0; const int chunk = (tid & 7) + 8 * i, dch = chunk % CPR;
        *(LAS u32x4*)(buf + ((tid >> 3) * NCOMP + c) * KST + dch * 16) = r[i]; }
}
template <int DH, int NCOMP, int NRB>
struct AttnUnit {
    static constexpr int NDV = 8 / NRB, DVW = 256 / NDV, NBLK = DVW / 32, KS = DH / 16, KST = DH * 2 + 16;
    const bf16* Q; int ldq; const bf16* K; int ldk; const bf16* V; int ldv; int ntiles; const float* qg; float m2;
    template <bool BG = false>
    __device__ __forceinline__ void run(LAS unsigned char* lds, f32x16 (&O)[NCOMP][NBLK], BgConv* bg = nullptr) const {
        int tid = threadIdx.x; asm volatile("" : "+v"(tid));
        const int lane = tid & 63, wid = __builtin_amdgcn_readfirstlane(tid >> 6), r = lane & 31, h = lane >> 5;
        const int kh = wid & 1, compA = (wid >> 1) % NCOMP, rbA = wid / (2 * NCOMP);
        const int dvp = wid % NDV, rbB = wid / NDV;
        const int b16 = (lane >> 4) & 1, q4 = (lane & 15) >> 2, p4 = lane & 3;
        LAS unsigned char* kbuf = lds + AT_K; LAS unsigned char* vbuf = lds + AT_V; LAS unsigned char* pbuf = lds + AT_P;
        LAS float* gq = (LAS float*)(lds + AT_G); LAS float* lbuf = (LAS float*)(lds + AT_L);
        if (tid < DH) gq[tid] = qg[tid];
        __syncthreads();
        bf16x8 qf[KS];
        const float qscale = ((DH == 128) ? 0.08838834764831845f : 0.0625f) * LOG2E;
#pragma unroll
        for (int pass = 0; pass < NRB / 2; ++pass) {
            u32x4 qr[4]; tile_load(qr, Q + (size_t)(64 * pass) * ldq, ldq, tid);
            tile_store_norm<DH, NCOMP>(qr, kbuf, gq, qscale, tid);
            __syncthreads();
            if (rbA / 2 == pass) {
#pragma unroll
                for (int s = 0; s < KS; ++s) qf[s] = *(const LAS bf16x8*)(kbuf + ((32 * (rbA & 1) + r) * NCOMP + compA) * KST + (16 * s + 8 * h) * 2);
            }
            __syncthreads();
        }
        u32x4 kreg[4], vreg[4];
        tile_load(kreg, K, ldk, tid); tile_load(vreg, V, ldv, tid);
        tile_store_k<DH, NCOMP>(kreg, kbuf, tid);
#pragma unroll
        for (int c = 0; c < NCOMP; ++c)
#pragma unroll
            for (int b = 0; b < NBLK; ++b)
#pragma unroll
                for (int i = 0; i < 16; ++i) O[c][b][i] = 0.f;
        float lsum = 0.f;
        f32x4 bgv[4], bgg;
        __syncthreads();
        auto body = [&](const int t, auto moret, auto bgt) {
            constexpr bool more = decltype(moret)::value, BGI = decltype(bgt)::value;
            if (more) tile_load(kreg, K + (size_t)(64 * (t + 1)) * ldk, ldk, tid);
            f32x16 st;
#pragma unroll
            for (int i = 0; i < 16; ++i) st[i] = 0.f;
            if (DH == 128) {
                bf16x8 kfa[KS];
#pragma unroll
                for (int s = 0; s < KS; ++s) kfa[s] = *(const LAS bf16x8*)(kbuf + ((32 * kh + r) * NCOMP + compA) * KST + (16 * s + 8 * h) * 2);
                asm volatile("" ::: "memory");
                tile_store_raw(vreg, vbuf, tid);
#pragma unroll
                for (int s = 0; s < KS; ++s) st = MFMA32(kfa[s], qf[s], st);
            } else {
            tile_store_raw(vreg, vbuf, tid);
#pragma unroll
            for (int s = 0; s < KS; ++s) { const bf16x8 kf = *(const LAS bf16x8*)(kbuf + ((32 * kh + r) * NCOMP + compA) * KST + (16 * s + 8 * h) * 2); st = MFMA32(kf, qf[s], st);
                if ((s & 3) == 3) asm volatile("" ::: "memory"); }
            }
            float pe[16];
#pragma unroll
            for (int i = 0; i < 16; ++i) { pe[i] = fexp2(st[i] - m2); lsum += pe[i]; }
#pragma unroll
            for (int g = 0; g < 4; ++g) { u32x2 w; w.x = pk2(pe[4 * g], pe[4 * g + 1]); w.y = pk2(pe[4 * g + 2], pe[4 * g + 3]);
                *(LAS u32x2*)(pbuf + ((compA * NRB + rbA) * 32 + r) * PST + (32 * kh + 8 * g + 4 * h) * 2) = w; }
            __syncthreads();
            if (more) tile_load(vreg, V + (size_t)(64 * (t + 1)) * ldv, ldv, tid);
#pragma unroll
            for (int s = 0; s < 4; ++s) {
                bf16x8 pf[NCOMP];
#pragma unroll
                for (int c = 0; c < NCOMP; ++c) pf[c] = *(const LAS bf16x8*)(pbuf + ((c * NRB + rbB) * 32 + r) * PST + (16 * s + 8 * h) * 2);
#pragma unroll
                for (int b = 0; b < NBLK; ++b) {
                    const bf16x8 vf = trfrag(vbuf + (16 * s + 8 * h + q4) * VST + (DVW * dvp + 32 * b + 16 * b16 + 4 * p4) * 2, 4 * VST);
#pragma unroll
                    for (int c = 0; c < NCOMP; ++c) O[c][b] = MFMA32(pf[c], vf, O[c][b]);
                }
                asm volatile("" ::: "memory");
                if (DH == 128 && s == 1) { if (more) tile_store_k<DH, NCOMP>(kreg, kbuf, tid); }
            }
            if (DH != 128) { if (more) tile_store_k<DH, NCOMP>(kreg, kbuf, tid); }
            if constexpr (BGI) { bg_store(*bg, bgv, bgg, lane); bg->h += bg->step; bg_load(*bg, bgv, bgg, lane); }
            __syncthreads();
        };
        int t = 0;
        if constexpr (BG) {
            int n = 0; if (bg->h < BG_NH) { n = (BG_NH - 1 - bg->h) / bg->step + 1; const int fit = (ntiles - 1) / 2; n = (n < fit) ? n : fit; }
            if (n > 0) { bg_load(*bg, bgv, bgg, lane);
#pragma unroll 1
                for (int g = 0; g < n; ++g, t += 2) { body(t, BoolT<true>{}, BoolT<false>{}); body(t + 1, BoolT<true>{}, BoolT<true>{}); } } }
        for (; t < ntiles - 1; ++t) body(t, BoolT<true>{}, BoolT<false>{});
        body(ntiles - 1, BoolT<false>{}, BoolT<false>{});
        lsum += __shfl_xor(lsum, 32);
        if (h == 0) lbuf[((compA * NRB + rbA) * 2 + kh) * 32 + r] = lsum;
        __syncthreads();
    }
};

template <bool BG = false>
__device__ __forceinline__ void diff_unit(Frame& F, int bh, int c, BgConv* bg = nullptr) {
    typedef AttnUnit<128, 2, 2> AU;
    const int b = bh >> 2, hd = bh & 3;
    const bf16* Z = WSP(bf16, WS_Z); const float* sc = WSP(float, WS_SC);
    AU u; u.Q = Z + (size_t)(b * SEQ + 64 * c) * NZ + ZQ_DIFF + hd * 256; u.ldq = NZ; u.K = Z + (size_t)(b * SEQ) * NZ + ZK_DIFF + hd * 256; u.ldk = NZ;
    u.V = Z + (size_t)(b * SEQ) * NZ + ZV_DIFF + hd * 256; u.ldv = NZ; u.ntiles = c + 1; u.qg = F.in[8]; u.m2 = sc[1];
    f32x16 O[2][2];
    u.template run<BG>(F.lds, O, bg);
    int tid = F.tid; asm volatile("" : "+v"(tid));
    const int lane = tid & 63, wid = F.wave, r = lane & 31, h = lane >> 5, dvp = wid & 3, rbB = wid >> 2;
    LAS unsigned char* lds = F.lds;
    const LAS float* lbuf = (const LAS float*)(lds + AT_L);
    const float lam = sc[0];
    if (tid < 256) ((LAS float*)(lds + AT_G + 1024))[tid] = F.in[14][tid] * (1.0f - LAM_INIT);
#pragma unroll
    for (int i = 0; i < 16; ++i) { const int q = crow(i, h);
        const float l1 = lbuf[((0 * 2 + rbB) * 2 + 0) * 32 + q] + lbuf[((0 * 2 + rbB) * 2 + 1) * 32 + q];
        const float l2 = lbuf[((1 * 2 + rbB) * 2 + 0) * 32 + q] + lbuf[((1 * 2 + rbB) * 2 + 1) * 32 + q];
        const float i1 = frcp(l1), i2 = lam * frcp(l2);
        LAS unsigned char* orow = lds + (32 * rbB + q) * 1024; const int sw = (q & 1) << 4;
        *(LAS float*)(orow + (((64 * dvp + r) * 4) ^ sw)) = O[0][0][i] * i1 - O[1][0][i] * i2;
        *(LAS float*)(orow + (((64 * dvp + 32 + r) * 4) ^ sw)) = O[0][1][i] * i1 - O[1][1][i] * i2; }
    __syncthreads();
    { const int l = tid >> 3, sw = (l & 1) << 4;
      const LAS unsigned char* orow = lds + l * 1024;
      const LAS f32x4* gnt = (const LAS f32x4*)(lds + AT_G + 1024);
      f32x4 o[4][2]; float ss = 0.f;
#pragma unroll
      for (int i = 0; i < 4; ++i) { const int ch = (tid & 7) + 8 * i;
          o[i][0] = *(const LAS f32x4*)(orow + ((ch * 32) ^ sw)); o[i][1] = *(const LAS f32x4*)(orow + ((ch * 32 + 16) ^ sw));
#pragma unroll
          for (int e = 0; e < 4; ++e) ss += o[i][0][e] * o[i][0][e] + o[i][1][e] * o[i][1][e]; }
      ss += __shfl_xor(ss, 1); ss += __shfl_xor(ss, 2); ss += __shfl_xor(ss, 4);
      const float rn = frsq(ss * (1.0f / 256.0f) + NORM_EPS);
      bf16* Y = (bf16*)F.out + (size_t)TOK * 1024 + (size_t)(b * SEQ + 64 * c + l) * 1024 + hd * 256 + (tid & 7) * 8;
#pragma unroll
      for (int i = 0; i < 4; ++i) { const int ch = (tid & 7) + 8 * i;
          const f32x4 g0 = gnt[2 * ch], g1 = gnt[2 * ch + 1];
          u32x4 w;
          w.x = pk2(o[i][0][0] * rn * g0[0], o[i][0][1] * rn * g0[1]); w.y = pk2(o[i][0][2] * rn * g0[2], o[i][0][3] * rn * g0[3]);
          w.z = pk2(o[i][1][0] * rn * g1[0], o[i][1][1] * rn * g1[1]); w.w = pk2(o[i][1][2] * rn * g1[2], o[i][1][3] * rn * g1[3]);
          *(u32x4*)(Y + 64 * i) = w; } }
    __syncthreads();
}
__device__ __forceinline__ void mem_unit(Frame& F, int b, int hd, int qb) {
    typedef AttnUnit<256, 1, 4> AU;
    const bf16* Z = WSP(bf16, WS_Z); const bf16* KVM = WSP(bf16, WS_KVM); const float* sc = WSP(float, WS_SC);
    AU u; u.Q = Z + (size_t)(b * SEQ + 128 * qb) * NZ + ZQ_MEM + hd * 256; u.ldq = NZ; u.K = KVM + (size_t)(b * NMEM) * 2048 + hd * 256; u.ldk = 2048;
    u.V = KVM + (size_t)(b * NMEM) * 2048 + 1024 + hd * 256; u.ldv = 2048; u.ntiles = 4; u.qg = F.in[15]; u.m2 = sc[2];
    f32x16 O[1][4];
    u.run(F.lds, O);
    const int lane = F.lane, wid = F.wave, r = lane & 31, h = lane >> 5, dvp = wid & 1, rbB = wid >> 1;
    const LAS float* lbuf = (const LAS float*)(F.lds + AT_L);
    bf16* Y = WSP(bf16, WS_YMEM);
#pragma unroll
    for (int i = 0; i < 16; ++i) { const int q = crow(i, h);
        const float il = frcp(lbuf[(rbB * 2 + 0) * 32 + q] + lbuf[(rbB * 2 + 1) * 32 + q]);
        bf16* yp = Y + (size_t)(b * SEQ + 128 * qb + 32 * rbB + q) * 1024 + hd * 256 + 128 * dvp + r;
#pragma unroll
        for (int blk = 0; blk < 4; ++blk) yp[32 * blk] = (bf16)(pk2(O[0][blk][i] * il, 0.f) & 0xffffu); }
    __syncthreads();
}

constexpr int GL_LA = 0;
constexpr int GL_VT = 32768;
constexpr int GL_KT = GL_VT + 36864;
constexpr int GL_KD = GL_KT + 20480;
constexpr int GL_ATT = GL_KD + 17408;
constexpr int GL_RED = GL_ATT + 9216;
constexpr int GL_SEG = GL_RED + 2048;
constexpr int GL_GY = GL_SEG + 2048;
static_assert(GL_GY + 32768 <= LDSCTL_OFF, "GLA LDS");
__device__ __forceinline__ void gla_load_la(LAS unsigned char* lds, const bf16* src, int tid) {
    const bf16* p = src + (size_t)(tid >> 3) * NZ + (tid & 7) * 8;
#pragma unroll
    for (int i = 0; i < 2; ++i) { const u32x4 v = *(const u32x4*)(p + 64 * i); LAS float* d = (LAS float*)(lds + GL_LA) + (tid >> 3) * 128 + ((tid & 7) + 8 * i) * 8;
        *(LAS f32x4*)d = (f32x4){bflo(v.x), bfhi(v.x), bflo(v.y), bfhi(v.y)}; *(LAS f32x4*)(d + 4) = (f32x4){bflo(v.z), bfhi(v.z), bflo(v.w), bfhi(v.w)}; }
}
__device__ __forceinline__ void gla_cumsum(LAS unsigned char* lds, int tid) {
    LAS float* la = (LAS float*)(lds + GL_LA) + (tid >> 7) * 16 * 128 + (tid & 127); LAS float* seg = (LAS float*)(lds + GL_SEG);
    float v[16];
#pragma unroll
    for (int i = 0; i < 16; ++i) v[i] = la[i * 128];
#pragma unroll
    for (int i = 1; i < 16; ++i) v[i] += v[i - 1];
    seg[tid] = v[15];
    __syncthreads();
    float off = 0.f;
#pragma unroll
    for (int sgi = 0; sgi < 3; ++sgi) off += (sgi < (tid >> 7)) ? seg[sgi * 128 + (tid & 127)] : 0.f;
#pragma unroll
    for (int i = 0; i < 16; ++i) la[i * 128] = v[i] + off;
}
__device__ __forceinline__ void gla_inc_unit(Frame& F, int bh, int n) {
    int tid = F.tid; asm volatile("" : "+v"(tid));
    const int lane = tid & 63, wid = F.wave, h = lane >> 5, b16 = (lane >> 4) & 1, q4 = (lane & 15) >> 2, p4 = lane & 3;
    const int b = bh >> 2, hd = bh & 3;
    const bf16* zrow = WSP(bf16, WS_Z) + (size_t)(b * SEQ + 64 * n) * NZ;
    LAS unsigned char* lds = F.lds;
    gla_load_la(lds, zrow + ZA_GLA + hd * 128, tid);
    u32x4 kr[2]; { const bf16* p = zrow + ZK_GLA + hd * 128 + (size_t)(tid >> 3) * NZ + (tid & 7) * 8; kr[0] = *(const u32x4*)p; kr[1] = *(const u32x4*)(p + 64); }
    { u32x4 vr[4]; tile_load(vr, zrow + ZV_GLA + hd * 256, NZ, tid); tile_store_raw(vr, lds + GL_VT, tid); }
    __syncthreads();
    gla_cumsum(lds, tid);
    __syncthreads();
    const LAS float* la = (const LAS float*)(lds + GL_LA);
#pragma unroll
    for (int i = 0; i < 2; ++i) { const int l = tid >> 3, d0 = ((tid & 7) + 8 * i) * 8;
        const f32x4 e0 = *(const LAS f32x4*)(la + 63 * 128 + d0), e1 = *(const LAS f32x4*)(la + 63 * 128 + d0 + 4), c0 = *(const LAS f32x4*)(la + l * 128 + d0), c1 = *(const LAS f32x4*)(la + l * 128 + d0 + 4);
        u32x4 w;
        w.x = pk2(bflo(kr[i].x) * fexp(e0[0] - c0[0]), bfhi(kr[i].x) * fexp(e0[1] - c0[1])); w.y = pk2(bflo(kr[i].y) * fexp(e0[2] - c0[2]), bfhi(kr[i].y) * fexp(e0[3] - c0[3]));
        w.z = pk2(bflo(kr[i].z) * fexp(e1[0] - c1[0]), bfhi(kr[i].z) * fexp(e1[1] - c1[1])); w.w = pk2(bflo(kr[i].w) * fexp(e1[2] - c1[2]), bfhi(kr[i].w) * fexp(e1[3] - c1[3]));
        *(LAS u32x4*)(lds + GL_KT + l * 320 + d0 * 2) = w; }
    if (tid < 128) WSP(float, WS_DEC)[(size_t)(bh * 64 + n) * 128 + tid] = fexp(la[63 * 128 + tid]);
    __syncthreads();
    f32x16 acc[4];
#pragma unroll
    for (int c = 0; c < 4; ++c)
#pragma unroll
        for (int i = 0; i < 16; ++i) acc[c][i] = 0.f;
#pragma unroll
    for (int s = 0; s < 4; ++s) {
        const bf16x8 af = trfrag(lds + GL_VT + (16 * s + 8 * h + q4) * VST + (32 * wid + 16 * b16 + 4 * p4) * 2, 4 * VST);
#pragma unroll
        for (int c = 0; c < 4; ++c) { const bf16x8 bf = trfrag(lds + GL_KT + (16 * s + 8 * h + q4) * 320 + (32 * c + 16 * b16 + 4 * p4) * 2, 4 * 320); acc[c] = MFMA32(af, bf, acc[c]); }
    }
    bf16* sb = WSP(bf16, WS_SB) + (size_t)(bh * 64 + n) * 256 * 128;
#pragma unroll
    for (int c = 0; c < 4; ++c)
#pragma unroll
        for (int i = 0; i < 16; ++i) sb[(size_t)(32 * wid + crow(i, h)) * 128 + 32 * c + (lane & 31)] = (bf16)(pk2(acc[c][i], 0.f) & 0xffffu);
    __syncthreads();
}
__device__ __forceinline__ void gla_scan(Frame& F) {
    const int NT = F.G * 512;
    for (int e = F.vcu * 512 + F.tid; e < 8 * 256 * 64; e += NT) {
        const int bh = e >> 14, rem = e & 16383, dv = rem >> 6, dk = (rem & 63) * 2;
        unsigned* sb = (unsigned*)(WSP(bf16, WS_SB) + (size_t)bh * 64 * 256 * 128 + (size_t)dv * 128 + dk);
        const float* dec = WSP(float, WS_DEC) + (size_t)bh * 64 * 128 + dk;
        float s0 = 0.f, s1 = 0.f;
#pragma unroll 8
        for (int n = 0; n < 64; ++n) { const unsigned inc = sb[(size_t)n * 256 * 64]; const f32x2 d = *(const f32x2*)(dec + n * 128);
            sb[(size_t)n * 256 * 64] = pk2(s0, s1); s0 = d.x * s0 + bflo(inc); s1 = d.y * s1 + bfhi(inc); }
    }
}
__device__ __forceinline__ void gla_out_unit(Frame& F, int bh, int n) {
    int tid = F.tid; asm volatile("" : "+v"(tid));
    const int lane = tid & 63, wid = F.wave, r = lane & 31, h = lane >> 5, b16 = (lane >> 4) & 1, q4 = (lane & 15) >> 2, p4 = lane & 3;
    const int b = bh >> 2, hd = bh & 3;
    const bf16* zrow = WSP(bf16, WS_Z) + (size_t)(b * SEQ + 64 * n) * NZ;
    LAS unsigned char* lds = F.lds;
    const bf16* sb = WSP(bf16, WS_SB) + (size_t)(bh * 64 + n) * 256 * 128 + (size_t)(32 * wid + r) * 128 + 8 * h;
    bf16x8 sf[8];
#pragma unroll
    for (int s = 0; s < 8; ++s) sf[s] = *(const bf16x8*)(sb + 16 * s);
    gla_load_la(lds, zrow + ZA_GLA + hd * 128, tid);
    u32x4 qr[2], kr[2];
    { const bf16* p = zrow + ZQ_GLA + hd * 128 + (size_t)(tid >> 3) * NZ + (tid & 7) * 8; qr[0] = *(const u32x4*)p; qr[1] = *(const u32x4*)(p + 64); }
    { const bf16* p = zrow + ZK_GLA + hd * 128 + (size_t)(tid >> 3) * NZ + (tid & 7) * 8; kr[0] = *(const u32x4*)p; kr[1] = *(const u32x4*)(p + 64); }
    { u32x4 vr[4]; tile_load(vr, zrow + ZV_GLA + hd * 256, NZ, tid); tile_store_raw(vr, lds + GL_VT, tid); }
    u32x4 gr[4]; tile_load(gr, zrow + ZG_GLA + hd * 256, NZ, tid);
    if (tid < 256) ((LAS float*)(lds + GL_RED))[tid] = F.in[7][tid];
    __syncthreads();
    gla_cumsum(lds, tid);
    __syncthreads();
    const LAS float* la = (const LAS float*)(lds + GL_LA);
    const float qs = 0.08838834764831845f;
#pragma unroll
    for (int i = 0; i < 2; ++i) { const int l = tid >> 3, d0 = ((tid & 7) + 8 * i) * 8;
        const f32x4 c0 = *(const LAS f32x4*)(la + l * 128 + d0), c1 = *(const LAS f32x4*)(la + l * 128 + d0 + 4);
        float ep[8], en[8];
#pragma unroll
        for (int e = 0; e < 4; ++e) { ep[e] = fexp(c0[e]); en[e] = fexp(-c0[e]); ep[4 + e] = fexp(c1[e]); en[4 + e] = fexp(-c1[e]); }
        u32x4 wq, wk;
        wq.x = pk2(bflo(qr[i].x) * qs * ep[0], bfhi(qr[i].x) * qs * ep[1]); wq.y = pk2(bflo(qr[i].y) * qs * ep[2], bfhi(qr[i].y) * qs * ep[3]);
        wq.z = pk2(bflo(qr[i].z) * qs * ep[4], bfhi(qr[i].z) * qs * ep[5]); wq.w = pk2(bflo(qr[i].w) * qs * ep[6], bfhi(qr[i].w) * qs * ep[7]);
        wk.x = pk2(bflo(kr[i].x) * en[0], bfhi(kr[i].x) * en[1]); wk.y = pk2(bflo(kr[i].y) * en[2], bfhi(kr[i].y) * en[3]);
        wk.z = pk2(bflo(kr[i].z) * en[4], bfhi(kr[i].z) * en[5]); wk.w = pk2(bflo(kr[i].w) * en[6], bfhi(kr[i].w) * en[7]);
        *(LAS u32x4*)(lds + GL_KT + l * 272 + d0 * 2) = wq; *(LAS u32x4*)(lds + GL_KD + l * 272 + d0 * 2) = wk; }
    __syncthreads();
    if (wid < 4) { const int mb = wid >> 1, lb = wid & 1; f32x16 st;
#pragma unroll
        for (int i = 0; i < 16; ++i) st[i] = 0.f;
#pragma unroll
        for (int s = 0; s < 8; ++s) { const bf16x8 kf = *(const LAS bf16x8*)(lds + GL_KD + (32 * mb + r) * 272 + (16 * s + 8 * h) * 2), qf = *(const LAS bf16x8*)(lds + GL_KT + (32 * lb + r) * 272 + (16 * s + 8 * h) * 2);
            st = MFMA32(kf, qf, st); }
        const int lrow = 32 * lb + r;
#pragma unroll
        for (int g = 0; g < 4; ++g) { float v[4];
#pragma unroll
            for (int e = 0; e < 4; ++e) { const int m = 32 * mb + 8 * g + 4 * h + e; v[e] = (m <= lrow) ? st[4 * g + e] : 0.f; }
            u32x2 w; w.x = pk2(v[0], v[1]); w.y = pk2(v[2], v[3]);
            *(LAS u32x2*)(lds + GL_ATT + lrow * PST + (32 * mb + 8 * g + 4 * h) * 2) = w; } }
    f32x16 acc[2];
#pragma unroll
    for (int lb = 0; lb < 2; ++lb)
#pragma unroll
        for (int i = 0; i < 16; ++i) acc[lb][i] = 0.f;
#pragma unroll
    for (int s = 0; s < 8; ++s)
#pragma unroll
        for (int lb = 0; lb < 2; ++lb) { const bf16x8 qf = *(const LAS bf16x8*)(lds + GL_KT + (32 * lb + r) * 272 + (16 * s + 8 * h) * 2); acc[lb] = MFMA32(qf, sf[s], acc[lb]); }
    __syncthreads();
#pragma unroll
    for (int s = 0; s < 4; ++s) { const bf16x8 vf = trfrag(lds + GL_VT + (16 * s + 8 * h + q4) * VST + (32 * wid + 16 * b16 + 4 * p4) * 2, 4 * VST);
#pragma unroll
        for (int lb = 0; lb < 2; ++lb) { const bf16x8 af = *(const LAS bf16x8*)(lds + GL_ATT + (32 * lb + r) * PST + (16 * s + 8 * h) * 2); acc[lb] = MFMA32(af, vf, acc[lb]); } }
#pragma unroll
    for (int lb = 0; lb < 2; ++lb)
#pragma unroll
        for (int i = 0; i < 16; ++i) { const int lr = crow(i, h);
            *(LAS float*)(lds + (lb ? GL_GY : GL_LA) + lr * 1024 + (((32 * wid + r) * 4) ^ ((lr & 1) << 4))) = acc[lb][i]; }
    __syncthreads();
    { const int l = tid >> 3, sw = (l & 1) << 4;
      const LAS unsigned char* orow = lds + ((l & 32) ? GL_GY : GL_LA) + (l & 31) * 1024;
      const LAS f32x4* gnt = (const LAS f32x4*)(lds + GL_RED);
      f32x4 o[4][2]; float ss = 0.f;
#pragma unroll
      for (int i = 0; i < 4; ++i) { const int c = (tid & 7) + 8 * i;
          o[i][0] = *(const LAS f32x4*)(orow + ((c * 32) ^ sw)); o[i][1] = *(const LAS f32x4*)(orow + ((c * 32 + 16) ^ sw));
#pragma unroll
          for (int e = 0; e < 4; ++e) ss += o[i][0][e] * o[i][0][e] + o[i][1][e] * o[i][1][e]; }
      ss += __shfl_xor(ss, 1); ss += __shfl_xor(ss, 2); ss += __shfl_xor(ss, 4);
      const float rn = frsq(ss * (1.0f / 256.0f) + NORM_EPS);
      bf16* Y = (bf16*)F.out + (size_t)(b * SEQ + 64 * n + l) * 1024 + hd * 256 + (tid & 7) * 8;
#pragma unroll
      for (int i = 0; i < 4; ++i) { const int c = (tid & 7) + 8 * i;
          const f32x4 g0 = gnt[2 * c], g1 = gnt[2 * c + 1];
          const unsigned gw[4] = {gr[i].x, gr[i].y, gr[i].z, gr[i].w};
          float y[8];
#pragma unroll
          for (int e = 0; e < 4; ++e) { const float ga = bflo(gw[e]), gb = bfhi(gw[e]);
              const float oa = (e < 2) ? o[i][0][2 * e] : o[i][1][2 * e - 4], ob = (e < 2) ? o[i][0][2 * e + 1] : o[i][1][2 * e - 3];
              const float na = (e < 2) ? g0[2 * e] : g1[2 * e - 4], nb = (e < 2) ? g0[2 * e + 1] : g1[2 * e - 3];
              y[2 * e] = oa * rn * na * (ga * sigmoidf_(ga)); y[2 * e + 1] = ob * rn * nb * (gb * sigmoidf_(gb)); }
          u32x4 w; w.x = pk2(y[0], y[1]); w.y = pk2(y[2], y[3]); w.z = pk2(y[4], y[5]); w.w = pk2(y[6], y[7]);
          *(u32x4*)(Y + 64 * i) = w; } }
    __syncthreads();
}

constexpr int N_PHASES = 9;
struct Args { const float* in[25]; float* out; unsigned char* ws; int ph_lo, ph_hi, li, pad; };
__global__ void __launch_bounds__(NWAVES * 64, 2) mk_fwd(Args args) {
    extern __shared__ __attribute__((aligned(16))) unsigned char lds_raw[];
    Frame F;
    F.lds = (LAS unsigned char*)lds_raw;
    F.tid = threadIdx.x; F.lane = F.tid & 63; F.wave = __builtin_amdgcn_readfirstlane(F.tid >> 6);
    F.G = gridDim.x; { const int bx = blockIdx.x; F.vcu = (F.G % 8 == 0) ? (bx % 8) * (F.G / 8) + bx / 8 : bx; }
#pragma unroll
    for (int i = 0; i < 25; ++i) F.in[i] = args.in[i];
    F.out = args.out; F.ws = args.ws;
    volatile LAS unsigned* MISC = (volatile LAS unsigned*)(F.lds + MISC_OFF);
    for (int u = F.tid; u < (LDS_BYTES - LDSCTL_OFF) / 4; u += NWAVES * 64) ((LAS unsigned*)(F.lds + LDSCTL_OFF))[u] = 0u;
    __syncthreads();
    gu32* ctl = (gu32*)(F.ws + WS_CTL);
    XcdBarrier bar; bar.bar = (unsigned*)(ctl + CW_BAR); bar.x = 0; bar.st = nullptr;
    if (MK_N_LAUNCHES == 1) bar = xcd_barrier_post((unsigned*)(ctl + CW_BAR), MISC + 8);
#define GRID_BAR() do { if (MK_N_LAUNCHES == 1) xcd_barrier(bar); } while (0)
    const int lo = args.ph_lo, hi = args.ph_hi;
#ifndef PHMASK
#define PHMASK 0x1ff
#endif
#define IN(k) (((PHMASK >> (k)) & 1) && lo <= (k) && (k) < hi)
#define BOTH(k) (IN(k) && IN((k) + 1))
#ifndef REPMASK
#define REPMASK 0
#endif
#define NREP(k) ((((REPMASK) >> (k)) & 1) ? rt2 : 1)
    const int G = F.G; const int rt2 = 1 + (args.ph_hi > 0);

    if (IN(0)) { for (int rep = 0; rep < NREP(0); ++rep) { p0_prologue(F); __syncthreads(); } if (BOTH(0)) GRID_BAR(); }
    if (IN(1)) {
        pg8::SchedP1 S; S.tm.init(TOK, NZ, WGM_P1); S.G = G; S.c = (int)blockIdx.x; S.A = (const char*)XBP; S.B = (const char*)WSP(bf16, WS_W1T);
        S.A2 = (const char*)WSP(bf16, WS_MEMB); S.B2 = (const char*)WSP(bf16, WS_WKVT); S.tstep = (size_t)256 * DM * 2;
        pg8::Epi1 E{WSP(bf16, WS_Z), WSP(bf16, WS_GATES), WSP(bf16, WS_KVM), WSP(float, WS_RINVX), WSP(float, WS_RINVM), F.in[6], F.in[20]};
#ifndef ONLY8
        for (int rep = 0; rep < NREP(1); ++rep) pg8::gemm_phase<pg8::Epi1, pg8::SchedP1, true, true>(F.lds, DM, S, E);
#endif
        { const int nfull = (S.tm.nwg + 16) % G;
          if (nfull > 0 && (int)blockIdx.x >= nfull) p1_tail_convert(F, nfull, G - nfull); else if (nfull == 0) p1_tail_convert(F, 0, G); }
        { pg8::SchedPlain S8; S8.tm.init(TOK, NGT, WGM_P1); S8.G = G; S8.c = (int)blockIdx.x; S8.A = (const char*)(F.ws + WS_XQ); S8.B = (const char*)(F.ws + WS_WG8); S8.tstep = (size_t)256 * DM;
          pg8::EpiG EG{WSP(bf16, WS_GATES), WSP(float, WS_RINVX), F.in[20]};
#ifndef NO8
          pg8::gemm_phase8<pg8::EpiG, pg8::SchedPlain, true, true>(F.lds, DM / 2, S8, EG);
#endif
        }
        if (BOTH(1)) GRID_BAR();
    }
    if (IN(2)) {
        { const int gw = F.vcu * NWAVES + F.wave, NGW = G * NWAVES;
            for (int it = gw; it < (MEMROWS / 8) * 4; it += NGW) knorm8<256>(WSP(bf16, WS_KVM) + (size_t)((it >> 2) * 8) * 2048 + (it & 3) * 256, 2048, F.in[16], F.lane);
            for (int it = gw; it < (TOK / 8) * 8; it += NGW) knorm8<128>(WSP(bf16, WS_Z) + (size_t)((it >> 3) * 8) * NZ + ZK_DIFF + (it & 7) * 128, NZ, F.in[9], F.lane); }
        for (int rep = 0; rep < NREP(2); ++rep) for (int u = F.vcu; u < 512; u += G) gla_inc_unit(F, u >> 6, u & 63);
        if (BOTH(2)) GRID_BAR();
    }
    if (IN(3)) { gla_scan(F); for (int rep = 0; rep < NREP(4); ++rep) for (int u = F.vcu; u < 256; u += G) mem_unit(F, u >> 7, (u >> 5) & 3, u & 31); if (BOTH(3)) GRID_BAR(); }
    if (IN(4)) {
#ifndef NO_GLAOUT
        for (int rep = 0; rep < NREP(6); ++rep) for (int u = F.vcu; u < 512; u += G) gla_out_unit(F, u >> 6, u & 63);
#endif
#ifndef NO_DIFF
        { BgConv bg; bg.src = F.in[23]; bg.gain = F.in[22]; bg.dst = WSP(bf16, WS_WFIT); bg.h = F.vcu * NWAVES + F.wave; bg.step = G * NWAVES;
          for (int rep = 0; rep < NREP(5); ++rep) for (int u = F.vcu; u < 256; u += G) { const int bh = u >> 5, c = u & 31; diff_unit<true>(F, bh, 63 - c, &bg); diff_unit<true>(F, bh, c, &bg); }
          for (; bg.h < BG_NH; bg.h += bg.step) { f32x4 v[4], gv; bg_load(bg, v, gv, F.lane); bg_store(bg, v, gv, F.lane); } }
#endif
        if (BOTH(4)) GRID_BAR();
    }
    if (IN(5)) {
        pg8::SchedP3 S; S.tm.init(TOK, DM, WGM_P3); S.G = G; S.c = (int)blockIdx.x; S.A = (const char*)F.out; S.A2 = (const char*)WSP(bf16, WS_YMEM); S.B = (const char*)WSP(bf16, WS_WBT);
        S.tstep = (size_t)256 * 1024 * 2; S.astride = (size_t)TOK * 1024 * 2; S.bstride = (size_t)DM * 1024 * 2;
        pg8::Epi3 E{WSP(bf16, WS_GATES), WSP(bf16, WS_MERGED)};
        for (int rep = 0; rep < NREP(7); ++rep) pg8::gemm_phase<pg8::Epi3, pg8::SchedP3, true, true>(F.lds, 1024, S, E);
        if (BOTH(5)) GRID_BAR();
    }
    if (IN(6)) {
        pg8::SchedPlain S; S.tm.init(TOK, DM, WGM_P4); S.G = G; S.c = (int)blockIdx.x; S.A = (const char*)WSP(bf16, WS_MERGED); S.B = (const char*)WSP(bf16, WS_WOT); S.tstep = (size_t)256 * DM * 2;
        pg8::Epi4 E{XBP, WSP(bf16, WS_X1B), WSP(float, WS_SS8)};
        for (int rep = 0; rep < NREP(8); ++rep) pg8::gemm_phase<pg8::Epi4, pg8::SchedPlain, false, true>(F.lds, DM, S, E);
        if (BOTH(6)) GRID_BAR();
    }
    if (IN(7)) {
        pg8::SchedPlain S; S.tm.init(TOK, 2 * DFF, WGM_P5); S.G = G; S.c = (int)blockIdx.x; S.A = (const char*)WSP(bf16, WS_X1B); S.B = (const char*)WSP(bf16, WS_WFIT); S.tstep = (size_t)256 * DM * 2;
        pg8::Epi5 E{WSP(float, WS_SS8), WSP(bf16, WS_ACT)};
        for (int rep = 0; rep < NREP(9); ++rep) pg8::gemm_phase<pg8::Epi5, pg8::SchedPlain, true, true>(F.lds, DM, S, E);
        { const int nfull = S.tm.nwg % G;
          if (nfull > 0 && (int)blockIdx.x >= nfull) p5_tail_convert(F, nfull, G - nfull); else if (nfull == 0) p5_tail_convert(F, 0, G); }
        if (BOTH(7)) GRID_BAR();
    }
    if (IN(8)) {
        pg8::SchedPlain S; S.tm.init(TOK, DM, WGM_P6); S.G = G; S.c = (int)blockIdx.x; S.A = (const char*)WSP(bf16, WS_ACT); S.B = (const char*)WSP(bf16, WS_WFDT); S.tstep = (size_t)256 * DFF * 2;
        pg8::Epi6 E{WSP(bf16, WS_X1B), F.out};
        pg8::gemm_phase<pg8::Epi6, pg8::SchedPlain, true, true>(F.lds, DFF, S, E);
    }
#undef IN
#undef BOTH
}

extern "C" void kernel_launch(void* const* d_in, const int* in_sizes, int n_in, void* d_out, int out_size, void* d_ws, size_t ws_size, hipStream_t stream) {
    static int grid = 0;
    if (grid == 0) {
        if (n_in != 25 || in_sizes[0] != TOK * DM || out_size != TOK * DM || ws_size < WS_END) {
            fprintf(stderr, "kernel_launch: unexpected problem: n_in %d in0 %d out %d ws %zu (need %zu)\n", n_in, n_in > 0 ? in_sizes[0] : -1, out_size, ws_size, (size_t)WS_END); grid = -1; return; }
        int dev = 0, cus = 0, per_cu = 0;
        if (hipGetDevice(&dev) != hipSuccess || hipDeviceGetAttribute(&cus, hipDeviceAttributeMultiprocessorCount, dev) != hipSuccess) { grid = -1; return; }
        if (hipFuncSetAttribute((const void*)mk_fwd, hipFuncAttributeMaxDynamicSharedMemorySize, LDS_BYTES) != hipSuccess) { fprintf(stderr, "kernel_launch: hipFuncSetAttribute failed\n"); grid = -1; return; }
        if (hipOccupancyMaxActiveBlocksPerMultiprocessor(&per_cu, (const void*)mk_fwd, NWAVES * 64, LDS_BYTES) != hipSuccess || per_cu < 1) { fprintf(stderr, "kernel_launch: occupancy query says %d\n", per_cu); per_cu = 1; }
        (void)hipGetLastError();
        grid = cus;
        if (grid != 256) fprintf(stderr, "kernel_launch: note: %d CUs (P4's epilogue expects 256 workgroups)\n", grid);
    }
    if (grid < 0) return;
    (void)hipMemsetAsync((char*)d_ws + WS_CTL, 0, CTL_ZERO_BYTES, stream);
    Args a{};
    for (int i = 0; i < 25; ++i) a.in[i] = (const float*)d_in[i];
    a.out = (float*)d_out; a.ws = (unsigned char*)d_ws;
    if (MK_N_LAUNCHES == 1) {
        a.ph_lo = 0; a.ph_hi = N_PHASES; a.li = 0;
        hipLaunchKernelGGL(mk_fwd, dim3(grid), dim3(NWAVES * 64), LDS_BYTES, stream, a);
    } else {
        for (int li = 0; li < N_PHASES; ++li) { a.ph_lo = li; a.ph_hi = li + 1; a.li = li; hipLaunchKernelGGL(mk_fwd, dim3(grid), dim3(NWAVES * 64), LDS_BYTES, stream, a); }
    }
}
```

```cpp
#include <hip/hip_runtime.h>
#include <cstdio>
#include <cstdint>

#ifndef MK_N_LAUNCHES
#define MK_N_LAUNCHES 1
#endif

#define WGM_P1 3
#define WGM_P3 3
#define WGM_P4 3
#define WGM_P5 3
#define WGM_P6 3
#define LAS __attribute__((address_space(3)))
#define GAS __attribute__((address_space(1)))
typedef unsigned short bf16;
typedef short bf16x8 __attribute__((ext_vector_type(8)));
typedef short s16x4 __attribute__((ext_vector_type(4)));
typedef float f32x2 __attribute__((ext_vector_type(2)));
typedef float f32x4 __attribute__((ext_vector_type(4)));
typedef float f32x16 __attribute__((ext_vector_type(16)));
typedef unsigned u32x2 __attribute__((ext_vector_type(2)));
typedef unsigned u32x4 __attribute__((ext_vector_type(4)));
typedef __bf16 bf16x2_t __attribute__((ext_vector_type(2)));
typedef GAS unsigned gu32;

constexpr int BATCH = 2, SEQ = 4096, DM = 2048, TOK = BATCH * SEQ;
constexpr int NMEM = 256, MEMROWS = BATCH * NMEM;
constexpr int DFF = 5632;
constexpr int NZ = 7680;
constexpr int NGT = 6144;
constexpr int N1 = NZ + NGT;
constexpr int ZQ_GLA = 0, ZK_GLA = 512, ZV_GLA = 1024, ZG_GLA = 2048, ZQ_DIFF = 3072, ZK_DIFF = 4096, ZV_DIFF = 5120, ZQ_MEM = 6144, ZA_GLA = 7168;
constexpr int WIN_LD = 7184;
constexpr float NORM_EPS = 1e-6f;
constexpr float LAM_INIT = 0.2f;
constexpr float LOG2E = 1.4426950408889634f;

constexpr size_t MiB = 1u << 20;
constexpr size_t WS_CTL = 0, CTL_ZERO_BYTES = 32768;
constexpr size_t WS_RINVX = 1 * MiB;
constexpr size_t WS_RINVM = WS_RINVX + 32768;
constexpr size_t WS_SC = WS_RINVM + 4096;
constexpr size_t WS_SS8 = WS_SC + 4096;
constexpr size_t WS_DEC = WS_SS8 + 262144;
static_assert(WS_DEC + 262144 <= 2 * MiB, "small region");
constexpr size_t WS_WOT = 2 * MiB;
constexpr size_t WS_WBT = 10 * MiB;
constexpr size_t WS_KVM = 22 * MiB;
constexpr size_t WS_RA = 24 * MiB;
constexpr size_t WS_W1T = WS_RA;
constexpr size_t WS_WG8 = WS_RA + 30 * MiB;
constexpr size_t WS_XQ = WS_RA + 42 * MiB;
constexpr size_t WS_YMEM = WS_RA + 44 * MiB;
constexpr size_t OUT_XB = 32 * MiB;
constexpr size_t WS_WKVT = WS_RA + 90 * MiB;
constexpr size_t WS_MEMB = WS_RA + 98 * MiB;
constexpr size_t WS_WFIT = WS_RA;
constexpr size_t WS_WFDT = WS_RA + 44 * MiB;
constexpr size_t WS_SB = WS_RA + 66 * MiB;
constexpr size_t WS_RZ = 128 * MiB;
constexpr size_t WS_Z = WS_RZ;
constexpr size_t WS_PART = WS_RZ;
constexpr size_t WS_MERGED = WS_RZ + 64 * MiB;
constexpr size_t WS_ACT = WS_RZ;
constexpr size_t WS_RG = 248 * MiB;
constexpr size_t WS_GATES = WS_RG;
constexpr size_t WS_X1B = WS_RG;
constexpr size_t WS_END = 344 * MiB;
constexpr int CW_TMO = 0, CW_BAR = 4096;

constexpr int RING_BYTES = 131072;
constexpr int LDS_BYTES = 163840;
constexpr int LDSCTL_OFF = LDS_BYTES - 1024, MISC_OFF = LDSCTL_OFF + 320;
constexpr int NWAVES = 8;

#define LDS_WAIT() asm volatile("s_waitcnt lgkmcnt(0)" ::: "memory")
#define VM_WAIT() asm volatile("s_waitcnt vmcnt(0)" ::: "memory")
#define RLX_AGENT __ATOMIC_RELAXED, __HIP_MEMORY_SCOPE_AGENT
__device__ __forceinline__ unsigned pk2(float lo, float hi) { f32x2 v = {lo, hi}; bf16x2_t b = __builtin_convertvector(v, bf16x2_t); return __builtin_bit_cast(unsigned, b); }
__device__ __forceinline__ float bflo(unsigned u) { return __uint_as_float(u << 16); }
__device__ __forceinline__ float bfhi(unsigned u) { return __uint_as_float(u & 0xffff0000u); }
__device__ __forceinline__ float bf1(bf16 v) { return __uint_as_float((unsigned)v << 16); }
__device__ __forceinline__ float fexp2(float x) { return __builtin_amdgcn_exp2f(x); }
__device__ __forceinline__ float fexp(float x) { return __builtin_amdgcn_exp2f(x * LOG2E); }
__device__ __forceinline__ float flog(float x) { return __builtin_amdgcn_logf(x) * 0.6931471805599453f; }
__device__ __forceinline__ float frcp(float x) { return __builtin_amdgcn_rcpf(x); }
__device__ __forceinline__ float frsq(float x) { return __builtin_amdgcn_rsqf(x); }
__device__ __forceinline__ float sigmoidf_(float x) { return frcp(1.0f + fexp(-x)); }
__device__ __forceinline__ float logsigmoidf_(float x) { return fminf(x, 0.f) - flog(1.0f + fexp(-fabsf(x))); }
__device__ __forceinline__ float wave_sum(float v) {
#pragma unroll
    for (int o = 1; o < 64; o <<= 1) v += __shfl_xor(v, o);
    return v;
}
__device__ __forceinline__ float wave_max(float v) {
#pragma unroll
    for (int o = 1; o < 64; o <<= 1) v = fmaxf(v, __shfl_xor(v, o));
    return v;
}
typedef short v4i16_t __attribute__((ext_vector_type(4)));
__device__ __forceinline__ s16x4 ldtr(LAS const unsigned char* p) { return __builtin_bit_cast(s16x4, __builtin_amdgcn_ds_read_tr16_b64_v4i16((LAS v4i16_t*)p)); }
__device__ __forceinline__ bf16x8 trfrag(LAS const unsigned char* p, int four_rows) {
    const s16x4 lo = ldtr(p), hi = ldtr(p + four_rows);
    return (bf16x8){lo[0], lo[1], lo[2], lo[3], hi[0], hi[1], hi[2], hi[3]};
}
__device__ __forceinline__ int crow(int r, int hi) { return (r & 3) + 8 * (r >> 2) + 4 * hi; }
#define MFMA32(a, b, c) __builtin_amdgcn_mfma_f32_32x32x16_bf16((a), (b), (c), 0, 0, 0)

namespace pg8 {
constexpr int BM = 256, BK = 64, HALF = 128, HTB = HALF * BK * 2, STAGE_BYTES = 8 * HTB, NXCD = 8, WGM = 8;
__host__ __device__ __forceinline__ int lds_byte(int r, int c) { const int st = (r >> 4) * 2 + (c >> 5), rr = r & 15, cc = c & 31, ob = rr * 64 + cc * 2; return st * 1024 + (ob ^ (((ob >> 9) & 1) << 5)); }
__host__ __device__ __forceinline__ void stage_rc(int b, int& R, int& C) { const int st = b / 1024, sb = b % 1024, swz = sb ^ (((sb >> 9) & 1) << 5); R = (st >> 1) * 16 + swz / 64; C = (st & 1) * 32 + (swz % 64) / 2; }
__host__ __device__ __forceinline__ int perm32(int rho) { const int n = rho >> 4, i = rho & 15; return 8 * (i >> 2) + 4 * n + (i & 3); }

struct Unit { int pm, pn, sub; };
struct TileMap {
    int nM, nN, nwg, wgm;
    __device__ __forceinline__ void init(int M, int N, int wgm_) { nM = M / BM; nN = N / BM; nwg = nM * nN; wgm = wgm_; }
    __device__ __forceinline__ void map(int L, int& pm, int& pn) const {
        int wgid = L; { const int q = nwg / NXCD, r = nwg % NXCD, xcd = wgid % NXCD, off = wgid / NXCD; wgid = (xcd < r ? xcd * (q + 1) : r * (q + 1) + (xcd - r) * q) + off; }
        const int nig = wgm * nN, gid = wgid / nig, fm = gid * wgm, gsz = (nM - fm) < wgm ? (nM - fm) : wgm;
        pm = fm + ((wgid % nig) % gsz); pn = (wgid % nig) / gsz;
    }
};
struct SchedPlain {
    TileMap tm; int G, c; const char* A; const char* B; size_t tstep;
    __device__ __forceinline__ bool next(int i, Unit& u) const { const long L = (long)i * G + c; if (L >= tm.nwg) return false; tm.map((int)L, u.pm, u.pn); u.sub = 0; return true; }
    __device__ __forceinline__ const char* aptr(const Unit& u) const { return A + (size_t)u.pm * tstep; }
    __device__ __forceinline__ const char* bptr(const Unit& u) const { return B + (size_t)u.pn * tstep; }
};
struct SchedP1 {
    TileMap tm; int G, c; const char* A; const char* B; const char* A2; const char* B2; size_t tstep;
    __device__ __forceinline__ bool next(int i, Unit& u) const {
        long L = (long)i * G + c; if (L < tm.nwg) { tm.map((int)L, u.pm, u.pn); u.sub = 0; return true; }
        L -= tm.nwg; if (L < 16) { u.pm = (int)(L & 1); u.pn = (int)(L >> 1); u.sub = 1; return true; } return false; }
    __device__ __forceinline__ const char* aptr(const Unit& u) const { return (u.sub ? A2 : A) + (size_t)u.pm * tstep; }
    __device__ __forceinline__ const char* bptr(const Unit& u) const { return (u.sub ? B2 : B) + (size_t)u.pn * tstep; }
};
struct SchedP3 {
    TileMap tm; int G, c; const char* A; const char* A2; const char* B; size_t tstep, astride, bstride;
    __device__ __forceinline__ bool next(int i, Unit& u) const { const int t = i / 3; const long L = (long)t * G + c; if (L >= tm.nwg) return false; tm.map((int)L, u.pm, u.pn); u.sub = i - 3 * t; return true; }
    __device__ __forceinline__ const char* aptr(const Unit& u) const { return (u.sub == 2 ? A2 : A + (size_t)u.sub * astride) + (size_t)u.pm * tstep; }
    __device__ __forceinline__ const char* bptr(const Unit& u) const { return B + (size_t)u.sub * bstride + (size_t)u.pn * tstep; }
};

typedef f32x4 Acc[2][2][4][2];

struct Epi1 {
    static constexpr bool PERM = true, AFTER_DRAIN = false;
    bf16* Z; bf16* GT; bf16* KVM; const float* rinvx; const float* rinvm; const float* b_alpha; const float* b_gate;
    __device__ __forceinline__ void operator()(const Acc& acc, const Unit& u, int wr, int wc, int fr, int fq) const {
        const int row0 = u.pm * BM + wr * 64 + fr; const int colt = u.pn * BM + wc * 32 + 8 * fq;
        int kind; bf16* base; int ld; const float* bias = nullptr; const float* rv = rinvx;
        if (u.sub) { kind = 0; base = KVM + colt; ld = 2048; rv = rinvm; }
        else if (u.pn < 28) { kind = 0; base = Z + colt; ld = NZ; }
        else if (u.pn < 30) { kind = 1; base = Z + colt; ld = NZ; bias = b_alpha + (colt - ZA_GLA); }
        else { kind = 2; base = GT + (colt - NZ); ld = NGT; bias = b_gate + (colt - NZ); }
        f32x4 bv[2][2];
#pragma unroll
        for (int bj = 0; bj < 2; ++bj)
#pragma unroll
            for (int n = 0; n < 2; ++n) bv[bj][n] = bias ? *(const f32x4*)(bias + bj * HALF + 4 * n) : (f32x4){0.f, 0.f, 0.f, 0.f};
        float rsv[2][4];
#pragma unroll
        for (int ai = 0; ai < 2; ++ai)
#pragma unroll
            for (int m = 0; m < 4; ++m) rsv[ai][m] = rv[row0 + ai * HALF + m * 16];
#pragma unroll
        for (int ai = 0; ai < 2; ++ai)
#pragma unroll
            for (int m = 0; m < 4; ++m) { const int row = row0 + ai * HALF + m * 16; const float rs = rsv[ai][m]; bf16* rowp = base + (size_t)row * ld;
#pragma unroll
                for (int bj = 0; bj < 2; ++bj) { f32x4 v0 = acc[ai][bj][m][0] * rs + bv[bj][0], v1 = acc[ai][bj][m][1] * rs + bv[bj][1];
                    if (kind == 1) {
#pragma unroll
                        for (int e = 0; e < 4; ++e) { v0[e] = logsigmoidf_(v0[e]) * 0.0625f; v1[e] = logsigmoidf_(v1[e]) * 0.0625f; } }
                    else if (kind == 2) {
#pragma unroll
                        for (int e = 0; e < 4; ++e) { v0[e] = sigmoidf_(v0[e]); v1[e] = sigmoidf_(v1[e]); } }
                    u32x4 w; w.x = pk2(v0[0], v0[1]); w.y = pk2(v0[2], v0[3]); w.z = pk2(v1[0], v1[1]); w.w = pk2(v1[2], v1[3]);
                    *(u32x4*)(rowp + bj * HALF) = w; } }
    }
};
struct EpiG {
    static constexpr bool PERM = true, AFTER_DRAIN = false;
    unsigned char* GT; const float* rinvx; const float* b_gate;
    __device__ __forceinline__ void operator()(const Acc& acc, const Unit& u, int wr, int wc, int fr, int fq) const {
        const int row0 = u.pm * BM + wr * 64 + fr; const int colt = u.pn * BM + wc * 32 + 8 * fq;
        f32x4 bv[2][2];
#pragma unroll
        for (int bj = 0; bj < 2; ++bj)
#pragma unroll
            for (int n = 0; n < 2; ++n) bv[bj][n] = *(const f32x4*)(b_gate + colt + bj * HALF + 4 * n);
        float rsv[2][4];
#pragma unroll
        for (int ai = 0; ai < 2; ++ai)
#pragma unroll
            for (int m = 0; m < 4; ++m) rsv[ai][m] = rinvx[row0 + ai * HALF + m * 16] * (1.0f / 512.0f);
#pragma unroll
        for (int ai = 0; ai < 2; ++ai)
#pragma unroll
            for (int m = 0; m < 4; ++m) { const int row = row0 + ai * HALF + m * 16; const float rs = rsv[ai][m]; unsigned char* rowp = GT + (size_t)row * NGT + colt;
#pragma unroll
                for (int bj = 0; bj < 2; ++bj) { f32x4 v0 = acc[ai][bj][m][0] * rs + bv[bj][0], v1 = acc[ai][bj][m][1] * rs + bv[bj][1];
                    unsigned q0[4], q1[4];
#pragma unroll
                    for (int e = 0; e < 4; ++e) { q0[e] = (unsigned)(sigmoidf_(v0[e]) * 255.0f + 0.5f); q1[e] = (unsigned)(sigmoidf_(v1[e]) * 255.0f + 0.5f); }
                    u32x2 w; w.x = q0[0] | (q0[1] << 8) | (q0[2] << 16) | (q0[3] << 24); w.y = q1[0] | (q1[1] << 8) | (q1[2] << 16) | (q1[3] << 24);
                    *(u32x2*)(rowp + bj * HALF) = w; } }
    }
};
struct Epi3 {
    static constexpr bool PERM = true, AFTER_DRAIN = false;
    const unsigned char* GT; bf16* MERGED;
    __device__ __forceinline__ void operator()(const Acc& acc, const Unit& u, int wr, int wc, int fr, int fq) const {
        const int row0 = u.pm * BM + wr * 64 + fr; const int col0 = u.pn * BM + wc * 32 + 8 * fq;
#pragma unroll
        for (int ai = 0; ai < 2; ++ai) {
            u32x2 g[4][2]; u32x4 p[4][2];
#pragma unroll
            for (int m = 0; m < 4; ++m)
#pragma unroll
                for (int bj = 0; bj < 2; ++bj) { const int row = row0 + ai * HALF + m * 16, col = col0 + bj * HALF;
                    g[m][bj] = *(const u32x2*)(GT + (size_t)row * NGT + u.sub * DM + col);
                    if (u.sub > 0) p[m][bj] = *(const u32x4*)(MERGED + (size_t)row * DM + col); else p[m][bj] = (u32x4){0u, 0u, 0u, 0u}; }
#pragma unroll
            for (int m = 0; m < 4; ++m)
#pragma unroll
                for (int bj = 0; bj < 2; ++bj) { const int row = row0 + ai * HALF + m * 16, col = col0 + bj * HALF; const u32x2 gg = g[m][bj]; const u32x4 pp = p[m][bj];
                    const f32x4 a0 = acc[ai][bj][m][0] * (1.0f / 255.0f), a1 = acc[ai][bj][m][1] * (1.0f / 255.0f);
                    u32x4 w;
                    w.x = pk2(a0[0] * (float)(gg.x & 0xffu) + bflo(pp.x), a0[1] * (float)((gg.x >> 8) & 0xffu) + bfhi(pp.x)); w.y = pk2(a0[2] * (float)((gg.x >> 16) & 0xffu) + bflo(pp.y), a0[3] * (float)(gg.x >> 24) + bfhi(pp.y));
                    w.z = pk2(a1[0] * (float)(gg.y & 0xffu) + bflo(pp.z), a1[1] * (float)((gg.y >> 8) & 0xffu) + bfhi(pp.z)); w.w = pk2(a1[2] * (float)((gg.y >> 16) & 0xffu) + bflo(pp.w), a1[3] * (float)(gg.y >> 24) + bfhi(pp.w));
                    *(u32x4*)(MERGED + (size_t)row * DM + col) = w; }
            asm volatile("" ::: "memory");
        }
    }
};
struct Epi4 {
    static constexpr bool PERM = true, AFTER_DRAIN = true;
    const bf16* X; bf16* X1B; float* SS8;
    __device__ __forceinline__ void fused(Acc& acc, const Unit& u, int wr, int wc, int fr, int fq, LAS unsigned char* lds, int wid, int lane) const {
        LAS float* P = (LAS float*)lds;
        const int row0 = u.pm * BM + wr * 64 + fr; const int col0 = u.pn * BM + wc * 32 + 8 * fq;
#pragma unroll
        for (int ai = 0; ai < 2; ++ai)
#pragma unroll
            for (int mp = 0; mp < 2; ++mp) {
                u32x4 xr[2][2];
#pragma unroll
                for (int mm = 0; mm < 2; ++mm)
#pragma unroll
                    for (int bj = 0; bj < 2; ++bj) { const size_t off = (size_t)(row0 + ai * HALF + (2 * mp + mm) * 16) * DM + col0 + bj * HALF; xr[mm][bj] = *(const u32x4*)(X + off); }
#pragma unroll
                for (int mm = 0; mm < 2; ++mm) { const int m = 2 * mp + mm; float s = 0.f;
#pragma unroll
                    for (int bj = 0; bj < 2; ++bj) { const size_t off = (size_t)(row0 + ai * HALF + m * 16) * DM + col0 + bj * HALF;
                        const u32x4 x = xr[mm][bj];
                        const f32x4 v0 = acc[ai][bj][m][0] + (f32x4){bflo(x.x), bfhi(x.x), bflo(x.y), bfhi(x.y)}, v1 = acc[ai][bj][m][1] + (f32x4){bflo(x.z), bfhi(x.z), bflo(x.w), bfhi(x.w)};
                        u32x4 w; w.x = pk2(v0[0], v0[1]); w.y = pk2(v0[2], v0[3]); w.z = pk2(v1[0], v1[1]); w.w = pk2(v1[2], v1[3]); *(u32x4*)(X1B + off) = w;
                        s += (v0[0] * v0[0] + v0[1] * v0[1]) + (v0[2] * v0[2] + v0[3] * v0[3]) + (v1[0] * v1[0] + v1[1] * v1[1]) + (v1[2] * v1[2] + v1[3] * v1[3]); }
                    s += __shfl_xor(s, 16); s += __shfl_xor(s, 32);
                    if (fq == 0) P[(ai * HALF + wr * 64 + m * 16 + fr) * 4 + wc] = s; }
                asm volatile("" ::: "memory");
            }
        LDS_WAIT(); __builtin_amdgcn_s_barrier(); asm volatile("" ::: "memory");
        const int t = wid * 64 + lane;
        if (t < 256) { const float s = (P[t * 4 + 0] + P[t * 4 + 1]) + (P[t * 4 + 2] + P[t * 4 + 3]); SS8[(size_t)(u.pm * BM + t) * 8 + u.pn] = s; }
    }
};
struct Epi5 {
    static constexpr bool PERM = true, AFTER_DRAIN = false;
    const float* SS8; bf16* ACT;
    __device__ __forceinline__ void operator()(const Acc& acc, const Unit& u, int wr, int wc, int fr, int fq) const {
        const int row0 = u.pm * BM + wr * 64 + fr; const int col0 = u.pn * HALF + wc * 32 + 8 * fq;
        float rsv[2][4];
#pragma unroll
        for (int ai = 0; ai < 2; ++ai)
#pragma unroll
            for (int m = 0; m < 4; ++m) { const int row = row0 + ai * HALF + m * 16;
                const f32x4 s0 = *(const f32x4*)(SS8 + (size_t)row * 8), s1 = *(const f32x4*)(SS8 + (size_t)row * 8 + 4);
                const float ss = ((s0[0] + s0[1]) + (s0[2] + s0[3])) + ((s1[0] + s1[1]) + (s1[2] + s1[3]));
                rsv[ai][m] = frsq(ss * (1.0f / DM) + NORM_EPS); }
#pragma unroll
        for (int ai = 0; ai < 2; ++ai)
#pragma unroll
            for (int m = 0; m < 4; ++m) { const int row = row0 + ai * HALF + m * 16; const float rs = rsv[ai][m];
                float o[8];
#pragma unroll
                for (int n = 0; n < 2; ++n)
#pragma unroll
                    for (int e = 0; e < 4; ++e) { const float g = acc[ai][0][m][n][e] * rs, up = acc[ai][1][m][n][e] * rs; o[4 * n + e] = g * sigmoidf_(g) * up; }
                u32x4 w; w.x = pk2(o[0], o[1]); w.y = pk2(o[2], o[3]); w.z = pk2(o[4], o[5]); w.w = pk2(o[6], o[7]);
                *(u32x4*)(ACT + (size_t)row * DFF + col0) = w; }
    }
};
struct Epi6 {
    static constexpr bool PERM = true, AFTER_DRAIN = false;
    const bf16* X1B; float* OUT;
    __device__ __forceinline__ void operator()(const Acc& acc, const Unit& u, int wr, int wc, int fr, int fq) const {
        const int row0 = u.pm * BM + wr * 64 + fr; const int col0 = u.pn * BM + wc * 32 + 8 * fq;
#pragma unroll
        for (int ai = 0; ai < 2; ++ai) {
            u32x4 xr[4][2];
#pragma unroll
            for (int m = 0; m < 4; ++m)
#pragma unroll
                for (int bj = 0; bj < 2; ++bj) xr[m][bj] = *(const u32x4*)(X1B + (size_t)(row0 + ai * HALF + m * 16) * DM + col0 + bj * HALF);
#pragma unroll
            for (int m = 0; m < 4; ++m)
#pragma unroll
                for (int bj = 0; bj < 2; ++bj) { float* p = OUT + (size_t)(row0 + ai * HALF + m * 16) * DM + col0 + bj * HALF; const u32x4 x = xr[m][bj];
                    *(f32x4*)p = (f32x4){bflo(x.x), bfhi(x.x), bflo(x.y), bfhi(x.y)} + acc[ai][bj][m][0]; *(f32x4*)(p + 4) = (f32x4){bflo(x.z), bfhi(x.z), bflo(x.w), bfhi(x.w)} + acc[ai][bj][m][1]; }
            asm volatile("" ::: "memory");
        }
    }
};

template <class Epi, class Sched, bool ALIGN_EPI, bool SP2>
__device__ __forceinline__ void gemm_phase(LAS unsigned char* lds, const int K, const Sched& S, const Epi& E) {
    const int tid = threadIdx.x, wid = __builtin_amdgcn_readfirstlane(tid >> 6), lane = tid & 63, wr = wid >> 2, wc = wid & 3, fr = lane & 15, fq = lane >> 4;
    const int nt = K / BK;
    unsigned voffA[2], voffB[2];
#pragma unroll
    for (int i = 0; i < 2; ++i) { int R, C; stage_rc(tid * 16 + i * 8192, R, C); const int Rb = Epi::PERM ? ((R & ~31) + perm32(R & 31)) : R;
        voffA[i] = (unsigned)(R * K + C) * 2u; voffB[i] = (unsigned)(Rb * K + C) * 2u; }
    const size_t kstep = (size_t)(BK * 2);
    const size_t hstep = (size_t)HALF * K * 2;
    const unsigned ldsw = (unsigned)wid * 1024u;
    const int aoff = lds_byte(wr * 64 + fr, fq * 8), boff = lds_byte(wc * 32 + fr, fq * 8);
#define PG8_SA(b, h) (((b) * 2 + (h)) * HTB)
#define PG8_SB(b, h) ((4 + (b) * 2 + (h)) * HTB)
#define PG8_STAGE(bufoff, gbase, voff) do { _Pragma("unroll") for (int _i = 0; _i < 2; ++_i) \
        __builtin_amdgcn_global_load_lds((const unsigned*)((const char*)(gbase) + (voff)[_i]), (LAS unsigned*)(lds + (bufoff) + ldsw + _i * 8192), 16, 0, 0); } while (0)
#define PG8_LDA(dst, b, h) do { _Pragma("unroll") for (int m = 0; m < 4; ++m) _Pragma("unroll") for (int k = 0; k < 2; ++k) dst[m][k] = *(const LAS bf16x8*)(lds + PG8_SA(b, h) + aoff + m * 2048 + k * 1024); } while (0)
#define PG8_LDB(dst, b, h) do { _Pragma("unroll") for (int n = 0; n < 2; ++n) _Pragma("unroll") for (int k = 0; k < 2; ++k) dst[n][k] = *(const LAS bf16x8*)(lds + PG8_SB(b, h) + boff + n * 2048 + k * 1024); } while (0)
#define PG8_MMA(ai, bj, At, Bt) do { __builtin_amdgcn_s_setprio(1); _Pragma("unroll") for (int m = 0; m < 4; ++m) _Pragma("unroll") for (int n = 0; n < 2; ++n) _Pragma("unroll") for (int k = 0; k < 2; ++k) \
        acc[ai][bj][m][n] = __builtin_amdgcn_mfma_f32_16x16x32_bf16(Bt[n][k], At[m][k], acc[ai][bj][m][n], 0, 0, 0); __builtin_amdgcn_s_setprio(0); } while (0)
#define PG8_WAIT_V(n) asm volatile("s_waitcnt vmcnt(" #n ")" ::: "memory")
#define PG8_WAIT_L(n) asm volatile("s_waitcnt lgkmcnt(" #n ")" ::: "memory")
#define PG8_BAR __builtin_amdgcn_s_barrier()
#define PG8_SCHED __builtin_amdgcn_sched_barrier(0)
    Unit cur, nxt; int ui = 0;
    if (!S.next(0, cur)) return;
    Acc acc;
#pragma unroll
    for (int a = 0; a < 2; ++a)
#pragma unroll
        for (int b = 0; b < 2; ++b)
#pragma unroll
            for (int m = 0; m < 4; ++m)
#pragma unroll
                for (int n = 0; n < 2; ++n) acc[a][b][m][n] = (f32x4){0.f, 0.f, 0.f, 0.f};
    bf16x8 At[4][2], B0[2][2], B1[2][2];
    const char* cA = S.aptr(cur); const char* cB = S.bptr(cur);
    if constexpr (SP2) {
        PG8_STAGE(PG8_SB(0, 0), cB, voffB); PG8_STAGE(PG8_SB(0, 1), cB + hstep, voffB); PG8_STAGE(PG8_SA(0, 0), cA, voffA); PG8_STAGE(PG8_SA(0, 1), cA + hstep, voffA);
        if (wr == 1) PG8_BAR;
        PG8_WAIT_V(2); PG8_BAR;
        PG8_STAGE(PG8_SB(1, 0), cB + kstep, voffB); PG8_STAGE(PG8_SA(1, 0), cA + kstep, voffA); PG8_STAGE(PG8_SB(1, 1), cB + hstep + kstep, voffB);
        PG8_WAIT_V(6); PG8_BAR;
    } else {
        PG8_STAGE(PG8_SB(0, 0), cB, voffB); PG8_STAGE(PG8_SA(0, 0), cA, voffA); PG8_STAGE(PG8_SB(0, 1), cB + hstep, voffB); PG8_STAGE(PG8_SA(0, 1), cA + hstep, voffA);
        if (wr == 1) PG8_BAR;
        PG8_WAIT_V(4); PG8_BAR;
        PG8_STAGE(PG8_SB(1, 0), cB + kstep, voffB); PG8_STAGE(PG8_SA(1, 0), cA + kstep, voffA); PG8_STAGE(PG8_SB(1, 1), cB + hstep + kstep, voffB);
        PG8_WAIT_V(6); PG8_BAR;
    }
    for (;;) {
        const bool has_next = S.next(ui + 1, nxt);
        const char* nA = has_next ? S.aptr(nxt) : cA; const char* nB = has_next ? S.bptr(nxt) : cB;
        for (int t = 0; t < nt; t += 2) {
            const bool last = (t == nt - 2);
            const char* a1 = cA + (size_t)(t + 1) * kstep;
            const char* a2 = last ? nA : cA + (size_t)(t + 2) * kstep; const char* b2 = last ? nB : cB + (size_t)(t + 2) * kstep;
            const char* a3 = a2 + kstep; const char* b3 = b2 + kstep;
            if constexpr (SP2) {
            PG8_LDB(B0, 0, 0); PG8_LDB(B1, 0, 1); PG8_SCHED; PG8_LDA(At, 0, 0); PG8_STAGE(PG8_SA(1, 1), a1 + hstep, voffA);
            PG8_WAIT_V(8); PG8_WAIT_L(0); PG8_BAR; PG8_MMA(0, 0, At, B0); PG8_MMA(0, 1, At, B1); PG8_BAR; PG8_SCHED;
            PG8_LDA(At, 0, 1); PG8_STAGE(PG8_SB(0, 0), b2, voffB); PG8_STAGE(PG8_SB(0, 1), b2 + hstep, voffB); PG8_STAGE(PG8_SA(0, 0), a2, voffA);
            PG8_WAIT_V(8); PG8_WAIT_L(0); PG8_BAR; PG8_MMA(1, 0, At, B0); PG8_MMA(1, 1, At, B1); PG8_BAR; PG8_SCHED;
            PG8_LDB(B0, 1, 0); PG8_LDB(B1, 1, 1); PG8_SCHED; PG8_LDA(At, 1, 0); PG8_STAGE(PG8_SA(0, 1), a2 + hstep, voffA);
            PG8_WAIT_V(8); PG8_WAIT_L(0); PG8_BAR; PG8_MMA(0, 0, At, B0); PG8_MMA(0, 1, At, B1); PG8_BAR; PG8_SCHED;
            PG8_LDA(At, 1, 1); PG8_STAGE(PG8_SB(1, 0), b3, voffB); PG8_STAGE(PG8_SB(1, 1), b3 + hstep, voffB); PG8_STAGE(PG8_SA(1, 0), a3, voffA);
            PG8_WAIT_V(8); PG8_WAIT_L(0); PG8_BAR; PG8_MMA(1, 0, At, B0); PG8_MMA(1, 1, At, B1); PG8_BAR; PG8_SCHED;
            } else {
            PG8_LDB(B0, 0, 0); PG8_SCHED; PG8_LDA(At, 0, 0); PG8_STAGE(PG8_SA(1, 1), a1 + hstep, voffA);
            PG8_WAIT_L(8); PG8_BAR; PG8_WAIT_L(0); PG8_MMA(0, 0, At, B0); PG8_BAR; PG8_SCHED;
            PG8_LDB(B1, 0, 1); PG8_STAGE(PG8_SB(0, 0), b2, voffB);
            PG8_BAR; PG8_WAIT_L(0); PG8_MMA(0, 1, At, B1); PG8_BAR;
            PG8_LDA(At, 0, 1); PG8_STAGE(PG8_SA(0, 0), a2, voffA);
            PG8_BAR; PG8_WAIT_L(0); PG8_MMA(1, 0, At, B0); PG8_BAR; PG8_SCHED;
            PG8_STAGE(PG8_SB(0, 1), b2 + hstep, voffB);
            PG8_WAIT_V(6); PG8_BAR; PG8_MMA(1, 1, At, B1); PG8_BAR;
            PG8_LDB(B0, 1, 0); PG8_SCHED; PG8_LDA(At, 1, 0); PG8_STAGE(PG8_SA(0, 1), a2 + hstep, voffA);
            PG8_WAIT_L(8); PG8_BAR; PG8_WAIT_L(0); PG8_MMA(0, 0, At, B0); PG8_BAR; PG8_SCHED;
            PG8_LDB(B1, 1, 1); PG8_STAGE(PG8_SB(1, 0), b3, voffB);
            PG8_BAR; PG8_WAIT_L(0); PG8_MMA(0, 1, At, B1); PG8_BAR;
            PG8_LDA(At, 1, 1); PG8_STAGE(PG8_SA(1, 0), a3, voffA);
            PG8_BAR; PG8_WAIT_L(0); PG8_MMA(1, 0, At, B0); PG8_BAR; PG8_SCHED;
            PG8_STAGE(PG8_SB(1, 1), b3 + hstep, voffB);
            PG8_WAIT_V(6); PG8_BAR; PG8_MMA(1, 1, At, B1); PG8_BAR;
            }
        }
        if constexpr (ALIGN_EPI) { if (wr == 0) PG8_BAR; }
        if constexpr (!Epi::AFTER_DRAIN) { E(acc, cur, wr, wc, fr, fq); }
        if (!has_next) break;
#pragma unroll
        for (int a = 0; a < 2; ++a)
#pragma unroll
            for (int b = 0; b < 2; ++b)
#pragma unroll
                for (int m = 0; m < 4; ++m)
#pragma unroll
                    for (int n = 0; n < 2; ++n) acc[a][b][m][n] = (f32x4){0.f, 0.f, 0.f, 0.f};
        cur = nxt; cA = nA; cB = nB; ++ui;
        if constexpr (ALIGN_EPI) { if (wr == 1) PG8_BAR; }
    }
    PG8_WAIT_V(0);
    if constexpr (!ALIGN_EPI) { if (wr == 0) PG8_BAR; }
    PG8_BAR;
    if constexpr (Epi::AFTER_DRAIN) { E.fused(acc, cur, wr, wc, fr, fq, lds, wid, lane); }
#undef PG8_SA
#undef PG8_SB
#undef PG8_STAGE
#undef PG8_LDA
#undef PG8_LDB
#undef PG8_MMA
#undef PG8_WAIT_V
#undef PG8_WAIT_L
#undef PG8_BAR
#undef PG8_SCHED
}
typedef int v8i_t __attribute__((ext_vector_type(8)));
typedef int v4i_t __attribute__((ext_vector_type(4)));
template <class Epi, class Sched, bool ALIGN_EPI, bool SP2>
__device__ __forceinline__ void gemm_phase8(LAS unsigned char* lds, const int K, const Sched& S, const Epi& E) {
    const int tid = threadIdx.x, wid = __builtin_amdgcn_readfirstlane(tid >> 6), lane = tid & 63, wr = wid >> 2, wc = wid & 3, fr = lane & 15, fq = lane >> 4;
    const int nt = K / BK;
    unsigned voffA[2], voffB[2];
#pragma unroll
    for (int i = 0; i < 2; ++i) { int R, C; stage_rc(tid * 16 + i * 8192, R, C); const int Rb = Epi::PERM ? ((R & ~31) + perm32(R & 31)) : R;
        voffA[i] = (unsigned)(R * K + C) * 2u; voffB[i] = (unsigned)(Rb * K + C) * 2u; }
    const size_t kstep = (size_t)(BK * 2);
    const size_t hstep = (size_t)HALF * K * 2;
    const unsigned ldsw = (unsigned)wid * 1024u;
    const int aoff = lds_byte(wr * 64 + fr, fq * 16), boff = lds_byte(wc * 32 + fr, fq * 16);
#define PG8_SA(b, h) (((b) * 2 + (h)) * HTB)
#define PG8_SB(b, h) ((4 + (b) * 2 + (h)) * HTB)
#define PG8_STAGE(bufoff, gbase, voff) do { _Pragma("unroll") for (int _i = 0; _i < 2; ++_i) \
        __builtin_amdgcn_global_load_lds((const unsigned*)((const char*)(gbase) + (voff)[_i]), (LAS unsigned*)(lds + (bufoff) + ldsw + _i * 8192), 16, 0, 0); } while (0)
#define PG8_LD32(p) __builtin_shufflevector(*(const LAS v4i_t*)(p), *(const LAS v4i_t*)((p) + 16), 0, 1, 2, 3, 4, 5, 6, 7)
#define PG8_LDA(dst, b, h) do { _Pragma("unroll") for (int m = 0; m < 4; ++m) dst[m] = PG8_LD32(lds + PG8_SA(b, h) + aoff + m * 2048); } while (0)
#define PG8_LDB(dst, b, h) do { _Pragma("unroll") for (int n = 0; n < 2; ++n) dst[n] = PG8_LD32(lds + PG8_SB(b, h) + boff + n * 2048); } while (0)
#define PG8_MMA(ai, bj, At, Bt) do { __builtin_amdgcn_s_setprio(1); _Pragma("unroll") for (int m = 0; m < 4; ++m) _Pragma("unroll") for (int n = 0; n < 2; ++n) \
        asm volatile("v_mfma_scale_f32_16x16x128_f8f6f4 %0, %1, %2, %0, %3, %3 op_sel_hi:[0,0,0]" : "+v"(acc[ai][bj][m][n]) : "v"(Bt[n]), "v"(At[m]), "v"(mxscale)); __builtin_amdgcn_s_setprio(0); } while (0)
#define PG8_WAIT_V(n) asm volatile("s_waitcnt vmcnt(" #n ")" ::: "memory")
#define PG8_WAIT_L(n) asm volatile("s_waitcnt lgkmcnt(" #n ")" ::: "memory")
#define PG8_BAR __builtin_amdgcn_s_barrier()
#define PG8_SCHED __builtin_amdgcn_sched_barrier(0)
    Unit cur, nxt; int ui = 0;
    if (!S.next(0, cur)) return;
    Acc acc;
#pragma unroll
    for (int a = 0; a < 2; ++a)
#pragma unroll
        for (int b = 0; b < 2; ++b)
#pragma unroll
            for (int m = 0; m < 4; ++m)
#pragma unroll
                for (int n = 0; n < 2; ++n) acc[a][b][m][n] = (f32x4){0.f, 0.f, 0.f, 0.f};
    v8i_t At[4], B0[2], B1[2]; int mxscale = 0x7f7f7f7f; asm volatile("" : "+v"(mxscale));
    const char* cA = S.aptr(cur); const char* cB = S.bptr(cur);
    if constexpr (SP2) {
        PG8_STAGE(PG8_SB(0, 0), cB, voffB); PG8_STAGE(PG8_SB(0, 1), cB + hstep, voffB); PG8_STAGE(PG8_SA(0, 0), cA, voffA); PG8_STAGE(PG8_SA(0, 1), cA + hstep, voffA);
        if (wr == 1) PG8_BAR;
        PG8_WAIT_V(2); PG8_BAR;
        PG8_STAGE(PG8_SB(1, 0), cB + kstep, voffB); PG8_STAGE(PG8_SA(1, 0), cA + kstep, voffA); PG8_STAGE(PG8_SB(1, 1), cB + hstep + kstep, voffB);
        PG8_WAIT_V(6); PG8_BAR;
    } else {
        PG8_STAGE(PG8_SB(0, 0), cB, voffB); PG8_STAGE(PG8_SA(0, 0), cA, voffA); PG8_STAGE(PG8_SB(0, 1), cB + hstep, voffB); PG8_STAGE(PG8_SA(0, 1), cA + hstep, voffA);
        if (wr == 1) PG8_BAR;
        PG8_WAIT_V(4); PG8_BAR;
        PG8_STAGE(PG8_SB(1, 0), cB + kstep, voffB); PG8_STAGE(PG8_SA(1, 0), cA + kstep, voffA); PG8_STAGE(PG8_SB(1, 1), cB + hstep + kstep, voffB);
        PG8_WAIT_V(6); PG8_BAR;
    }
    for (;;) {
        const bool has_next = S.next(ui + 1, nxt);
        const char* nA = has_next ? S.aptr(nxt) : cA; const char* nB = has_next ? S.bptr(nxt) : cB;
        for (int t = 0; t < nt; t += 2) {
            const bool last = (t == nt - 2);
            const char* a1 = cA + (size_t)(t + 1) * kstep;
            const char* a2 = last ? nA : cA + (size_t)(t + 2) * kstep; const char* b2 = last ? nB : cB + (size_t)(t + 2) * kstep;
            const char* a3 = a2 + kstep; const char* b3 = b2 + kstep;
            if constexpr (SP2) {
            PG8_LDB(B0, 0, 0); PG8_LDB(B1, 0, 1); PG8_SCHED; PG8_LDA(At, 0, 0); PG8_STAGE(PG8_SA(1, 1), a1 + hstep, voffA);
            PG8_WAIT_V(8); PG8_WAIT_L(0); PG8_BAR; PG8_MMA(0, 0, At, B0); PG8_MMA(0, 1, At, B1); PG8_BAR; PG8_SCHED;
            PG8_LDA(At, 0, 1); PG8_STAGE(PG8_SB(0, 0), b2, voffB); PG8_STAGE(PG8_SB(0, 1), b2 + hstep, voffB); PG8_STAGE(PG8_SA(0, 0), a2, voffA);
            PG8_WAIT_V(8); PG8_WAIT_L(0); PG8_BAR; PG8_MMA(1, 0, At, B0); PG8_MMA(1, 1, At, B1); PG8_BAR; PG8_SCHED;
            PG8_LDB(B0, 1, 0); PG8_LDB(B1, 1, 1); PG8_SCHED; PG8_LDA(At, 1, 0); PG8_STAGE(PG8_SA(0, 1), a2 + hstep, voffA);
            PG8_WAIT_V(8); PG8_WAIT_L(0); PG8_BAR; PG8_MMA(0, 0, At, B0); PG8_MMA(0, 1, At, B1); PG8_BAR; PG8_SCHED;
            PG8_LDA(At, 1, 1); PG8_STAGE(PG8_SB(1, 0), b3, voffB); PG8_STAGE(PG8_SB(1, 1), b3 + hstep, voffB); PG8_STAGE(PG8_SA(1, 0), a3, voffA);
            PG8_WAIT_V(8); PG8_WAIT_L(0); PG8_BAR; PG8_MMA(1, 0, At, B0); PG8_MMA(1, 1, At, B1); PG8_BAR; PG8_SCHED;
            } else {
            PG8_LDB(B0, 0, 0); PG8_SCHED; PG8_LDA(At, 0, 0); PG8_STAGE(PG8_SA(1, 1), a1 + hstep, voffA);
            PG8_WAIT_L(8); PG8_BAR; PG8_WAIT_L(0); PG8_MMA(0, 0, At, B0); PG8_BAR; PG8_SCHED;
            PG8_LDB(B1, 0, 1); PG8_STAGE(PG8_SB(0, 0), b2, voffB);
            PG8_BAR; PG8_WAIT_L(0); PG8_MMA(0, 1, At, B1); PG8_BAR;
            PG8_LDA(At, 0, 1); PG8_STAGE(PG8_SA(0, 0), a2, voffA);
            PG8_BAR; PG8_WAIT_L(0); PG8_MMA(1, 0, At, B0); PG8_BAR; PG8_SCHED;
            PG8_STAGE(PG8_SB(0, 1), b2 + hstep, voffB);
            PG8_WAIT_V(6); PG8_BAR; PG8_MMA(1, 1, At, B1); PG8_BAR;
            PG8_LDB(B0, 1, 0); PG8_SCHED; PG8_LDA(At, 1, 0); PG8_STAGE(PG8_SA(0, 1), a2 + hstep, voffA);
            PG8_WAIT_L(8); PG8_BAR; PG8_WAIT_L(0); PG8_MMA(0, 0, At, B0); PG8_BAR; PG8_SCHED;
            PG8_LDB(B1, 1, 1); PG8_STAGE(PG8_SB(1, 0), b3, voffB);
            PG8_BAR; PG8_WAIT_L(0); PG8_MMA(0, 1, At, B1); PG8_BAR;
            PG8_LDA(At, 1, 1); PG8_STAGE(PG8_SA(1, 0), a3, voffA);
            PG8_BAR; PG8_WAIT_L(0); PG8_MMA(1, 0, At, B0); PG8_BAR; PG8_SCHED;
            PG8_STAGE(PG8_SB(1, 1), b3 + hstep, voffB);
            PG8_WAIT_V(6); PG8_BAR; PG8_MMA(1, 1, At, B1); PG8_BAR;
            }
        }
        if constexpr (ALIGN_EPI) { if (wr == 0) PG8_BAR; }
        asm volatile("s_nop 15\n\ts_nop 7" ::: "memory");
        if constexpr (!Epi::AFTER_DRAIN) { E(acc, cur, wr, wc, fr, fq); }
        if (!has_next) break;
#pragma unroll
        for (int a = 0; a < 2; ++a)
#pragma unroll
            for (int b = 0; b < 2; ++b)
#pragma unroll
                for (int m = 0; m < 4; ++m)
#pragma unroll
                    for (int n = 0; n < 2; ++n) acc[a][b][m][n] = (f32x4){0.f, 0.f, 0.f, 0.f};
        cur = nxt; cA = nA; cB = nB; ++ui;
        if constexpr (ALIGN_EPI) { if (wr == 1) PG8_BAR; }
    }
    PG8_WAIT_V(0);
    if constexpr (!ALIGN_EPI) { if (wr == 0) PG8_BAR; }
    PG8_BAR;
    if constexpr (Epi::AFTER_DRAIN) { E.fused(acc, cur, wr, wc, fr, fq, lds, wid, lane); }
#undef PG8_SA
#undef PG8_SB
#undef PG8_STAGE
#undef PG8_LDA
#undef PG8_LDB
#undef PG8_MMA
#undef PG8_LD32
#undef PG8_WAIT_V
#undef PG8_WAIT_L
#undef PG8_BAR
#undef PG8_SCHED
}
}

#define XB_TMO      128
#define XB_XCNT(j)  (256  + 64 * (j))
#define XB_XSUB(j)  (1280 + 64 * (j))
#define XB_XGEN(j)  (2304 + 64 * (j))
#define XB_TOP      3328
#define XB_TOPGEN   3392
#define XCD_BAR_WORDS 3456
#define XB_SPIN_CAP (1u << 20)
__device__ __forceinline__ unsigned xb_ld(unsigned* p)              { return __hip_atomic_load(p, __ATOMIC_RELAXED, __HIP_MEMORY_SCOPE_AGENT); }
__device__ __forceinline__ unsigned xb_add(unsigned* p, unsigned v) { return __hip_atomic_fetch_add(p, v, __ATOMIC_RELAXED, __HIP_MEMORY_SCOPE_AGENT); }
__device__ __forceinline__ unsigned xb_xcc_id() { return (unsigned)__builtin_amdgcn_s_getreg((3 << 11) | 20) & 0xFu; }
#define XB_SPIN(cond, bar) do { unsigned _sp = 0; while (cond) { __builtin_amdgcn_s_sleep(1); \
    if ((++_sp & 255u) == 0u) { if (xb_ld(&(bar)[XB_TMO])) break; if (_sp > XB_SPIN_CAP) { atomicAdd(&(bar)[XB_TMO], 1u); break; } } } } while (0)
struct XcdBarrier { unsigned* bar; unsigned x; volatile LAS unsigned* st; };
__device__ __forceinline__ XcdBarrier xcd_barrier_post(unsigned* bar, volatile LAS unsigned* st) {
    XcdBarrier b; b.bar = bar; b.x = xb_xcc_id(); b.st = st;
    if (threadIdx.x == 0) (void)xb_add(&bar[XB_XCNT(b.x)], 1u);
    return b;
}
__device__ __forceinline__ void xcd_barrier_complete(unsigned* bar, unsigned x, unsigned& nloc, unsigned& nx) {
    const unsigned G = gridDim.x * gridDim.y * gridDim.z;
    unsigned sum, cnt, mine, sp = 0u;
    for (;;) {
        sum = 0u; cnt = 0u; mine = 0u;
#pragma unroll
        for (unsigned j = 0; j < 16; ++j) { const unsigned c = xb_ld(&bar[XB_XCNT(j)]); sum += c; cnt += (c > 0u) ? 1u : 0u; mine = (j == x) ? c : mine; }
        if (sum == G) break;
        __builtin_amdgcn_s_sleep(1);
        if ((++sp & 255u) == 0u) { if (xb_ld(&bar[XB_TMO])) break; if (sp > XB_SPIN_CAP) { atomicAdd(&bar[XB_TMO], 1u); break; } }
    }
    nloc = mine > 0u ? mine : 1u; nx = cnt > 0u ? cnt : 1u;
}
__device__ __forceinline__ void xcd_barrier(const XcdBarrier& b) {
    asm volatile("s_waitcnt vmcnt(0)" ::: "memory");
    __syncthreads();
    if (threadIdx.x == 0) {
        unsigned* bar = b.bar;
        __builtin_amdgcn_s_waitcnt(0);
        unsigned nloc = b.st[0], nx = b.st[1];
        if (nloc == 0u) { xcd_barrier_complete(bar, b.x, nloc, nx); b.st[0] = nloc; b.st[1] = nx; }
        const unsigned old = xb_add(&bar[XB_XSUB(b.x)], 1u);
        const unsigned gen = old / nloc;
        if (old + 1u == (gen + 1u) * nloc) {
            __builtin_amdgcn_fence(__ATOMIC_RELEASE, "agent");
            asm volatile("s_waitcnt vmcnt(0)" ::: "memory");
            const unsigned og = xb_add(&bar[XB_TOP], 1u);
            const unsigned tg = og / nx;
            if (og + 1u == (tg + 1u) * nx) xb_add(&bar[XB_TOPGEN], 1u);
            else XB_SPIN(xb_ld(&bar[XB_TOPGEN]) == tg, bar);
            __builtin_amdgcn_fence(__ATOMIC_ACQUIRE, "agent");
            xb_add(&bar[XB_XGEN(b.x)], 1u);
            asm volatile("s_waitcnt vmcnt(0)" ::: "memory");
        } else {
            XB_SPIN(xb_ld(&bar[XB_XGEN(b.x)]) == gen, bar);
            __builtin_amdgcn_fence(__ATOMIC_ACQUIRE, "agent");
            asm volatile("s_waitcnt vmcnt(0)" ::: "memory");
        }
    }
    __syncthreads();
}

struct Frame {
    LAS unsigned char* lds;
    int tid, lane, wave, vcu, G;
    const float* in[25]; float* out; unsigned char* ws;
};
#define WSP(T, off) ((T*)(F.ws + (off)))
#define XBP ((bf16*)((unsigned char*)F.out + OUT_XB))

struct TrItem { const float* src; const float* gain; bf16* dst; int ldw, K, f8; };
__device__ __forceinline__ unsigned pk4_fp8(float a, float b, float c, float d) { int p = 0; p = __builtin_amdgcn_cvt_pk_fp8_f32(a, b, p, false); p = __builtin_amdgcn_cvt_pk_fp8_f32(c, d, p, true); return (unsigned)p; }
__device__ __forceinline__ void tr_load(f32x4 (&v)[8], const TrItem& t, int lane) {
    const float* p = t.src + (size_t)(8 * (lane & 7)) * t.ldw + 4 * (lane >> 3);
#pragma unroll
    for (int j = 0; j < 8; ++j) v[j] = __builtin_nontemporal_load((const f32x4*)(p + (size_t)j * t.ldw));
}
__device__ __forceinline__ void tr_store(const f32x4 (&v)[8], const TrItem& t, int lane) {
    float g[8];
    if (t.gain) { const f32x4 g0 = *(const f32x4*)(t.gain + 8 * (lane & 7)), g1 = *(const f32x4*)(t.gain + 8 * (lane & 7) + 4);
        g[0] = g0[0]; g[1] = g0[1]; g[2] = g0[2]; g[3] = g0[3]; g[4] = g1[0]; g[5] = g1[1]; g[6] = g1[2]; g[7] = g1[3]; }
    else {
#pragma unroll
        for (int j = 0; j < 8; ++j) g[j] = 1.0f; }
    if (t.f8) {
        unsigned char* d8 = (unsigned char*)t.dst + (size_t)(4 * (lane >> 3)) * t.K + 8 * (lane & 7);
#pragma unroll
        for (int i = 0; i < 4; ++i) { u32x2 o; o.x = pk4_fp8(v[0][i] * g[0] * 64.f, v[1][i] * g[1] * 64.f, v[2][i] * g[2] * 64.f, v[3][i] * g[3] * 64.f);
            o.y = pk4_fp8(v[4][i] * g[4] * 64.f, v[5][i] * g[5] * 64.f, v[6][i] * g[6] * 64.f, v[7][i] * g[7] * 64.f);
            *(GAS u32x2*)(d8 + (size_t)i * t.K) = o; }
        return; }
    bf16* d = t.dst + (size_t)(4 * (lane >> 3)) * t.K + 8 * (lane & 7);
#pragma unroll
    for (int i = 0; i < 4; ++i) { u32x4 o; o.x = pk2(v[0][i] * g[0], v[1][i] * g[1]); o.y = pk2(v[2][i] * g[2], v[3][i] * g[3]); o.z = pk2(v[4][i] * g[4], v[5][i] * g[5]); o.w = pk2(v[6][i] * g[6], v[7][i] * g[7]);
        *(GAS u32x4*)(d + (size_t)i * t.K) = o; }
}
__device__ __forceinline__ void tr_alpha(const float* win, const float* wup, const float* gain, bf16* dst, int k0, int n0, int lane) {
    const int lk = lane & 7, ln = lane >> 3;
    f32x4 wu[16];
#pragma unroll
    for (int r = 0; r < 16; ++r) wu[r] = *(const f32x4*)(wup + r * 512 + n0 + 4 * ln);
    f32x4 v[8];
#pragma unroll
    for (int j = 0; j < 8; ++j) { const float* a = win + (size_t)(k0 + 8 * lk + j) * WIN_LD + 3072; f32x4 acc = {0.f, 0.f, 0.f, 0.f};
#pragma unroll
        for (int r4 = 0; r4 < 4; ++r4) { const f32x4 av = *(const f32x4*)(a + 4 * r4); acc += wu[4 * r4] * av[0] + wu[4 * r4 + 1] * av[1] + wu[4 * r4 + 2] * av[2] + wu[4 * r4 + 3] * av[3]; }
        v[j] = acc; }
    TrItem t; t.f8 = 0; t.src = nullptr; t.gain = gain + k0; t.dst = dst + (size_t)n0 * DM + k0; t.ldw = 0; t.K = DM;
    tr_store(v, t, lane);
}
__device__ __forceinline__ void row_to_bf16(const float* xrow, bf16* orow, float* rinv, int lane, unsigned* qrow = nullptr) {
    const GAS f32x4* xr = (const GAS f32x4*)xrow + lane;
    f32x4 v[8]; float s = 0.f;
#pragma unroll
    for (int j = 0; j < 8; ++j) { v[j] = __builtin_nontemporal_load(xr + 64 * j); s += (v[j].x * v[j].x + v[j].y * v[j].y) + (v[j].z * v[j].z + v[j].w * v[j].w); }
    s = wave_sum(s);
    if (lane == 0) *rinv = 1.0f / sqrtf(s * (1.0f / DM) + NORM_EPS);
    GAS u32x2* o8 = (GAS u32x2*)orow + lane;
#pragma unroll
    for (int j = 0; j < 8; ++j) { u32x2 w; w.x = pk2(v[j].x, v[j].y); w.y = pk2(v[j].z, v[j].w); o8[64 * j] = w; }
    if (qrow) {
#pragma unroll
        for (int j = 0; j < 8; ++j) ((GAS unsigned*)qrow)[lane + 64 * j] = pk4_fp8(v[j].x * 8.f, v[j].y * 8.f, v[j].z * 8.f, v[j].w * 8.f); }
}

__device__ __forceinline__ TrItem p0_item(Frame& F, int r) {
    constexpr int I_A = 32 * 96, I_B = 32 * 128, I_G = 32 * 192;
    const float* w_in = F.in[4]; const float* g_mix = F.in[2]; bf16* W1T = WSP(bf16, WS_W1T);
    TrItem t; t.f8 = 0;
    if (r < I_A) { const int kb = r / 96, nb = r % 96; t.src = w_in + (size_t)(64 * kb) * WIN_LD + 32 * nb; t.ldw = WIN_LD; t.gain = g_mix + 64 * kb; t.dst = W1T + (size_t)(32 * nb) * DM + 64 * kb; t.K = DM; return t; } r -= I_A;
    if (r < I_B) { const int kb = r / 128, nb = r % 128; t.src = w_in + (size_t)(64 * kb) * WIN_LD + 3088 + 32 * nb; t.ldw = WIN_LD; t.gain = g_mix + 64 * kb; t.dst = W1T + (size_t)(3072 + 32 * nb) * DM + 64 * kb; t.K = DM; return t; } r -= I_B;
    if (r < I_G) { const int kb = r / 192, nb = r % 192; t.src = F.in[19] + (size_t)(64 * kb) * NGT + 32 * nb; t.ldw = NGT; t.gain = g_mix + 64 * kb; t.dst = (bf16*)(F.ws + WS_WG8 + (size_t)(32 * nb) * DM + 64 * kb); t.K = DM; t.f8 = 1; return t; } r -= I_G;
    { const int kb = r / 64, nb = r % 64; t.src = F.in[17] + (size_t)(64 * kb) * 2048 + 32 * nb; t.ldw = 2048; t.gain = F.in[3] + 64 * kb; t.dst = WSP(bf16, WS_WKVT) + (size_t)(32 * nb) * DM + 64 * kb; t.K = DM; return t; }
}
__device__ __forceinline__ TrItem p1t_item(Frame& F, int r) {
    constexpr int I_BR = 3 * 16 * 64;
    TrItem t; t.f8 = 0;
    if (r < I_BR) { const int br = r / 1024, q = r % 1024, kb = q / 64, nb = q % 64;
        t.src = F.in[18] + (size_t)br * 1024 * 2048 + (size_t)(64 * kb) * 2048 + 32 * nb; t.ldw = 2048; t.gain = nullptr; t.dst = WSP(bf16, WS_WBT) + (size_t)br * 2048 * 1024 + (size_t)(32 * nb) * 1024 + 64 * kb; t.K = 1024; return t; } r -= I_BR;
    { const int kb = r / 64, nb = r % 64; t.src = F.in[21] + (size_t)(64 * kb) * 2048 + 32 * nb; t.ldw = 2048; t.gain = nullptr; t.dst = WSP(bf16, WS_WOT) + (size_t)(32 * nb) * DM + 64 * kb; t.K = DM; return t; }
}
__device__ __forceinline__ TrItem p2_item(Frame& F, int r) {
    TrItem t; t.f8 = 0;
    { const int kb = r / 352, nb = r % 352; const int j0 = 32 * nb; const int drow = (j0 < DFF) ? (256 * (j0 / 128) + (j0 % 128)) : (256 * ((j0 - DFF) / 128) + 128 + ((j0 - DFF) % 128));
        t.src = F.in[23] + (size_t)(64 * kb) * (2 * DFF) + j0; t.ldw = 2 * DFF; t.gain = F.in[22] + 64 * kb; t.dst = WSP(bf16, WS_WFIT) + (size_t)drow * DM + 64 * kb; t.K = DM; return t; }
}
__device__ __forceinline__ TrItem p5t_item(Frame& F, int r) {
    TrItem t; t.f8 = 0;
    { const int kb = r / 64, nb = r % 64; t.src = F.in[24] + (size_t)(64 * kb) * DM + 32 * nb; t.ldw = DM; t.gain = nullptr; t.dst = WSP(bf16, WS_WFDT) + (size_t)(32 * nb) * DFF + 64 * kb; t.K = DFF; return t; }
}
#define TR_RUN(DECODE, NITEMS) do { \
    for (int it = gw; it < (NITEMS); it += 4 * NGW) { const int it2 = it + NGW, it3 = it + 2 * NGW, it4 = it + 3 * NGW; const bool two = it2 < (NITEMS), three = it3 < (NITEMS), four = it4 < (NITEMS); \
        const TrItem ta = DECODE(F, it); const TrItem tb = DECODE(F, two ? it2 : it); const TrItem tc = DECODE(F, three ? it3 : it); const TrItem td = DECODE(F, four ? it4 : it); \
        f32x4 va[8], vb[8], vc[8], vd[8]; tr_load(va, ta, F.lane); if (two) tr_load(vb, tb, F.lane); if (three) tr_load(vc, tc, F.lane); if (four) tr_load(vd, td, F.lane); \
        tr_store(va, ta, F.lane); if (two) tr_store(vb, tb, F.lane); if (three) tr_store(vc, tc, F.lane); if (four) tr_store(vd, td, F.lane); } } while (0)

__device__ __forceinline__ void p0_prologue(Frame& F) {
    const int gw = F.vcu * NWAVES + F.wave, NGW = F.G * NWAVES;
    constexpr int NITEMS = 32 * 96 + 32 * 128 + 32 * 192 + 32 * 64;
    TR_RUN(p0_item, NITEMS);
    for (int it = gw; it < 32 * 16; it += NGW) { const int kb = it / 16, nb = it % 16; tr_alpha(F.in[4], F.in[5], F.in[2], WSP(bf16, WS_W1T) + (size_t)ZA_GLA * DM, 64 * kb, 32 * nb, F.lane); }
    for (int m = gw; m < TOK; m += NGW) row_to_bf16(F.in[0] + (size_t)m * DM, XBP + (size_t)m * DM, WSP(float, WS_RINVX) + m, F.lane, (unsigned*)(F.ws + WS_XQ + (size_t)m * DM));
    for (int m = gw; m < MEMROWS; m += NGW) row_to_bf16(F.in[1] + (size_t)m * DM, WSP(bf16, WS_MEMB) + (size_t)m * DM, WSP(float, WS_RINVM) + m, F.lane);
    if (gw == 0) {
        const int l = F.lane;
        float d1 = F.in[10][l] * F.in[11][l] + F.in[10][l + 64] * F.in[11][l + 64];
        float d2 = F.in[12][l] * F.in[13][l] + F.in[12][l + 64] * F.in[13][l + 64];
        d1 = wave_sum(d1); d2 = wave_sum(d2);
        const float gq = wave_max(fmaxf(fabsf(F.in[8][l]), fabsf(F.in[8][l + 64]))), gk = wave_max(fmaxf(fabsf(F.in[9][l]), fabsf(F.in[9][l + 64])));
        const float mq = wave_max(fmaxf(fmaxf(fabsf(F.in[15][l]), fabsf(F.in[15][l + 64])), fmaxf(fabsf(F.in[15][l + 128]), fabsf(F.in[15][l + 192]))));
        const float mk = wave_max(fmaxf(fmaxf(fabsf(F.in[16][l]), fabsf(F.in[16][l + 64])), fmaxf(fabsf(F.in[16][l + 128]), fabsf(F.in[16][l + 192]))));
        if (l == 0) { float* sc = WSP(float, WS_SC); sc[0] = expf(d1) - expf(d2) + LAM_INIT; sc[1] = 11.313708499f * gq * gk * LOG2E; sc[2] = 16.0f * mq * mk * LOG2E; }
    }
}
__device__ __forceinline__ void p2_convert(Frame& F) {
    const int gw = F.vcu * NWAVES + F.wave, NGW = F.G * NWAVES;
    TR_RUN(p2_item, 32 * 352);
}
template <int DH>
__device__ __forceinline__ void knorm8(bf16* base  , size_t ld, const float* gain, int lane) {
    constexpr int NCH = DH / 64;
    bf16* p = base + (size_t)(lane >> 3) * ld + (lane & 7) * 8;
    u32x4 v[NCH]; float ss = 0.f;
#pragma unroll
    for (int i = 0; i < NCH; ++i) { v[i] = *(const u32x4*)(p + 64 * i);
        const float a0 = bflo(v[i].x), a1 = bfhi(v[i].x), a2 = bflo(v[i].y), a3 = bfhi(v[i].y), a4 = bflo(v[i].z), a5 = bfhi(v[i].z), a6 = bflo(v[i].w), a7 = bfhi(v[i].w);
        ss += (a0 * a0 + a1 * a1) + (a2 * a2 + a3 * a3) + (a4 * a4 + a5 * a5) + (a6 * a6 + a7 * a7); }
    ss += __shfl_xor(ss, 1); ss += __shfl_xor(ss, 2); ss += __shfl_xor(ss, 4);
    const float rn = frsq(ss * (1.0f / DH) + NORM_EPS);
#pragma unroll
    for (int i = 0; i < NCH; ++i) { const float* g = gain + ((lane & 7) + 8 * i) * 8; const f32x4 g0 = *(const f32x4*)g, g1 = *(const f32x4*)(g + 4);
        u32x4 w;
        w.x = pk2(bflo(v[i].x) * rn * g0[0], bfhi(v[i].x) * rn * g0[1]); w.y = pk2(bflo(v[i].y) * rn * g0[2], bfhi(v[i].y) * rn * g0[3]);
        w.z = pk2(bflo(v[i].z) * rn * g1[0], bfhi(v[i].z) * rn * g1[1]); w.w = pk2(bflo(v[i].w) * rn * g1[2], bfhi(v[i].w) * rn * g1[3]);
        *(u32x4*)(p + 64 * i) = w; }
}

__device__ __forceinline__ void p1_tail_convert(Frame& F, int first, int nw) {
    const int gw = ((int)blockIdx.x - first) * NWAVES + F.wave, NGW = nw * NWAVES;
    TR_RUN(p1t_item, 3 * 16 * 64 + 32 * 64);
}
__device__ __forceinline__ void p5_tail_convert(Frame& F, int first, int nw) {
    const int gw = ((int)blockIdx.x - first) * NWAVES + F.wave, NGW = nw * NWAVES;
    TR_RUN(p5t_item, 88 * 64);
}

constexpr int BG_NH = 2 * 32 * 352;
template <bool V> struct BoolT { static constexpr bool value = V; };
struct BgConv { const float* src; const float* gain; bf16* dst; int h, step; };
__device__ __forceinline__ void bg_load(const BgConv& B, f32x4 (&v)[4], f32x4& gv, int lane) {
    const int hh = (B.h < BG_NH) ? B.h : BG_NH - 1;
    const int r = hh >> 1, half = hh & 1, kb = r / 352, nb = r % 352;
    const float* p = B.src + (size_t)(64 * kb + 4 * half + 8 * (lane & 7)) * (2 * DFF) + 32 * nb + 4 * (lane >> 3);
#pragma unroll
    for (int j = 0; j < 4; ++j) v[j] = __builtin_nontemporal_load((const f32x4*)(p + (size_t)j * (2 * DFF)));
    gv = *(const f32x4*)(B.gain + 64 * kb + 4 * half + 8 * (lane & 7));
}
__device__ __forceinline__ void bg_store(const BgConv& B, const f32x4 (&v)[4], const f32x4& gv, int lane) {
    const int r = B.h >> 1, half = B.h & 1, kb = r / 352, nb = r % 352; const int j0 = 32 * nb;
    const int drow = (j0 < DFF) ? (256 * (j0 / 128) + (j0 % 128)) : (256 * ((j0 - DFF) / 128) + 128 + ((j0 - DFF) % 128));
    bf16* d = B.dst + (size_t)(drow + 4 * (lane >> 3)) * DM + 64 * kb + 4 * half + 8 * (lane & 7);
#pragma unroll
    for (int i = 0; i < 4; ++i) { u32x2 o; o.x = pk2(v[0][i] * gv[0], v[1][i] * gv[1]); o.y = pk2(v[2][i] * gv[2], v[3][i] * gv[3]); *(GAS u32x2*)(d + (size_t)i * DM) = o; }
}

constexpr int AT_K = 0, AT_V = 34816, AT_P = AT_V + 36864, AT_G = AT_P + 18432, AT_L = AT_G + 2048, AT_R = AT_L + 1024, AT_END = AT_R + 1024;
static_assert(AT_END <= RING_BYTES, "attention LDS");
constexpr int VST = 576, PST = 144;

__device__ __forceinline__ void tile_load(u32x4 (&r)[4], const bf16* base, int ld, int tid) {
    const bf16* p = base + (size_t)(tid >> 3) * ld + (tid & 7) * 8;
#pragma unroll
    for (int i = 0; i < 4; ++i) r[i] = *(const u32x4*)(p + 64 * i);
}
__device__ __forceinline__ void tile_store_raw(const u32x4 (&r)[4], LAS unsigned char* buf, int tid) {
#pragma unroll
    for (int i = 0; i < 4; ++i) *(LAS u32x4*)(buf + (tid >> 3) * VST + ((tid & 7) + 8 * i) * 16) = r[i];
}
template <int DH, int NCOMP>
__device__ __forceinline__ void tile_store_norm(const u32x4 (&r)[4], LAS unsigned char* buf, const LAS float* gain, float scale, int tid) {
    constexpr int KST = DH * 2 + 16, CPR = DH / 8;
    float ss[2] = {0.f, 0.f};
#pragma unroll
    for (int i = 0; i < 4; ++i) { const int c = (NCOMP == 2) ? (i >> 1) : 0;
        const float a0 = bflo(r[i].x), a1 = bfhi(r[i].x), a2 = bflo(r[i].y), a3 = bfhi(r[i].y), a4 = bflo(r[i].z), a5 = bfhi(r[i].z), a6 = bflo(r[i].w), a7 = bfhi(r[i].w);
        ss[c] += (a0 * a0 + a1 * a1) + (a2 * a2 + a3 * a3) + (a4 * a4 + a5 * a5) + (a6 * a6 + a7 * a7); }
#pragma unroll
    for (int c = 0; c < NCOMP; ++c) { ss[c] += __shfl_xor(ss[c], 1); ss[c] += __shfl_xor(ss[c], 2); ss[c] += __shfl_xor(ss[c], 4); ss[c] = frsq(ss[c] * (1.0f / DH) + NORM_EPS) * scale; }
#pragma unroll
    for (int i = 0; i < 4; ++i) { const int c = (NCOMP == 2) ? (i >> 1) : 0; const int chunk = (tid & 7) + 8 * i, dch = chunk % CPR; const float rn = ss[c];
        const f32x4 g0 = *(const LAS f32x4*)(gain + dch * 8), g1 = *(const LAS f32x4*)(gain + dch * 8 + 4);
        u32x4 w;
        w.x = pk2(bflo(r[i].x) * rn * g0[0], bfhi(r[i].x) * rn * g0[1]); w.y = pk2(bflo(r[i].y) * rn * g0[2], bfhi(r[i].y) * rn * g0[3]);
        w.z = pk2(bflo(r[i].z) * rn * g1[0], bfhi(r[i].z) * rn * g1[1]); w.w = pk2(bflo(r[i].w) * rn * g1[2], bfhi(r[i].w) * rn * g1[3]);
        *(LAS u32x4*)(buf + ((tid >> 3) * NCOMP + c) * KST + dch * 16) = w; }
}

template <int DH, int NCOMP>
__device__ __forceinline__ void tile_store_k(const u32x4 (&r)[4], LAS unsigned char* buf, int tid) {
    constexpr int KST = DH * 2 + 16, CPR = DH / 8;
#pragma unroll
    for (int i = 0; i < 4; ++i) { const int c = (NCOMP == 2) ? (i >> 1) : 0; const int chunk = (tid & 7) + 8 * i, dch = chunk % CPR;
        *(LAS u32x4*)(buf + ((tid >> 3) * NCOMP + c) * KST + dch * 16) = r[i]; }
}
template <int DH, int NCOMP, int NRB>
struct AttnUnit {
    static constexpr int NDV = 8 / NRB, DVW = 256 / NDV, NBLK = DVW / 32, KS = DH / 16, KST = DH * 2 + 16;
    const bf16* Q; int ldq; const bf16* K; int ldk; const bf16* V; int ldv; int ntiles; const float* qg; float m2;
    template <bool BG = false>
    __device__ __forceinline__ void run(LAS unsigned char* lds, f32x16 (&O)[NCOMP][NBLK], BgConv* bg = nullptr) const {
        int tid = threadIdx.x; asm volatile("" : "+v"(tid));
        const int lane = tid & 63, wid = __builtin_amdgcn_readfirstlane(tid >> 6), r = lane & 31, h = lane >> 5;
        const int kh = wid & 1, compA = (wid >> 1) % NCOMP, rbA = wid / (2 * NCOMP);
        const int dvp = wid % NDV, rbB = wid / NDV;
        const int b16 = (lane >> 4) & 1, q4 = (lane & 15) >> 2, p4 = lane & 3;
        LAS unsigned char* kbuf = lds + AT_K; LAS unsigned char* vbuf = lds + AT_V; LAS unsigned char* pbuf = lds + AT_P;
        LAS float* gq = (LAS float*)(lds + AT_G); LAS float* lbuf = (LAS float*)(lds + AT_L);
        if (tid < DH) gq[tid] = qg[tid];
        __syncthreads();
        bf16x8 qf[KS];
        const float qscale = ((DH == 128) ? 0.08838834764831845f : 0.0625f) * LOG2E;
#pragma unroll
        for (int pass = 0; pass < NRB / 2; ++pass) {
            u32x4 qr[4]; tile_load(qr, Q + (size_t)(64 * pass) * ldq, ldq, tid);
            tile_store_norm<DH, NCOMP>(qr, kbuf, gq, qscale, tid);
            __syncthreads();
            if (rbA / 2 == pass) {
#pragma unroll
                for (int s = 0; s < KS; ++s) qf[s] = *(const LAS bf16x8*)(kbuf + ((32 * (rbA & 1) + r) * NCOMP + compA) * KST + (16 * s + 8 * h) * 2);
            }
            __syncthreads();
        }
        u32x4 kreg[4], vreg[4];
        tile_load(kreg, K, ldk, tid); tile_load(vreg, V, ldv, tid);
        tile_store_k<DH, NCOMP>(kreg, kbuf, tid);
#pragma unroll
        for (int c = 0; c < NCOMP; ++c)
#pragma unroll
            for (int b = 0; b < NBLK; ++b)
#pragma unroll
                for (int i = 0; i < 16; ++i) O[c][b][i] = 0.f;
        float lsum = 0.f;
        f32x4 bgv[4], bgg;
        __syncthreads();
        auto body = [&](const int t, auto moret, auto bgt) {
            constexpr bool more = decltype(moret)::value, BGI = decltype(bgt)::value;
            if (more) tile_load(kreg, K + (size_t)(64 * (t + 1)) * ldk, ldk, tid);
            f32x16 st;
#pragma unroll
            for (int i = 0; i < 16; ++i) st[i] = 0.f;
            if (DH == 128) {
                bf16x8 kfa[KS];
#pragma unroll
                for (int s = 0; s < KS; ++s) kfa[s] = *(const LAS bf16x8*)(kbuf + ((32 * kh + r) * NCOMP + compA) * KST + (16 * s + 8 * h) * 2);
                asm volatile("" ::: "memory");
                tile_store_raw(vreg, vbuf, tid);
#pragma unroll
                for (int s = 0; s < KS; ++s) st = MFMA32(kfa[s], qf[s], st);
            } else {
            tile_store_raw(vreg, vbuf, tid);
#pragma unroll
            for (int s = 0; s < KS; ++s) { const bf16x8 kf = *(const LAS bf16x8*)(kbuf + ((32 * kh + r) * NCOMP + compA) * KST + (16 * s + 8 * h) * 2); st = MFMA32(kf, qf[s], st);
                if ((s & 3) == 3) asm volatile("" ::: "memory"); }
            }
            float pe[16];
#pragma unroll
            for (int i = 0; i < 16; ++i) { pe[i] = fexp2(st[i] - m2); lsum += pe[i]; }
#pragma unroll
            for (int g = 0; g < 4; ++g) { u32x2 w; w.x = pk2(pe[4 * g], pe[4 * g + 1]); w.y = pk2(pe[4 * g + 2], pe[4 * g + 3]);
                *(LAS u32x2*)(pbuf + ((compA * NRB + rbA) * 32 + r) * PST + (32 * kh + 8 * g + 4 * h) * 2) = w; }
            __syncthreads();
            if (more) tile_load(vreg, V + (size_t)(64 * (t + 1)) * ldv, ldv, tid);
#pragma unroll
            for (int s = 0; s < 4; ++s) {
                bf16x8 pf[NCOMP];
#pragma unroll
                for (int c = 0; c < NCOMP; ++c) pf[c] = *(const LAS bf16x8*)(pbuf + ((c * NRB + rbB) * 32 + r) * PST + (16 * s + 8 * h) * 2);
#pragma unroll
                for (int b = 0; b < NBLK; ++b) {
                    const bf16x8 vf = trfrag(vbuf + (16 * s + 8 * h + q4) * VST + (DVW * dvp + 32 * b + 16 * b16 + 4 * p4) * 2, 4 * VST);
#pragma unroll
                    for (int c = 0; c < NCOMP; ++c) O[c][b] = MFMA32(pf[c], vf, O[c][b]);
                }
                asm volatile("" ::: "memory");
                if (DH == 128 && s == 1) { if (more) tile_store_k<DH, NCOMP>(kreg, kbuf, tid); }
            }
            if (DH != 128) { if (more) tile_store_k<DH, NCOMP>(kreg, kbuf, tid); }
            if constexpr (BGI) { bg_store(*bg, bgv, bgg, lane); bg->h += bg->step; bg_load(*bg, bgv, bgg, lane); }
            __syncthreads();
        };
        int t = 0;
        if constexpr (BG) {
            int n = 0; if (bg->h < BG_NH) { n = (BG_NH - 1 - bg->h) / bg->step + 1; const int fit = (ntiles - 1) / 2; n = (n < fit) ? n : fit; }
            if (n > 0) { bg_load(*bg, bgv, bgg, lane);
#pragma unroll 1
                for (int g = 0; g < n; ++g, t += 2) { body(t, BoolT<true>{}, BoolT<false>{}); body(t + 1, BoolT<true>{}, BoolT<true>{}); } } }
        for (; t < ntiles - 1; ++t) body(t, BoolT<true>{}, BoolT<false>{});
        body(ntiles - 1, BoolT<false>{}, BoolT<false>{});
        lsum += __shfl_xor(lsum, 32);
        if (h == 0) lbuf[((compA * NRB + rbA) * 2 + kh) * 32 + r] = lsum;
        __syncthreads();
    }
};

template <bool BG = false>
__device__ __forceinline__ void diff_unit(Frame& F, int bh, int c, BgConv* bg = nullptr) {
    typedef AttnUnit<128, 2, 2> AU;
    const int b = bh >> 2, hd = bh & 3;
    const bf16* Z = WSP(bf16, WS_Z); const float* sc = WSP(float, WS_SC);
    AU u; u.Q = Z + (size_t)(b * SEQ + 64 * c) * NZ + ZQ_DIFF + hd * 256; u.ldq = NZ; u.K = Z + (size_t)(b * SEQ) * NZ + ZK_DIFF + hd * 256; u.ldk = NZ;
    u.V = Z + (size_t)(b * SEQ) * NZ + ZV_DIFF + hd * 256; u.ldv = NZ; u.ntiles = c + 1; u.qg = F.in[8]; u.m2 = sc[1];
    f32x16 O[2][2];
    u.template run<BG>(F.lds, O, bg);
    int tid = F.tid; asm volatile("" : "+v"(tid));
    const int lane = tid & 63, wid = F.wave, r = lane & 31, h = lane >> 5, dvp = wid & 3, rbB = wid >> 2;
    LAS unsigned char* lds = F.lds;
    const LAS float* lbuf = (const LAS float*)(lds + AT_L);
    const float lam = sc[0];
    if (tid < 256) ((LAS float*)(lds + AT_G + 1024))[tid] = F.in[14][tid] * (1.0f - LAM_INIT);
#pragma unroll
    for (int i = 0; i < 16; ++i) { const int q = crow(i, h);
        const float l1 = lbuf[((0 * 2 + rbB) * 2 + 0) * 32 + q] + lbuf[((0 * 2 + rbB) * 2 + 1) * 32 + q];
        const float l2 = lbuf[((1 * 2 + rbB) * 2 + 0) * 32 + q] + lbuf[((1 * 2 + rbB) * 2 + 1) * 32 + q];
        const float i1 = frcp(l1), i2 = lam * frcp(l2);
        LAS unsigned char* orow = lds + (32 * rbB + q) * 1024; const int sw = (q & 1) << 4;
        *(LAS float*)(orow + (((64 * dvp + r) * 4) ^ sw)) = O[0][0][i] * i1 - O[1][0][i] * i2;
        *(LAS float*)(orow + (((64 * dvp + 32 + r) * 4) ^ sw)) = O[0][1][i] * i1 - O[1][1][i] * i2; }
    __syncthreads();
    { const int l = tid >> 3, sw = (l & 1) << 4;
      const LAS unsigned char* orow = lds + l * 1024;
      const LAS f32x4* gnt = (const LAS f32x4*)(lds + AT_G + 1024);
      f32x4 o[4][2]; float ss = 0.f;
#pragma unroll
      for (int i = 0; i < 4; ++i) { const int ch = (tid & 7) + 8 * i;
          o[i][0] = *(const LAS f32x4*)(orow + ((ch * 32) ^ sw)); o[i][1] = *(const LAS f32x4*)(orow + ((ch * 32 + 16) ^ sw));
#pragma unroll
          for (int e = 0; e < 4; ++e) ss += o[i][0][e] * o[i][0][e] + o[i][1][e] * o[i][1][e]; }
      ss += __shfl_xor(ss, 1); ss += __shfl_xor(ss, 2); ss += __shfl_xor(ss, 4);
      const float rn = frsq(ss * (1.0f / 256.0f) + NORM_EPS);
      bf16* Y = (bf16*)F.out + (size_t)TOK * 1024 + (size_t)(b * SEQ + 64 * c + l) * 1024 + hd * 256 + (tid & 7) * 8;
#pragma unroll
      for (int i = 0; i < 4; ++i) { const int ch = (tid & 7) + 8 * i;
          const f32x4 g0 = gnt[2 * ch], g1 = gnt[2 * ch + 1];
          u32x4 w;
          w.x = pk2(o[i][0][0] * rn * g0[0], o[i][0][1] * rn * g0[1]); w.y = pk2(o[i][0][2] * rn * g0[2], o[i][0][3] * rn * g0[3]);
          w.z = pk2(o[i][1][0] * rn * g1[0], o[i][1][1] * rn * g1[1]); w.w = pk2(o[i][1][2] * rn * g1[2], o[i][1][3] * rn * g1[3]);
          *(u32x4*)(Y + 64 * i) = w; } }
    __syncthreads();
}
__device__ __forceinline__ void mem_unit(Frame& F, int b, int hd, int qb) {
    typedef AttnUnit<256, 1, 4> AU;
    const bf16* Z = WSP(bf16, WS_Z); const bf16* KVM = WSP(bf16, WS_KVM); const float* sc = WSP(float, WS_SC);
    AU u; u.Q = Z + (size_t)(b * SEQ + 128 * qb) * NZ + ZQ_MEM + hd * 256; u.ldq = NZ; u.K = KVM + (size_t)(b * NMEM) * 2048 + hd * 256; u.ldk = 2048;
    u.V = KVM + (size_t)(b * NMEM) * 2048 + 1024 + hd * 256; u.ldv = 2048; u.ntiles = 4; u.qg = F.in[15]; u.m2 = sc[2];
    f32x16 O[1][4];
    u.run(F.lds, O);
    const int lane = F.lane, wid = F.wave, r = lane & 31, h = lane >> 5, dvp = wid & 1, rbB = wid >> 1;
    const LAS float* lbuf = (const LAS float*)(F.lds + AT_L);
    bf16* Y = WSP(bf16, WS_YMEM);
#pragma unroll
    for (int i = 0; i < 16; ++i) { const int q = crow(i, h);
        const float il = frcp(lbuf[(rbB * 2 + 0) * 32 + q] + lbuf[(rbB * 2 + 1) * 32 + q]);
        bf16* yp = Y + (size_t)(b * SEQ + 128 * qb + 32 * rbB + q) * 1024 + hd * 256 + 128 * dvp + r;
#pragma unroll
        for (int blk = 0; blk < 4; ++blk) yp[32 * blk] = (bf16)(pk2(O[0][blk][i] * il, 0.f) & 0xffffu); }
    __syncthreads();
}

constexpr int GL_LA = 0;
constexpr int GL_VT = 32768;
constexpr int GL_KT = GL_VT + 36864;
constexpr int GL_KD = GL_KT + 20480;
constexpr int GL_ATT = GL_KD + 17408;
constexpr int GL_RED = GL_ATT + 9216;
constexpr int GL_SEG = GL_RED + 2048;
constexpr int GL_GY = GL_SEG + 2048;
static_assert(GL_GY + 32768 <= LDSCTL_OFF, "GLA LDS");
__device__ __forceinline__ void gla_load_la(LAS unsigned char* lds, const bf16* src, int tid) {
    const bf16* p = src + (size_t)(tid >> 3) * NZ + (tid & 7) * 8;
#pragma unroll
    for (int i = 0; i < 2; ++i) { const u32x4 v = *(const u32x4*)(p + 64 * i); LAS float* d = (LAS float*)(lds + GL_LA) + (tid >> 3) * 128 + ((tid & 7) + 8 * i) * 8;
        *(LAS f32x4*)d = (f32x4){bflo(v.x), bfhi(v.x), bflo(v.y), bfhi(v.y)}; *(LAS f32x4*)(d + 4) = (f32x4){bflo(v.z), bfhi(v.z), bflo(v.w), bfhi(v.w)}; }
}
__device__ __forceinline__ void gla_cumsum(LAS unsigned char* lds, int tid) {
    LAS float* la = (LAS float*)(lds + GL_LA) + (tid >> 7) * 16 * 128 + (tid & 127); LAS float* seg = (LAS float*)(lds + GL_SEG);
    float v[16];
#pragma unroll
    for (int i = 0; i < 16; ++i) v[i] = la[i * 128];
#pragma unroll
    for (int i = 1; i < 16; ++i) v[i] += v[i - 1];
    seg[tid] = v[15];
    __syncthreads();
    float off = 0.f;
#pragma unroll
    for (int sgi = 0; sgi < 3; ++sgi) off += (sgi < (tid >> 7)) ? seg[sgi * 128 + (tid & 127)] : 0.f;
#pragma unroll
    for (int i = 0; i < 16; ++i) la[i * 128] = v[i] + off;
}
__device__ __forceinline__ void gla_inc_unit(Frame& F, int bh, int n) {
    int tid = F.tid; asm volatile("" : "+v"(tid));
    const int lane = tid & 63, wid = F.wave, h = lane >> 5, b16 = (lane >> 4) & 1, q4 = (lane & 15) >> 2, p4 = lane & 3;
    const int b = bh >> 2, hd = bh & 3;
    const bf16* zrow = WSP(bf16, WS_Z) + (size_t)(b * SEQ + 64 * n) * NZ;
    LAS unsigned char* lds = F.lds;
    gla_load_la(lds, zrow + ZA_GLA + hd * 128, tid);
    u32x4 kr[2]; { const bf16* p = zrow + ZK_GLA + hd * 128 + (size_t)(tid >> 3) * NZ + (tid & 7) * 8; kr[0] = *(const u32x4*)p; kr[1] = *(const u32x4*)(p + 64); }
    { u32x4 vr[4]; tile_load(vr, zrow + ZV_GLA + hd * 256, NZ, tid); tile_store_raw(vr, lds + GL_VT, tid); }
    __syncthreads();
    gla_cumsum(lds, tid);
    __syncthreads();
    const LAS float* la = (const LAS float*)(lds + GL_LA);
#pragma unroll
    for (int i = 0; i < 2; ++i) { const int l = tid >> 3, d0 = ((tid & 7) + 8 * i) * 8;
        const f32x4 e0 = *(const LAS f32x4*)(la + 63 * 128 + d0), e1 = *(const LAS f32x4*)(la + 63 * 128 + d0 + 4), c0 = *(const LAS f32x4*)(la + l * 128 + d0), c1 = *(const LAS f32x4*)(la + l * 128 + d0 + 4);
        u32x4 w;
        w.x = pk2(bflo(kr[i].x) * fexp(e0[0] - c0[0]), bfhi(kr[i].x) * fexp(e0[1] - c0[1])); w.y = pk2(bflo(kr[i].y) * fexp(e0[2] - c0[2]), bfhi(kr[i].y) * fexp(e0[3] - c0[3]));
        w.z = pk2(bflo(kr[i].z) * fexp(e1[0] - c1[0]), bfhi(kr[i].z) * fexp(e1[1] - c1[1])); w.w = pk2(bflo(kr[i].w) * fexp(e1[2] - c1[2]), bfhi(kr[i].w) * fexp(e1[3] - c1[3]));
        *(LAS u32x4*)(lds + GL_KT + l * 320 + d0 * 2) = w; }
    if (tid < 128) WSP(float, WS_DEC)[(size_t)(bh * 64 + n) * 128 + tid] = fexp(la[63 * 128 + tid]);
    __syncthreads();
    f32x16 acc[4];
#pragma unroll
    for (int c = 0; c < 4; ++c)
#pragma unroll
        for (int i = 0; i < 16; ++i) acc[c][i] = 0.f;
#pragma unroll
    for (int s = 0; s < 4; ++s) {
        const bf16x8 af = trfrag(lds + GL_VT + (16 * s + 8 * h + q4) * VST + (32 * wid + 16 * b16 + 4 * p4) * 2, 4 * VST);
#pragma unroll
        for (int c = 0; c < 4; ++c) { const bf16x8 bf = trfrag(lds + GL_KT + (16 * s + 8 * h + q4) * 320 + (32 * c + 16 * b16 + 4 * p4) * 2, 4 * 320); acc[c] = MFMA32(af, bf, acc[c]); }
    }
    bf16* sb = WSP(bf16, WS_SB) + (size_t)(bh * 64 + n) * 256 * 128;
#pragma unroll
    for (int c = 0; c < 4; ++c)
#pragma unroll
        for (int i = 0; i < 16; ++i) sb[(size_t)(32 * wid + crow(i, h)) * 128 + 32 * c + (lane & 31)] = (bf16)(pk2(acc[c][i], 0.f) & 0xffffu);
    __syncthreads();
}
__device__ __forceinline__ void gla_scan(Frame& F) {
    const int NT = F.G * 512;
    for (int e = F.vcu * 512 + F.tid; e < 8 * 256 * 64; e += NT) {
        const int bh = e >> 14, rem = e & 16383, dv = rem >> 6, dk = (rem & 63) * 2;
        unsigned* sb = (unsigned*)(WSP(bf16, WS_SB) + (size_t)bh * 64 * 256 * 128 + (size_t)dv * 128 + dk);
        const float* dec = WSP(float, WS_DEC) + (size_t)bh * 64 * 128 + dk;
        float s0 = 0.f, s1 = 0.f;
#pragma unroll 8
        for (int n = 0; n < 64; ++n) { const unsigned inc = sb[(size_t)n * 256 * 64]; const f32x2 d = *(const f32x2*)(dec + n * 128);
            sb[(size_t)n * 256 * 64] = pk2(s0, s1); s0 = d.x * s0 + bflo(inc); s1 = d.y * s1 + bfhi(inc); }
    }
}
__device__ __forceinline__ void gla_out_unit(Frame& F, int bh, int n) {
    int tid = F.tid; asm volatile("" : "+v"(tid));
    const int lane = tid & 63, wid = F.wave, r = lane & 31, h = lane >> 5, b16 = (lane >> 4) & 1, q4 = (lane & 15) >> 2, p4 = lane & 3;
    const int b = bh >> 2, hd = bh & 3;
    const bf16* zrow = WSP(bf16, WS_Z) + (size_t)(b * SEQ + 64 * n) * NZ;
    LAS unsigned char* lds = F.lds;
    const bf16* sb = WSP(bf16, WS_SB) + (size_t)(bh * 64 + n) * 256 * 128 + (size_t)(32 * wid + r) * 128 + 8 * h;
    bf16x8 sf[8];
#pragma unroll
    for (int s = 0; s < 8; ++s) sf[s] = *(const bf16x8*)(sb + 16 * s);
    gla_load_la(lds, zrow + ZA_GLA + hd * 128, tid);
    u32x4 qr[2], kr[2];
    { const bf16* p = zrow + ZQ_GLA + hd * 128 + (size_t)(tid >> 3) * NZ + (tid & 7) * 8; qr[0] = *(const u32x4*)p; qr[1] = *(const u32x4*)(p + 64); }
    { const bf16* p = zrow + ZK_GLA + hd * 128 + (size_t)(tid >> 3) * NZ + (tid & 7) * 8; kr[0] = *(const u32x4*)p; kr[1] = *(const u32x4*)(p + 64); }
    { u32x4 vr[4]; tile_load(vr, zrow + ZV_GLA + hd * 256, NZ, tid); tile_store_raw(vr, lds + GL_VT, tid); }
    u32x4 gr[4]; tile_load(gr, zrow + ZG_GLA + hd * 256, NZ, tid);
    if (tid < 256) ((LAS float*)(lds + GL_RED))[tid] = F.in[7][tid];
    __syncthreads();
    gla_cumsum(lds, tid);
    __syncthreads();
    const LAS float* la = (const LAS float*)(lds + GL_LA);
    const float qs = 0.08838834764831845f;
#pragma unroll
    for (int i = 0; i < 2; ++i) { const int l = tid >> 3, d0 = ((tid & 7) + 8 * i) * 8;
        const f32x4 c0 = *(const LAS f32x4*)(la + l * 128 + d0), c1 = *(const LAS f32x4*)(la + l * 128 + d0 + 4);
        float ep[8], en[8];
#pragma unroll
        for (int e = 0; e < 4; ++e) { ep[e] = fexp(c0[e]); en[e] = fexp(-c0[e]); ep[4 + e] = fexp(c1[e]); en[4 + e] = fexp(-c1[e]); }
        u32x4 wq, wk;
        wq.x = pk2(bflo(qr[i].x) * qs * ep[0], bfhi(qr[i].x) * qs * ep[1]); wq.y = pk2(bflo(qr[i].y) * qs * ep[2], bfhi(qr[i].y) * qs * ep[3]);
        wq.z = pk2(bflo(qr[i].z) * qs * ep[4], bfhi(qr[i].z) * qs * ep[5]); wq.w = pk2(bflo(qr[i].w) * qs * ep[6], bfhi(qr[i].w) * qs * ep[7]);
        wk.x = pk2(bflo(kr[i].x) * en[0], bfhi(kr[i].x) * en[1]); wk.y = pk2(bflo(kr[i].y) * en[2], bfhi(kr[i].y) * en[3]);
        wk.z = pk2(bflo(kr[i].z) * en[4], bfhi(kr[i].z) * en[5]); wk.w = pk2(bflo(kr[i].w) * en[6], bfhi(kr[i].w) * en[7]);
        *(LAS u32x4*)(lds + GL_KT + l * 272 + d0 * 2) = wq; *(LAS u32x4*)(lds + GL_KD + l * 272 + d0 * 2) = wk; }
    __syncthreads();
    if (wid < 4) { const int mb = wid >> 1, lb = wid & 1; f32x16 st;
#pragma unroll
        for (int i = 0; i < 16; ++i) st[i] = 0.f;
#pragma unroll
        for (int s = 0; s < 8; ++s) { const bf16x8 kf = *(const LAS bf16x8*)(lds + GL_KD + (32 * mb + r) * 272 + (16 * s + 8 * h) * 2), qf = *(const LAS bf16x8*)(lds + GL_KT + (32 * lb + r) * 272 + (16 * s + 8 * h) * 2);
            st = MFMA32(kf, qf, st); }
        const int lrow = 32 * lb + r;
#pragma unroll
        for (int g = 0; g < 4; ++g) { float v[4];
#pragma unroll
            for (int e = 0; e < 4; ++e) { const int m = 32 * mb + 8 * g + 4 * h + e; v[e] = (m <= lrow) ? st[4 * g + e] : 0.f; }
            u32x2 w; w.x = pk2(v[0], v[1]); w.y = pk2(v[2], v[3]);
            *(LAS u32x2*)(lds + GL_ATT + lrow * PST + (32 * mb + 8 * g + 4 * h) * 2) = w; } }
    f32x16 acc[2];
#pragma unroll
    for (int lb = 0; lb < 2; ++lb)
#pragma unroll
        for (int i = 0; i < 16; ++i) acc[lb][i] = 0.f;
#pragma unroll
    for (int s = 0; s < 8; ++s)
#pragma unroll
        for (int lb = 0; lb < 2; ++lb) { const bf16x8 qf = *(const LAS bf16x8*)(lds + GL_KT + (32 * lb + r) * 272 + (16 * s + 8 * h) * 2); acc[lb] = MFMA32(qf, sf[s], acc[lb]); }
    __syncthreads();
#pragma unroll
    for (int s = 0; s < 4; ++s) { const bf16x8 vf = trfrag(lds + GL_VT + (16 * s + 8 * h + q4) * VST + (32 * wid + 16 * b16 + 4 * p4) * 2, 4 * VST);
#pragma unroll
        for (int lb = 0; lb < 2; ++lb) { const bf16x8 af = *(const LAS bf16x8*)(lds + GL_ATT + (32 * lb + r) * PST + (16 * s + 8 * h) * 2); acc[lb] = MFMA32(af, vf, acc[lb]); } }
#pragma unroll
    for (int lb = 0; lb < 2; ++lb)
#pragma unroll
        for (int i = 0; i < 16; ++i) { const int lr = crow(i, h);
            *(LAS float*)(lds + (lb ? GL_GY : GL_LA) + lr * 1024 + (((32 * wid + r) * 4) ^ ((lr & 1) << 4))) = acc[lb][i]; }
    __syncthreads();
    { const int l = tid >> 3, sw = (l & 1) << 4;
      const LAS unsigned char* orow = lds + ((l & 32) ? GL_GY : GL_LA) + (l & 31) * 1024;
      const LAS f32x4* gnt = (const LAS f32x4*)(lds + GL_RED);
      f32x4 o[4][2]; float ss = 0.f;
#pragma unroll
      for (int i = 0; i < 4; ++i) { const int c = (tid & 7) + 8 * i;
          o[i][0] = *(const LAS f32x4*)(orow + ((c * 32) ^ sw)); o[i][1] = *(const LAS f32x4*)(orow + ((c * 32 + 16) ^ sw));
#pragma unroll
          for (int e = 0; e < 4; ++e) ss += o[i][0][e] * o[i][0][e] + o[i][1][e] * o[i][1][e]; }
      ss += __shfl_xor(ss, 1); ss += __shfl_xor(ss, 2); ss += __shfl_xor(ss, 4);
      const float rn = frsq(ss * (1.0f / 256.0f) + NORM_EPS);
      bf16* Y = (bf16*)F.out + (size_t)(b * SEQ + 64 * n + l) * 1024 + hd * 256 + (tid & 7) * 8;
#pragma unroll
      for (int i = 0; i < 4; ++i) { const int c = (tid & 7) + 8 * i;
          const f32x4 g0 = gnt[2 * c], g1 = gnt[2 * c + 1];
          const unsigned gw[4] = {gr[i].x, gr[i].y, gr[i].z, gr[i].w};
          float y[8];
#pragma unroll
          for (int e = 0; e < 4; ++e) { const float ga = bflo(gw[e]), gb = bfhi(gw[e]);
              const float oa = (e < 2) ? o[i][0][2 * e] : o[i][1][2 * e - 4], ob = (e < 2) ? o[i][0][2 * e + 1] : o[i][1][2 * e - 3];
              const float na = (e < 2) ? g0[2 * e] : g1[2 * e - 4], nb = (e < 2) ? g0[2 * e + 1] : g1[2 * e - 3];
              y[2 * e] = oa * rn * na * (ga * sigmoidf_(ga)); y[2 * e + 1] = ob * rn * nb * (gb * sigmoidf_(gb)); }
          u32x4 w; w.x = pk2(y[0], y[1]); w.y = pk2(y[2], y[3]); w.z = pk2(y[4], y[5]); w.w = pk2(y[6], y[7]);
          *(u32x4*)(Y + 64 * i) = w; } }
    __syncthreads();
}

constexpr int N_PHASES = 9;
struct Args { const float* in[25]; float* out; unsigned char* ws; int ph_lo, ph_hi, li, pad; };
__global__ void __launch_bounds__(NWAVES * 64, 2) mk_fwd(Args args) {
    extern __shared__ __attribute__((aligned(16))) unsigned char lds_raw[];
    Frame F;
    F.lds = (LAS unsigned char*)lds_raw;
    F.tid = threadIdx.x; F.lane = F.tid & 63; F.wave = __builtin_amdgcn_readfirstlane(F.tid >> 6);
    F.G = gridDim.x; { const int bx = blockIdx.x; F.vcu = (F.G % 8 == 0) ? (bx % 8) * (F.G / 8) + bx / 8 : bx; }
#pragma unroll
    for (int i = 0; i < 25; ++i) F.in[i] = args.in[i];
    F.out = args.out; F.ws = args.ws;
    volatile LAS unsigned* MISC = (volatile LAS unsigned*)(F.lds + MISC_OFF);
    for (int u = F.tid; u < (LDS_BYTES - LDSCTL_OFF) / 4; u += NWAVES * 64) ((LAS unsigned*)(F.lds + LDSCTL_OFF))[u] = 0u;
    __syncthreads();
    gu32* ctl = (gu32*)(F.ws + WS_CTL);
    XcdBarrier bar; bar.bar = (unsigned*)(ctl + CW_BAR); bar.x = 0; bar.st = nullptr;
    if (MK_N_LAUNCHES == 1) bar = xcd_barrier_post((unsigned*)(ctl + CW_BAR), MISC + 8);
#define GRID_BAR() do { if (MK_N_LAUNCHES == 1) xcd_barrier(bar); } while (0)
    const int lo = args.ph_lo, hi = args.ph_hi;
#ifndef PHMASK
#define PHMASK 0x1ff
#endif
#define IN(k) (((PHMASK >> (k)) & 1) && lo <= (k) && (k) < hi)
#define BOTH(k) (IN(k) && IN((k) + 1))
#ifndef REPMASK
#define REPMASK 0
#endif
#define NREP(k) ((((REPMASK) >> (k)) & 1) ? rt2 : 1)
    const int G = F.G; const int rt2 = 1 + (args.ph_hi > 0);

    if (IN(0)) { for (int rep = 0; rep < NREP(0); ++rep) { p0_prologue(F); __syncthreads(); } if (BOTH(0)) GRID_BAR(); }
    if (IN(1)) {
        pg8::SchedP1 S; S.tm.init(TOK, NZ, WGM_P1); S.G = G; S.c = (int)blockIdx.x; S.A = (const char*)XBP; S.B = (const char*)WSP(bf16, WS_W1T);
        S.A2 = (const char*)WSP(bf16, WS_MEMB); S.B2 = (const char*)WSP(bf16, WS_WKVT); S.tstep = (size_t)256 * DM * 2;
        pg8::Epi1 E{WSP(bf16, WS_Z), WSP(bf16, WS_GATES), WSP(bf16, WS_KVM), WSP(float, WS_RINVX), WSP(float, WS_RINVM), F.in[6], F.in[20]};
#ifndef ONLY8
        for (int rep = 0; rep < NREP(1); ++rep) pg8::gemm_phase<pg8::Epi1, pg8::SchedP1, true, true>(F.lds, DM, S, E);
#endif
        { const int nfull = (S.tm.nwg + 16) % G;
          if (nfull > 0 && (int)blockIdx.x >= nfull) p1_tail_convert(F, nfull, G - nfull); else if (nfull == 0) p1_tail_convert(F, 0, G); }
        { pg8::SchedPlain S8; S8.tm.init(TOK, NGT, WGM_P1); S8.G = G; S8.c = (int)blockIdx.x; S8.A = (const char*)(F.ws + WS_XQ); S8.B = (const char*)(F.ws + WS_WG8); S8.tstep = (size_t)256 * DM;
          pg8::EpiG EG{WSP(unsigned char, WS_GATES), WSP(float, WS_RINVX), F.in[20]};
#ifndef NO8
          pg8::gemm_phase8<pg8::EpiG, pg8::SchedPlain, true, true>(F.lds, DM / 2, S8, EG);
#endif
        }
        if (BOTH(1)) GRID_BAR();
    }
    if (IN(2)) {
        { const int gw = F.vcu * NWAVES + F.wave, NGW = G * NWAVES;
            for (int it = gw; it < (MEMROWS / 8) * 4; it += NGW) knorm8<256>(WSP(bf16, WS_KVM) + (size_t)((it >> 2) * 8) * 2048 + (it & 3) * 256, 2048, F.in[16], F.lane);
            for (int it = gw; it < (TOK / 8) * 8; it += NGW) knorm8<128>(WSP(bf16, WS_Z) + (size_t)((it >> 3) * 8) * NZ + ZK_DIFF + (it & 7) * 128, NZ, F.in[9], F.lane); }
        for (int rep = 0; rep < NREP(2); ++rep) for (int u = F.vcu; u < 512; u += G) gla_inc_unit(F, u >> 6, u & 63);
        if (BOTH(2)) GRID_BAR();
    }
    if (IN(3)) { gla_scan(F); for (int rep = 0; rep < NREP(4); ++rep) for (int u = F.vcu; u < 256; u += G) mem_unit(F, u >> 7, (u >> 5) & 3, u & 31); if (BOTH(3)) GRID_BAR(); }
    if (IN(4)) {
#ifndef NO_GLAOUT
        for (int rep = 0; rep < NREP(6); ++rep) for (int u = F.vcu; u < 512; u += G) gla_out_unit(F, u >> 6, u & 63);
#endif
#ifndef NO_DIFF
        { BgConv bg; bg.src = F.in[23]; bg.gain = F.in[22]; bg.dst = WSP(bf16, WS_WFIT); bg.h = F.vcu * NWAVES + F.wave; bg.step = G * NWAVES;
          for (int rep = 0; rep < NREP(5); ++rep) for (int u = F.vcu; u < 256; u += G) { const int bh = u >> 5, c = u & 31; diff_unit<true>(F, bh, 63 - c, &bg); diff_unit<true>(F, bh, c, &bg); }
          for (; bg.h < BG_NH; bg.h += bg.step) { f32x4 v[4], gv; bg_load(bg, v, gv, F.lane); bg_store(bg, v, gv, F.lane); } }
#endif
        if (BOTH(4)) GRID_BAR();
    }
    if (IN(5)) {
        pg8::SchedP3 S; S.tm.init(TOK, DM, WGM_P3); S.G = G; S.c = (int)blockIdx.x; S.A = (const char*)F.out; S.A2 = (const char*)WSP(bf16, WS_YMEM); S.B = (const char*)WSP(bf16, WS_WBT);
        S.tstep = (size_t)256 * 1024 * 2; S.astride = (size_t)TOK * 1024 * 2; S.bstride = (size_t)DM * 1024 * 2;
        pg8::Epi3 E{WSP(unsigned char, WS_GATES), WSP(bf16, WS_MERGED)};
        for (int rep = 0; rep < NREP(7); ++rep) pg8::gemm_phase<pg8::Epi3, pg8::SchedP3, true, true>(F.lds, 1024, S, E);
        if (BOTH(5)) GRID_BAR();
    }
    if (IN(6)) {
        pg8::SchedPlain S; S.tm.init(TOK, DM, WGM_P4); S.G = G; S.c = (int)blockIdx.x; S.A = (const char*)WSP(bf16, WS_MERGED); S.B = (const char*)WSP(bf16, WS_WOT); S.tstep = (size_t)256 * DM * 2;
        pg8::Epi4 E{XBP, WSP(bf16, WS_X1B), WSP(float, WS_SS8)};
        for (int rep = 0; rep < NREP(8); ++rep) pg8::gemm_phase<pg8::Epi4, pg8::SchedPlain, false, true>(F.lds, DM, S, E);
        if (BOTH(6)) GRID_BAR();
    }
    if (IN(7)) {
        pg8::SchedPlain S; S.tm.init(TOK, 2 * DFF, WGM_P5); S.G = G; S.c = (int)blockIdx.x; S.A = (const char*)WSP(bf16, WS_X1B); S.B = (const char*)WSP(bf16, WS_WFIT); S.tstep = (size_t)256 * DM * 2;
        pg8::Epi5 E{WSP(float, WS_SS8), WSP(bf16, WS_ACT)};
        for (int rep = 0; rep < NREP(9); ++rep) pg8::gemm_phase<pg8::Epi5, pg8::SchedPlain, true, true>(F.lds, DM, S, E);
        { const int nfull = S.tm.nwg % G;
          if (nfull > 0 && (int)blockIdx.x >= nfull) p5_tail_convert(F, nfull, G - nfull); else if (nfull == 0) p5_tail_convert(F, 0, G); }
        if (BOTH(7)) GRID_BAR();
    }
    if (IN(8)) {
        pg8::SchedPlain S; S.tm.init(TOK, DM, WGM_P6); S.G = G; S.c = (int)blockIdx.x; S.A = (const char*)WSP(bf16, WS_ACT); S.B = (const char*)WSP(bf16, WS_WFDT); S.tstep = (size_t)256 * DFF * 2;
        pg8::Epi6 E{WSP(bf16, WS_X1B), F.out};
        pg8::gemm_phase<pg8::Epi6, pg8::SchedPlain, true, true>(F.lds, DFF, S, E);
    }
#undef IN
#undef BOTH
}

extern "C" void kernel_launch(void* const* d_in, const int* in_sizes, int n_in, void* d_out, int out_size, void* d_ws, size_t ws_size, hipStream_t stream) {
    static int grid = 0;
    if (grid == 0) {
        if (n_in != 25 || in_sizes[0] != TOK * DM || out_size != TOK * DM || ws_size < WS_END) {
            fprintf(stderr, "kernel_launch: unexpected problem: n_in %d in0 %d out %d ws %zu (need %zu)\n", n_in, n_in > 0 ? in_sizes[0] : -1, out_size, ws_size, (size_t)WS_END); grid = -1; return; }
        int dev = 0, cus = 0, per_cu = 0;
        if (hipGetDevice(&dev) != hipSuccess || hipDeviceGetAttribute(&cus, hipDeviceAttributeMultiprocessorCount, dev) != hipSuccess) { grid = -1; return; }
        if (hipFuncSetAttribute((const void*)mk_fwd, hipFuncAttributeMaxDynamicSharedMemorySize, LDS_BYTES) != hipSuccess) { fprintf(stderr, "kernel_launch: hipFuncSetAttribute failed\n"); grid = -1; return; }
        if (hipOccupancyMaxActiveBlocksPerMultiprocessor(&per_cu, (const void*)mk_fwd, NWAVES * 64, LDS_BYTES) != hipSuccess || per_cu < 1) { fprintf(stderr, "kernel_launch: occupancy query says %d\n", per_cu); per_cu = 1; }
        (void)hipGetLastError();
        grid = cus;
        if (grid != 256) fprintf(stderr, "kernel_launch: note: %d CUs (P4's epilogue expects 256 workgroups)\n", grid);
    }
    if (grid < 0) return;
    (void)hipMemsetAsync((char*)d_ws + WS_CTL, 0, CTL_ZERO_BYTES, stream);
    Args a{};
    for (int i = 0; i < 25; ++i) a.in[i] = (const float*)d_in[i];
    a.out = (float*)d_out; a.ws = (unsigned char*)d_ws;
    if (MK_N_LAUNCHES == 1) {
        a.ph_lo = 0; a.ph_hi = N_PHASES; a.li = 0;
        hipLaunchKernelGGL(mk_fwd, dim3(grid), dim3(NWAVES * 64), LDS_BYTES, stream, a);
    } else {
        for (int li = 0; li < N_PHASES; ++li) { a.ph_lo = li; a.ph_hi = li + 1; a.li = li; hipLaunchKernelGGL(mk_fwd, dim3(grid), dim3(NWAVES * 64), LDS_BYTES, stream, a); }
    }
}
```

```cpp
#include <hip/hip_runtime.h>
#include <cstdio>
#include <cstdint>

#ifndef MK_N_LAUNCHES
#define MK_N_LAUNCHES 1
#endif

#define WGM_P1 3
#define WGM_P3 3
#define WGM_P4 3
#define WGM_P5 3
#define WGM_P6 3
#define LAS __attribute__((address_space(3)))
#define GAS __attribute__((address_space(1)))
typedef unsigned short bf16;
typedef short bf16x8 __attribute__((ext_vector_type(8)));
typedef short s16x4 __attribute__((ext_vector_type(4)));
typedef float f32x2 __attribute__((ext_vector_type(2)));
typedef float f32x4 __attribute__((ext_vector_type(4)));
typedef float f32x16 __attribute__((ext_vector_type(16)));
typedef unsigned u32x2 __attribute__((ext_vector_type(2)));
typedef unsigned u32x4 __attribute__((ext_vector_type(4)));
typedef __bf16 bf16x2_t __attribute__((ext_vector_type(2)));
typedef GAS unsigned gu32;

constexpr int BATCH = 2, SEQ = 4096, DM = 2048, TOK = BATCH * SEQ;
constexpr int NMEM = 256, MEMROWS = BATCH * NMEM;
constexpr int DFF = 5632;
constexpr int NZ = 7680;
constexpr int NGT = 6144;
constexpr int NG8 = 8192;
constexpr int N1 = NZ + NGT;
constexpr int ZQ_GLA = 0, ZK_GLA = 512, ZV_GLA = 1024, ZG_GLA = 2048, ZQ_DIFF = 3072, ZK_DIFF = 4096, ZV_DIFF = 5120, ZQ_MEM = 6144, ZA_GLA = 7168;
constexpr int WIN_LD = 7184;
constexpr float NORM_EPS = 1e-6f;
constexpr float LAM_INIT = 0.2f;
constexpr float LOG2E = 1.4426950408889634f;

constexpr size_t MiB = 1u << 20;
constexpr size_t WS_CTL = 0, CTL_ZERO_BYTES = 32768;
constexpr size_t WS_RINVX = 1 * MiB;
constexpr size_t WS_RINVM = WS_RINVX + 32768;
constexpr size_t WS_SC = WS_RINVM + 4096;
constexpr size_t WS_SS8 = WS_SC + 4096;
constexpr size_t WS_DEC = WS_SS8 + 262144;
static_assert(WS_DEC + 262144 <= 2 * MiB, "small region");
constexpr size_t WS_WOT = 2 * MiB;
constexpr size_t WS_WBT = 10 * MiB;
constexpr size_t WS_KVM = 22 * MiB;
constexpr size_t WS_RA = 24 * MiB;
constexpr size_t WS_W1T = WS_RA;
constexpr size_t WS_WG8 = WS_RA + 30 * MiB;
constexpr size_t WS_XQ = WS_RA + 46 * MiB;
constexpr size_t OUT_XB = 32 * MiB;
constexpr size_t WS_WKVT = WS_RA + 90 * MiB;
constexpr size_t WS_MEMB = WS_RA + 98 * MiB;
constexpr size_t WS_WFIT = WS_RA;
constexpr size_t WS_WFDT = WS_RA + 44 * MiB;
constexpr size_t WS_SB = WS_RA + 66 * MiB;
constexpr size_t WS_RZ = 128 * MiB;
constexpr size_t WS_Z = WS_RZ;
constexpr size_t WS_PART = WS_RZ;
constexpr size_t WS_MERGED = WS_RZ + 64 * MiB;
constexpr size_t WS_ACT = WS_RZ;
constexpr size_t WS_RG = 248 * MiB;
constexpr size_t WS_GATES = WS_RG;
constexpr size_t WS_YMEM = WS_RG + 48 * MiB;
constexpr size_t WS_X1B = WS_RG;
constexpr size_t WS_END = 344 * MiB;
constexpr int CW_TMO = 0, CW_BAR = 4096;

constexpr int RING_BYTES = 131072;
constexpr int LDS_BYTES = 163840;
constexpr int LDSCTL_OFF = LDS_BYTES - 1024, MISC_OFF = LDSCTL_OFF + 320;
constexpr int NWAVES = 8;

#define LDS_WAIT() asm volatile("s_waitcnt lgkmcnt(0)" ::: "memory")
#define VM_WAIT() asm volatile("s_waitcnt vmcnt(0)" ::: "memory")
#define RLX_AGENT __ATOMIC_RELAXED, __HIP_MEMORY_SCOPE_AGENT
__device__ __forceinline__ unsigned pk2(float lo, float hi) { f32x2 v = {lo, hi}; bf16x2_t b = __builtin_convertvector(v, bf16x2_t); return __builtin_bit_cast(unsigned, b); }
__device__ __forceinline__ float bflo(unsigned u) { return __uint_as_float(u << 16); }
__device__ __forceinline__ float bfhi(unsigned u) { return __uint_as_float(u & 0xffff0000u); }
__device__ __forceinline__ float bf1(bf16 v) { return __uint_as_float((unsigned)v << 16); }
__device__ __forceinline__ float fexp2(float x) { return __builtin_amdgcn_exp2f(x); }
__device__ __forceinline__ float fexp(float x) { return __builtin_amdgcn_exp2f(x * LOG2E); }
__device__ __forceinline__ float flog(float x) { return __builtin_amdgcn_logf(x) * 0.6931471805599453f; }
__device__ __forceinline__ float frcp(float x) { return __builtin_amdgcn_rcpf(x); }
__device__ __forceinline__ float frsq(float x) { return __builtin_amdgcn_rsqf(x); }
__device__ __forceinline__ float sigmoidf_(float x) { return frcp(1.0f + fexp(-x)); }
__device__ __forceinline__ float logsigmoidf_(float x) { return fminf(x, 0.f) - flog(1.0f + fexp(-fabsf(x))); }
__device__ __forceinline__ float wave_sum(float v) {
#pragma unroll
    for (int o = 1; o < 64; o <<= 1) v += __shfl_xor(v, o);
    return v;
}
__device__ __forceinline__ float wave_max(float v) {
#pragma unroll
    for (int o = 1; o < 64; o <<= 1) v = fmaxf(v, __shfl_xor(v, o));
    return v;
}
typedef short v4i16_t __attribute__((ext_vector_type(4)));
__device__ __forceinline__ s16x4 ldtr(LAS const unsigned char* p) { return __builtin_bit_cast(s16x4, __builtin_amdgcn_ds_read_tr16_b64_v4i16((LAS v4i16_t*)p)); }
__device__ __forceinline__ bf16x8 trfrag(LAS const unsigned char* p, int four_rows) {
    const s16x4 lo = ldtr(p), hi = ldtr(p + four_rows);
    return (bf16x8){lo[0], lo[1], lo[2], lo[3], hi[0], hi[1], hi[2], hi[3]};
}
__device__ __forceinline__ int crow(int r, int hi) { return (r & 3) + 8 * (r >> 2) + 4 * hi; }
#define MFMA32(a, b, c) __builtin_amdgcn_mfma_f32_32x32x16_bf16((a), (b), (c), 0, 0, 0)

namespace pg8 {
constexpr int BM = 256, BK = 64, HALF = 128, HTB = HALF * BK * 2, STAGE_BYTES = 8 * HTB, NXCD = 8, WGM = 8;
__host__ __device__ __forceinline__ int lds_byte(int r, int c) { const int st = (r >> 4) * 2 + (c >> 5), rr = r & 15, cc = c & 31, ob = rr * 64 + cc * 2; return st * 1024 + (ob ^ (((ob >> 9) & 1) << 5)); }
__host__ __device__ __forceinline__ void stage_rc(int b, int& R, int& C) { const int st = b / 1024, sb = b % 1024, swz = sb ^ (((sb >> 9) & 1) << 5); R = (st >> 1) * 16 + swz / 64; C = (st & 1) * 32 + (swz % 64) / 2; }
__host__ __device__ __forceinline__ int perm32(int rho) { const int n = rho >> 4, i = rho & 15; return 8 * (i >> 2) + 4 * n + (i & 3); }

struct Unit { int pm, pn, sub; };
struct TileMap {
    int nM, nN, nwg, wgm;
    __device__ __forceinline__ void init(int M, int N, int wgm_) { nM = M / BM; nN = N / BM; nwg = nM * nN; wgm = wgm_; }
    __device__ __forceinline__ void map(int L, int& pm, int& pn) const {
        int wgid = L; { const int q = nwg / NXCD, r = nwg % NXCD, xcd = wgid % NXCD, off = wgid / NXCD; wgid = (xcd < r ? xcd * (q + 1) : r * (q + 1) + (xcd - r) * q) + off; }
        const int nig = wgm * nN, gid = wgid / nig, fm = gid * wgm, gsz = (nM - fm) < wgm ? (nM - fm) : wgm;
        pm = fm + ((wgid % nig) % gsz); pn = (wgid % nig) / gsz;
    }
};
struct SchedPlain {
    TileMap tm; int G, c; const char* A; const char* B; size_t tstep; int pn0 = 0;
    __device__ __forceinline__ bool next(int i, Unit& u) const { const long L = (long)i * G + c; if (L >= tm.nwg) return false; tm.map((int)L, u.pm, u.pn); u.pn += pn0; u.sub = i; return true; }
    __device__ __forceinline__ const char* aptr(const Unit& u) const { return A + (size_t)u.pm * tstep; }
    __device__ __forceinline__ const char* bptr(const Unit& u) const { return B + (size_t)u.pn * tstep; }
};
struct SchedP1 {
    TileMap tm; int G, c; const char* A; const char* B; const char* A2; const char* B2; size_t tstep;
    __device__ __forceinline__ bool next(int i, Unit& u) const {
        long L = (long)i * G + c; if (L < tm.nwg) { tm.map((int)L, u.pm, u.pn); if (u.pn >= 10) u.pn += 2; u.sub = 0; return true; }
        L -= tm.nwg; if (L < 16) { u.pm = (int)(L & 1); u.pn = (int)(L >> 1); u.sub = 1; return true; } return false; }
    __device__ __forceinline__ const char* aptr(const Unit& u) const { return (u.sub ? A2 : A) + (size_t)u.pm * tstep; }
    __device__ __forceinline__ const char* bptr(const Unit& u) const { return (u.sub ? B2 : B) + (size_t)u.pn * tstep; }
};
struct SchedP3 {
    TileMap tm; int G, c; const char* A; const char* A2; const char* B; size_t tstep, astride, bstride;
    __device__ __forceinline__ bool next(int i, Unit& u) const { const int t = i / 3; const long L = (long)t * G + c; if (L >= tm.nwg) return false; tm.map((int)L, u.pm, u.pn); u.sub = i - 3 * t; return true; }
    __device__ __forceinline__ const char* aptr(const Unit& u) const { return (u.sub == 2 ? A2 : A + (size_t)u.sub * astride) + (size_t)u.pm * tstep; }
    __device__ __forceinline__ const char* bptr(const Unit& u) const { return B + (size_t)u.sub * bstride + (size_t)u.pn * tstep; }
};

typedef f32x4 Acc[2][2][4][2];

struct Epi1 {
    static constexpr bool PERM = true, AFTER_DRAIN = false; static constexpr bool CHAIN = false;
    bf16* Z; bf16* GT; bf16* KVM; const float* rinvx; const float* rinvm; const float* b_alpha; const float* b_gate; const float* gk; const float* gkm; LAS unsigned char* lds;
    __device__ __forceinline__ void operator()(const Acc& acc, const Unit& u, int wr, int wc, int fr, int fq) const {
        const int row0 = u.pm * BM + wr * 64 + fr; const int colt = u.pn * BM + wc * 32 + 8 * fq;
        int kind; bf16* base; int ld; const float* bias = nullptr; const float* rv = rinvx;
        if (u.sub) { kind = 0; base = KVM + colt; ld = 2048; rv = rinvm; }
        else if (u.pn < 28) { kind = 0; base = Z + colt; ld = NZ; }
        else if (u.pn < 30) { kind = 1; base = Z + colt; ld = NZ; bias = b_alpha + (colt - ZA_GLA); }
        else { kind = 2; base = GT + (colt - NZ); ld = NGT; bias = b_gate + (colt - NZ); }
        f32x4 bv[2][2];
#pragma unroll
        for (int bj = 0; bj < 2; ++bj)
#pragma unroll
            for (int n = 0; n < 2; ++n) bv[bj][n] = bias ? *(const f32x4*)(bias + bj * HALF + 4 * n) : (f32x4){0.f, 0.f, 0.f, 0.f};
        float rsv[2][4];
#pragma unroll
        for (int ai = 0; ai < 2; ++ai)
#pragma unroll
            for (int m = 0; m < 4; ++m) rsv[ai][m] = rv[row0 + ai * HALF + m * 16];
        const bool kn_mem = u.sub && u.pn < 4;
        if (kn_mem || (!u.sub && u.pn >= ZK_DIFF / BM && u.pn < ZV_DIFF / BM)) {
            LAS float* P = (LAS float*)(lds + RING_BYTES);
#pragma unroll
            for (int ai = 0; ai < 2; ++ai)
#pragma unroll
                for (int m = 0; m < 4; ++m) { const float rs = rsv[ai][m];
#pragma unroll
                    for (int bj = 0; bj < 2; ++bj) { const f32x4 v0 = acc[ai][bj][m][0] * rs, v1 = acc[ai][bj][m][1] * rs;
                        float sq = (v0[0] * v0[0] + v0[1] * v0[1]) + (v0[2] * v0[2] + v0[3] * v0[3]) + (v1[0] * v1[0] + v1[1] * v1[1]) + (v1[2] * v1[2] + v1[3] * v1[3]);
                        sq += __shfl_xor(sq, 16); sq += __shfl_xor(sq, 32);
                        if (fq == 0) P[((ai * HALF + wr * 64 + m * 16 + fr) * 2 + bj) * 4 + wc] = sq; } }
            LDS_WAIT(); __builtin_amdgcn_s_barrier(); asm volatile("" ::: "memory");
            const float* gb = (kn_mem ? gkm : gk) + wc * 32 + 8 * fq; const int gstep = kn_mem ? HALF : 0;
            f32x4 gg[2][2];
#pragma unroll
            for (int bj = 0; bj < 2; ++bj) { gg[bj][0] = *(const f32x4*)(gb + bj * gstep); gg[bj][1] = *(const f32x4*)(gb + bj * gstep + 4); }
#pragma unroll
            for (int ai = 0; ai < 2; ++ai)
#pragma unroll
                for (int m = 0; m < 4; ++m) { const int row = row0 + ai * HALF + m * 16; const float rs = rsv[ai][m]; bf16* rowp = base + (size_t)row * ld;
                    const LAS f32x4* pp = (const LAS f32x4*)(P + (ai * HALF + wr * 64 + m * 16 + fr) * 8); const f32x4 pa = pp[0], pb = pp[1];
                    const float ta = (pa[0] + pa[1]) + (pa[2] + pa[3]), tb = (pb[0] + pb[1]) + (pb[2] + pb[3]);
#pragma unroll
                    for (int bj = 0; bj < 2; ++bj) {
                        const float rn = frsq(kn_mem ? (ta + tb) * (1.0f / 256.0f) + NORM_EPS : (bj ? tb : ta) * (1.0f / 128.0f) + NORM_EPS) * rs;
                        const f32x4 v0 = acc[ai][bj][m][0] * rn * gg[bj][0], v1 = acc[ai][bj][m][1] * rn * gg[bj][1];
                        u32x4 w; w.x = pk2(v0[0], v0[1]); w.y = pk2(v0[2], v0[3]); w.z = pk2(v1[0], v1[1]); w.w = pk2(v1[2], v1[3]);
                        *(u32x4*)(rowp + bj * HALF) = w; } }
            LDS_WAIT(); __builtin_amdgcn_s_barrier(); asm volatile("" ::: "memory");
            return;
        }
#pragma unroll
        for (int ai = 0; ai < 2; ++ai)
#pragma unroll
            for (int m = 0; m < 4; ++m) { const int row = row0 + ai * HALF + m * 16; const float rs = rsv[ai][m]; bf16* rowp = base + (size_t)row * ld;
#pragma unroll
                for (int bj = 0; bj < 2; ++bj) { f32x4 v0 = acc[ai][bj][m][0] * rs + bv[bj][0], v1 = acc[ai][bj][m][1] * rs + bv[bj][1];
                    if (kind == 1) {
#pragma unroll
                        for (int e = 0; e < 4; ++e) { v0[e] = logsigmoidf_(v0[e]) * 0.0625f; v1[e] = logsigmoidf_(v1[e]) * 0.0625f; } }
                    else if (kind == 2) {
#pragma unroll
                        for (int e = 0; e < 4; ++e) { v0[e] = sigmoidf_(v0[e]); v1[e] = sigmoidf_(v1[e]); } }
                    u32x4 w; w.x = pk2(v0[0], v0[1]); w.y = pk2(v0[2], v0[3]); w.z = pk2(v1[0], v1[1]); w.w = pk2(v1[2], v1[3]);
                    *(u32x4*)(rowp + bj * HALF) = w; } }
    }
};
struct EpiG {
    static constexpr bool PERM = true, AFTER_DRAIN = false; static constexpr bool CHAIN = false;
    unsigned char* GT; const float* rinvx; const float* b_gate; bf16* Z; const float* b_alpha;
    __device__ __forceinline__ void operator()(const Acc& acc, const Unit& u, int wr, int wc, int fr, int fq) const {
        const int row0 = u.pm * BM + wr * 64 + fr; const int colt = u.pn * BM + wc * 32 + 8 * fq;
        if (u.pn >= 24) {
            const int zc = ((u.pn < 28) ? 6144 + (u.pn - 24) * BM : (u.pn < 30) ? 7168 + (u.pn - 28) * BM : 2560 + (u.pn - 30) * BM) + wc * 32 + 8 * fq;
            const bool isa = (u.pn >= 28 && u.pn < 30);
            f32x4 bb[2][2];
#pragma unroll
            for (int bj = 0; bj < 2; ++bj)
#pragma unroll
                for (int n = 0; n < 2; ++n) bb[bj][n] = isa ? *(const f32x4*)(b_alpha + (zc - 7168) + bj * HALF + 4 * n) : (f32x4){0.f, 0.f, 0.f, 0.f};
            float rz[2][4];
#pragma unroll
            for (int ai = 0; ai < 2; ++ai)
#pragma unroll
                for (int m = 0; m < 4; ++m) rz[ai][m] = rinvx[row0 + ai * HALF + m * 16] * (1.0f / 512.0f);
#pragma unroll
            for (int ai = 0; ai < 2; ++ai)
#pragma unroll
                for (int m = 0; m < 4; ++m) { const int row = row0 + ai * HALF + m * 16; const float rs = rz[ai][m]; bf16* rowp = Z + (size_t)row * NZ + zc;
#pragma unroll
                    for (int bj = 0; bj < 2; ++bj) { f32x4 v0 = acc[ai][bj][m][0] * rs + bb[bj][0], v1 = acc[ai][bj][m][1] * rs + bb[bj][1];
                        if (isa) {
#pragma unroll
                            for (int e = 0; e < 4; ++e) { v0[e] = logsigmoidf_(v0[e]) * 0.0625f; v1[e] = logsigmoidf_(v1[e]) * 0.0625f; } }
                        u32x4 w; w.x = pk2(v0[0], v0[1]); w.y = pk2(v0[2], v0[3]); w.z = pk2(v1[0], v1[1]); w.w = pk2(v1[2], v1[3]);
                        *(u32x4*)(rowp + bj * HALF) = w; } }
            return;
        }
        f32x4 bv[2][2];
#pragma unroll
        for (int bj = 0; bj < 2; ++bj)
#pragma unroll
            for (int n = 0; n < 2; ++n) bv[bj][n] = *(const f32x4*)(b_gate + colt + bj * HALF + 4 * n);
        float rsv[2][4];
#pragma unroll
        for (int ai = 0; ai < 2; ++ai)
#pragma unroll
            for (int m = 0; m < 4; ++m) rsv[ai][m] = rinvx[row0 + ai * HALF + m * 16] * (1.0f / 512.0f);
#pragma unroll
        for (int ai = 0; ai < 2; ++ai)
#pragma unroll
            for (int m = 0; m < 4; ++m) { const int row = row0 + ai * HALF + m * 16; const float rs = rsv[ai][m]; unsigned char* rowp = GT + (size_t)row * NGT + colt;
#pragma unroll
                for (int bj = 0; bj < 2; ++bj) { f32x4 v0 = acc[ai][bj][m][0] * rs + bv[bj][0], v1 = acc[ai][bj][m][1] * rs + bv[bj][1];
                    unsigned q0[4], q1[4];
#pragma unroll
                    for (int e = 0; e < 4; ++e) { q0[e] = (unsigned)fmaxf(sigmoidf_(v0[e]) * 255.0f + 0.5f, 1.0f); q1[e] = (unsigned)fmaxf(sigmoidf_(v1[e]) * 255.0f + 0.5f, 1.0f); }
                    u32x2 w; w.x = q0[0] | (q0[1] << 8) | (q0[2] << 16) | (q0[3] << 24); w.y = q1[0] | (q1[1] << 8) | (q1[2] << 16) | (q1[3] << 24);
                    *(u32x2*)(rowp + bj * HALF) = w; } }
    }
};
struct Epi3 {
    static constexpr bool PERM = true, AFTER_DRAIN = false, CHAIN = true;
    const unsigned char* GT; bf16* MERGED;
    static __device__ __forceinline__ float ub(unsigned w, int i) { return (float)((w >> (8 * i)) & 0xffu); }
    __device__ __forceinline__ void chain(Acc& acc, const Unit& u, int wr, int wc, int fr, int fq) const {
        const int row0 = u.pm * BM + wr * 64 + fr; const int col0 = u.pn * BM + wc * 32 + 8 * fq;
        const int sub = u.sub, subn = (u.sub < 2) ? u.sub + 1 : 2;
#pragma unroll
        for (int ai = 0; ai < 2; ++ai) {
            u32x2 g[4][2], h[4][2];
#pragma unroll
            for (int m = 0; m < 4; ++m)
#pragma unroll
                for (int bj = 0; bj < 2; ++bj) { const unsigned char* p = GT + (size_t)(row0 + ai * HALF + m * 16) * NGT + col0 + bj * HALF;
                    g[m][bj] = *(const u32x2*)(p + sub * DM); h[m][bj] = *(const u32x2*)(p + subn * DM); }
#pragma unroll
            for (int m = 0; m < 4; ++m)
#pragma unroll
                for (int bj = 0; bj < 2; ++bj) { const u32x2 gg = g[m][bj], hh = h[m][bj];
                    float sc[8];
                    if (sub < 2) {
#pragma unroll
                        for (int e = 0; e < 8; ++e) sc[e] = ub(e < 4 ? gg.x : gg.y, e & 3) * frcp(ub(e < 4 ? hh.x : hh.y, e & 3));
                    } else {
#pragma unroll
                        for (int e = 0; e < 8; ++e) sc[e] = ub(e < 4 ? gg.x : gg.y, e & 3) * (1.0f / 255.0f);
                    }
                    f32x4 a0 = acc[ai][bj][m][0], a1 = acc[ai][bj][m][1];
                    a0 *= (f32x4){sc[0], sc[1], sc[2], sc[3]}; a1 *= (f32x4){sc[4], sc[5], sc[6], sc[7]};
                    if (sub < 2) { acc[ai][bj][m][0] = a0; acc[ai][bj][m][1] = a1; }
                    else { u32x4 w; w.x = pk2(a0[0], a0[1]); w.y = pk2(a0[2], a0[3]); w.z = pk2(a1[0], a1[1]); w.w = pk2(a1[2], a1[3]);
                        *(u32x4*)(MERGED + (size_t)(row0 + ai * HALF + m * 16) * DM + col0 + bj * HALF) = w; } }
            asm volatile("" ::: "memory");
        }
    }
};
struct Epi4 {
    static constexpr bool PERM = true, AFTER_DRAIN = true; static constexpr bool CHAIN = false;
    const bf16* X; bf16* X1B; float* SS8;
    __device__ __forceinline__ void fused(Acc& acc, const Unit& u, int wr, int wc, int fr, int fq, LAS unsigned char* lds, int wid, int lane) const {
        LAS float* P = (LAS float*)lds;
        const int row0 = u.pm * BM + wr * 64 + fr; const int col0 = u.pn * BM + wc * 32 + 8 * fq;
#pragma unroll
        for (int ai = 0; ai < 2; ++ai)
#pragma unroll
            for (int mp = 0; mp < 2; ++mp) {
                u32x4 xr[2][2];
#pragma unroll
                for (int mm = 0; mm < 2; ++mm)
#pragma unroll
                    for (int bj = 0; bj < 2; ++bj) { const size_t off = (size_t)(row0 + ai * HALF + (2 * mp + mm) * 16) * DM + col0 + bj * HALF; xr[mm][bj] = *(const u32x4*)(X + off); }
#pragma unroll
                for (int mm = 0; mm < 2; ++mm) { const int m = 2 * mp + mm; float s = 0.f;
#pragma unroll
                    for (int bj = 0; bj < 2; ++bj) { const size_t off = (size_t)(row0 + ai * HALF + m * 16) * DM + col0 + bj * HALF;
                        const u32x4 x = xr[mm][bj];
                        const f32x4 v0 = acc[ai][bj][m][0] + (f32x4){bflo(x.x), bfhi(x.x), bflo(x.y), bfhi(x.y)}, v1 = acc[ai][bj][m][1] + (f32x4){bflo(x.z), bfhi(x.z), bflo(x.w), bfhi(x.w)};
                        u32x4 w; w.x = pk2(v0[0], v0[1]); w.y = pk2(v0[2], v0[3]); w.z = pk2(v1[0], v1[1]); w.w = pk2(v1[2], v1[3]); *(u32x4*)(X1B + off) = w;
                        s += (v0[0] * v0[0] + v0[1] * v0[1]) + (v0[2] * v0[2] + v0[3] * v0[3]) + (v1[0] * v1[0] + v1[1] * v1[1]) + (v1[2] * v1[2] + v1[3] * v1[3]); }
                    s += __shfl_xor(s, 16); s += __shfl_xor(s, 32);
                    if (fq == 0) P[(ai * HALF + wr * 64 + m * 16 + fr) * 4 + wc] = s; }
                asm volatile("" ::: "memory");
            }
        LDS_WAIT(); __builtin_amdgcn_s_barrier(); asm volatile("" ::: "memory");
        const int t = wid * 64 + lane;
        if (t < 256) { const float s = (P[t * 4 + 0] + P[t * 4 + 1]) + (P[t * 4 + 2] + P[t * 4 + 3]); SS8[(size_t)(u.pm * BM + t) * 8 + u.pn] = s; }
    }
};
struct Epi5 {
    static constexpr bool PERM = true, AFTER_DRAIN = false; static constexpr bool CHAIN = false;
    const LAS float* RTAB; bf16* ACT;
    __device__ __forceinline__ void operator()(const Acc& acc, const Unit& u, int wr, int wc, int fr, int fq) const {
        const int row0 = u.pm * BM + wr * 64 + fr; const int col0 = u.pn * HALF + wc * 32 + 8 * fq;
        float rsv[2][4];
#pragma unroll
        for (int ai = 0; ai < 2; ++ai)
#pragma unroll
            for (int m = 0; m < 4; ++m) rsv[ai][m] = RTAB[u.sub * BM + ai * HALF + wr * 64 + m * 16 + fr];
#pragma unroll
        for (int ai = 0; ai < 2; ++ai)
#pragma unroll
            for (int m = 0; m < 4; ++m) { const int row = row0 + ai * HALF + m * 16; const float rs = rsv[ai][m];
                float o[8];
#pragma unroll
                for (int n = 0; n < 2; ++n)
#pragma unroll
                    for (int e = 0; e < 4; ++e) { const float g = acc[ai][0][m][n][e] * rs, up = acc[ai][1][m][n][e] * rs; o[4 * n + e] = g * sigmoidf_(g) * up; }
                u32x4 w; w.x = pk2(o[0], o[1]); w.y = pk2(o[2], o[3]); w.z = pk2(o[4], o[5]); w.w = pk2(o[6], o[7]);
                *(u32x4*)(ACT + (size_t)row * DFF + col0) = w; }
    }
};
struct Epi6 {
    static constexpr bool PERM = true, AFTER_DRAIN = false; static constexpr bool CHAIN = false;
    const bf16* X1B; float* OUT;
    __device__ __forceinline__ void operator()(const Acc& acc, const Unit& u, int wr, int wc, int fr, int fq) const {
        const int row0 = u.pm * BM + wr * 64 + fr; const int col0 = u.pn * BM + wc * 32 + 8 * fq;
#pragma unroll
        for (int ai = 0; ai < 2; ++ai) {
            u32x4 xr[4][2];
#pragma unroll
            for (int m = 0; m < 4; ++m)
#pragma unroll
                for (int bj = 0; bj < 2; ++bj) xr[m][bj] = *(const u32x4*)(X1B + (size_t)(row0 + ai * HALF + m * 16) * DM + col0 + bj * HALF);
#pragma unroll
            for (int m = 0; m < 4; ++m)
#pragma unroll
                for (int bj = 0; bj < 2; ++bj) { float* p = OUT + (size_t)(row0 + ai * HALF + m * 16) * DM + col0 + bj * HALF; const u32x4 x = xr[m][bj];
                    *(f32x4*)p = (f32x4){bflo(x.x), bfhi(x.x), bflo(x.y), bfhi(x.y)} + acc[ai][bj][m][0]; *(f32x4*)(p + 4) = (f32x4){bflo(x.z), bfhi(x.z), bflo(x.w), bfhi(x.w)} + acc[ai][bj][m][1]; }
            asm volatile("" ::: "memory");
        }
    }
};

template <class Epi, class Sched, bool ALIGN_EPI, bool SP2>
__device__ __forceinline__ void gemm_phase(LAS unsigned char* lds, const int K, const Sched& S, const Epi& E) {
    const int tid = threadIdx.x, wid = __builtin_amdgcn_readfirstlane(tid >> 6), lane = tid & 63, wr = wid >> 2, wc = wid & 3, fr = lane & 15, fq = lane >> 4;
    const int nt = K / BK;
    unsigned voffA[2], voffB[2];
#pragma unroll
    for (int i = 0; i < 2; ++i) { int R, C; stage_rc(tid * 16 + i * 8192, R, C); const int Rb = Epi::PERM ? ((R & ~31) + perm32(R & 31)) : R;
        voffA[i] = (unsigned)(R * K + C) * 2u; voffB[i] = (unsigned)(Rb * K + C) * 2u; }
    const size_t kstep = (size_t)(BK * 2);
    const size_t hstep = (size_t)HALF * K * 2;
    const unsigned ldsw = (unsigned)wid * 1024u;
    const int aoff = lds_byte(wr * 64 + fr, fq * 8), boff = lds_byte(wc * 32 + fr, fq * 8);
#define PG8_SA(b, h) (((b) * 2 + (h)) * HTB)
#define PG8_SB(b, h) ((4 + (b) * 2 + (h)) * HTB)
#define PG8_STAGE(bufoff, gbase, voff) do { _Pragma("unroll") for (int _i = 0; _i < 2; ++_i) \
        __builtin_amdgcn_global_load_lds((const unsigned*)((const char*)(gbase) + (voff)[_i]), (LAS unsigned*)(lds + (bufoff) + ldsw + _i * 8192), 16, 0, 0); } while (0)
#define PG8_LDA(dst, b, h) do { _Pragma("unroll") for (int m = 0; m < 4; ++m) _Pragma("unroll") for (int k = 0; k < 2; ++k) dst[m][k] = *(const LAS bf16x8*)(lds + PG8_SA(b, h) + aoff + m * 2048 + k * 1024); } while (0)
#define PG8_LDB(dst, b, h) do { _Pragma("unroll") for (int n = 0; n < 2; ++n) _Pragma("unroll") for (int k = 0; k < 2; ++k) dst[n][k] = *(const LAS bf16x8*)(lds + PG8_SB(b, h) + boff + n * 2048 + k * 1024); } while (0)
#define PG8_MMA(ai, bj, At, Bt) do { __builtin_amdgcn_s_setprio(1); _Pragma("unroll") for (int m = 0; m < 4; ++m) _Pragma("unroll") for (int n = 0; n < 2; ++n) _Pragma("unroll") for (int k = 0; k < 2; ++k) \
        acc[ai][bj][m][n] = __builtin_amdgcn_mfma_f32_16x16x32_bf16(Bt[n][k], At[m][k], acc[ai][bj][m][n], 0, 0, 0); __builtin_amdgcn_s_setprio(0); } while (0)
#define PG8_WAIT_V(n) asm volatile("s_waitcnt vmcnt(" #n ")" ::: "memory")
#define PG8_WAIT_L(n) asm volatile("s_waitcnt lgkmcnt(" #n ")" ::: "memory")
#define PG8_BAR __builtin_amdgcn_s_barrier()
#define PG8_SCHED __builtin_amdgcn_sched_barrier(0)
    Unit cur, nxt; int ui = 0;
    if (!S.next(0, cur)) return;
    Acc acc;
#pragma unroll
    for (int a = 0; a < 2; ++a)
#pragma unroll
        for (int b = 0; b < 2; ++b)
#pragma unroll
            for (int m = 0; m < 4; ++m)
#pragma unroll
                for (int n = 0; n < 2; ++n) acc[a][b][m][n] = (f32x4){0.f, 0.f, 0.f, 0.f};
    bf16x8 At[4][2], B0[2][2], B1[2][2];
    const char* cA = S.aptr(cur); const char* cB = S.bptr(cur);
    if constexpr (SP2) {
        PG8_STAGE(PG8_SB(0, 0), cB, voffB); PG8_STAGE(PG8_SB(0, 1), cB + hstep, voffB); PG8_STAGE(PG8_SA(0, 0), cA, voffA); PG8_STAGE(PG8_SA(0, 1), cA + hstep, voffA);
        if (wr == 1) PG8_BAR;
        PG8_WAIT_V(2); PG8_BAR;
        PG8_STAGE(PG8_SB(1, 0), cB + kstep, voffB); PG8_STAGE(PG8_SA(1, 0), cA + kstep, voffA); PG8_STAGE(PG8_SB(1, 1), cB + hstep + kstep, voffB);
        PG8_WAIT_V(6); PG8_BAR;
    } else {
        PG8_STAGE(PG8_SB(0, 0), cB, voffB); PG8_STAGE(PG8_SA(0, 0), cA, voffA); PG8_STAGE(PG8_SB(0, 1), cB + hstep, voffB); PG8_STAGE(PG8_SA(0, 1), cA + hstep, voffA);
        if (wr == 1) PG8_BAR;
        PG8_WAIT_V(4); PG8_BAR;
        PG8_STAGE(PG8_SB(1, 0), cB + kstep, voffB); PG8_STAGE(PG8_SA(1, 0), cA + kstep, voffA); PG8_STAGE(PG8_SB(1, 1), cB + hstep + kstep, voffB);
        PG8_WAIT_V(6); PG8_BAR;
    }
    for (;;) {
        const bool has_next = S.next(ui + 1, nxt);
        const char* nA = has_next ? S.aptr(nxt) : cA; const char* nB = has_next ? S.bptr(nxt) : cB;
        for (int t = 0; t < nt; t += 2) {
            const bool last = (t == nt - 2);
            const char* a1 = cA + (size_t)(t + 1) * kstep;
            const char* a2 = last ? nA : cA + (size_t)(t + 2) * kstep; const char* b2 = last ? nB : cB + (size_t)(t + 2) * kstep;
            const char* a3 = a2 + kstep; const char* b3 = b2 + kstep;
            if constexpr (SP2) {
            PG8_LDB(B0, 0, 0); PG8_LDB(B1, 0, 1); PG8_SCHED; PG8_LDA(At, 0, 0); PG8_STAGE(PG8_SA(1, 1), a1 + hstep, voffA);
            PG8_WAIT_V(8); PG8_WAIT_L(0); PG8_BAR; PG8_MMA(0, 0, At, B0); PG8_MMA(0, 1, At, B1); PG8_BAR; PG8_SCHED;
            PG8_LDA(At, 0, 1); PG8_STAGE(PG8_SB(0, 0), b2, voffB); PG8_STAGE(PG8_SB(0, 1), b2 + hstep, voffB); PG8_STAGE(PG8_SA(0, 0), a2, voffA);
            PG8_WAIT_V(8); PG8_WAIT_L(0); PG8_BAR; PG8_MMA(1, 0, At, B0); PG8_MMA(1, 1, At, B1); PG8_BAR; PG8_SCHED;
            PG8_LDB(B0, 1, 0); PG8_LDB(B1, 1, 1); PG8_SCHED; PG8_LDA(At, 1, 0); PG8_STAGE(PG8_SA(0, 1), a2 + hstep, voffA);
            PG8_WAIT_V(8); PG8_WAIT_L(0); PG8_BAR; PG8_MMA(0, 0, At, B0); PG8_MMA(0, 1, At, B1); PG8_BAR; PG8_SCHED;
            PG8_LDA(At, 1, 1); PG8_STAGE(PG8_SB(1, 0), b3, voffB); PG8_STAGE(PG8_SB(1, 1), b3 + hstep, voffB); PG8_STAGE(PG8_SA(1, 0), a3, voffA);
            PG8_WAIT_V(8); PG8_WAIT_L(0); PG8_BAR; PG8_MMA(1, 0, At, B0); PG8_MMA(1, 1, At, B1); PG8_BAR; PG8_SCHED;
            } else {
            PG8_LDB(B0, 0, 0); PG8_SCHED; PG8_LDA(At, 0, 0); PG8_STAGE(PG8_SA(1, 1), a1 + hstep, voffA);
            PG8_WAIT_L(8); PG8_BAR; PG8_WAIT_L(0); PG8_MMA(0, 0, At, B0); PG8_BAR; PG8_SCHED;
            PG8_LDB(B1, 0, 1); PG8_STAGE(PG8_SB(0, 0), b2, voffB);
            PG8_BAR; PG8_WAIT_L(0); PG8_MMA(0, 1, At, B1); PG8_BAR;
            PG8_LDA(At, 0, 1); PG8_STAGE(PG8_SA(0, 0), a2, voffA);
            PG8_BAR; PG8_WAIT_L(0); PG8_MMA(1, 0, At, B0); PG8_BAR; PG8_SCHED;
            PG8_STAGE(PG8_SB(0, 1), b2 + hstep, voffB);
            PG8_WAIT_V(6); PG8_BAR; PG8_MMA(1, 1, At, B1); PG8_BAR;
            PG8_LDB(B0, 1, 0); PG8_SCHED; PG8_LDA(At, 1, 0); PG8_STAGE(PG8_SA(0, 1), a2 + hstep, voffA);
            PG8_WAIT_L(8); PG8_BAR; PG8_WAIT_L(0); PG8_MMA(0, 0, At, B0); PG8_BAR; PG8_SCHED;
            PG8_LDB(B1, 1, 1); PG8_STAGE(PG8_SB(1, 0), b3, voffB);
            PG8_BAR; PG8_WAIT_L(0); PG8_MMA(0, 1, At, B1); PG8_BAR;
            PG8_LDA(At, 1, 1); PG8_STAGE(PG8_SA(1, 0), a3, voffA);
            PG8_BAR; PG8_WAIT_L(0); PG8_MMA(1, 0, At, B0); PG8_BAR; PG8_SCHED;
            PG8_STAGE(PG8_SB(1, 1), b3 + hstep, voffB);
            PG8_WAIT_V(6); PG8_BAR; PG8_MMA(1, 1, At, B1); PG8_BAR;
            }
        }
        if constexpr (ALIGN_EPI) { if (wr == 0) PG8_BAR; }
        if constexpr (!Epi::AFTER_DRAIN) { if constexpr (Epi::CHAIN) E.chain(acc, cur, wr, wc, fr, fq); else E(acc, cur, wr, wc, fr, fq); }
        if (!has_next) break;
        if (!(Epi::CHAIN && nxt.sub != 0))
#pragma unroll
        for (int a = 0; a < 2; ++a)
#pragma unroll
            for (int b = 0; b < 2; ++b)
#pragma unroll
                for (int m = 0; m < 4; ++m)
#pragma unroll
                    for (int n = 0; n < 2; ++n) acc[a][b][m][n] = (f32x4){0.f, 0.f, 0.f, 0.f};
        cur = nxt; cA = nA; cB = nB; ++ui;
        if constexpr (ALIGN_EPI) { if (wr == 1) PG8_BAR; }
    }
    PG8_WAIT_V(0);
    if constexpr (!ALIGN_EPI) { if (wr == 0) PG8_BAR; }
    PG8_BAR;
    if constexpr (Epi::AFTER_DRAIN) { E.fused(acc, cur, wr, wc, fr, fq, lds, wid, lane); }
#undef PG8_SA
#undef PG8_SB
#undef PG8_STAGE
#undef PG8_LDA
#undef PG8_LDB
#undef PG8_MMA
#undef PG8_WAIT_V
#undef PG8_WAIT_L
#undef PG8_BAR
#undef PG8_SCHED
}
typedef int v8i_t __attribute__((ext_vector_type(8)));
typedef int v4i_t __attribute__((ext_vector_type(4)));
template <class Epi, class Sched, bool ALIGN_EPI, bool SP2>
__device__ __forceinline__ void gemm_phase8(LAS unsigned char* lds, const int K, const Sched& S, const Epi& E) {
    const int tid = threadIdx.x, wid = __builtin_amdgcn_readfirstlane(tid >> 6), lane = tid & 63, wr = wid >> 2, wc = wid & 3, fr = lane & 15, fq = lane >> 4;
    const int nt = K / BK;
    unsigned voffA[2], voffB[2];
#pragma unroll
    for (int i = 0; i < 2; ++i) { int R, C; stage_rc(tid * 16 + i * 8192, R, C); const int Rb = Epi::PERM ? ((R & ~31) + perm32(R & 31)) : R;
        voffA[i] = (unsigned)(R * K + C) * 2u; voffB[i] = (unsigned)(Rb * K + C) * 2u; }
    const size_t kstep = (size_t)(BK * 2);
    const size_t hstep = (size_t)HALF * K * 2;
    const unsigned ldsw = (unsigned)wid * 1024u;
    const int aoff = lds_byte(wr * 64 + fr, fq * 16), boff = lds_byte(wc * 32 + fr, fq * 16);
#define PG8_SA(b, h) (((b) * 2 + (h)) * HTB)
#define PG8_SB(b, h) ((4 + (b) * 2 + (h)) * HTB)
#define PG8_STAGE(bufoff, gbase, voff) do { _Pragma("unroll") for (int _i = 0; _i < 2; ++_i) \
        __builtin_amdgcn_global_load_lds((const unsigned*)((const char*)(gbase) + (voff)[_i]), (LAS unsigned*)(lds + (bufoff) + ldsw + _i * 8192), 16, 0, 0); } while (0)
#define PG8_LD32(p) __builtin_shufflevector(*(const LAS v4i_t*)(p), *(const LAS v4i_t*)((p) + 16), 0, 1, 2, 3, 4, 5, 6, 7)
#define PG8_LDA(dst, b, h) do { _Pragma("unroll") for (int m = 0; m < 4; ++m) dst[m] = PG8_LD32(lds + PG8_SA(b, h) + aoff + m * 2048); } while (0)
#define PG8_LDB(dst, b, h) do { _Pragma("unroll") for (int n = 0; n < 2; ++n) dst[n] = PG8_LD32(lds + PG8_SB(b, h) + boff + n * 2048); } while (0)
#define PG8_MMA(ai, bj, At, Bt) do { __builtin_amdgcn_s_setprio(1); _Pragma("unroll") for (int m = 0; m < 4; ++m) _Pragma("unroll") for (int n = 0; n < 2; ++n) \
        asm volatile("v_mfma_scale_f32_16x16x128_f8f6f4 %0, %1, %2, %0, %3, %3 op_sel_hi:[0,0,0]" : "+v"(acc[ai][bj][m][n]) : "v"(Bt[n]), "v"(At[m]), "v"(mxscale)); __builtin_amdgcn_s_setprio(0); } while (0)
#define PG8_WAIT_V(n) asm volatile("s_waitcnt vmcnt(" #n ")" ::: "memory")
#define PG8_WAIT_L(n) asm volatile("s_waitcnt lgkmcnt(" #n ")" ::: "memory")
#define PG8_BAR __builtin_amdgcn_s_barrier()
#define PG8_SCHED __builtin_amdgcn_sched_barrier(0)
    Unit cur, nxt; int ui = 0;
    if (!S.next(0, cur)) return;
    Acc acc;
#pragma unroll
    for (int a = 0; a < 2; ++a)
#pragma unroll
        for (int b = 0; b < 2; ++b)
#pragma unroll
            for (int m = 0; m < 4; ++m)
#pragma unroll
                for (int n = 0; n < 2; ++n) acc[a][b][m][n] = (f32x4){0.f, 0.f, 0.f, 0.f};
    v8i_t At[4], B0[2], B1[2]; int mxscale = 0x7f7f7f7f; asm volatile("" : "+v"(mxscale));
    const char* cA = S.aptr(cur); const char* cB = S.bptr(cur);
    if constexpr (SP2) {
        PG8_STAGE(PG8_SB(0, 0), cB, voffB); PG8_STAGE(PG8_SB(0, 1), cB + hstep, voffB); PG8_STAGE(PG8_SA(0, 0), cA, voffA); PG8_STAGE(PG8_SA(0, 1), cA + hstep, voffA);
        if (wr == 1) PG8_BAR;
        PG8_WAIT_V(2); PG8_BAR;
        PG8_STAGE(PG8_SB(1, 0), cB + kstep, voffB); PG8_STAGE(PG8_SA(1, 0), cA + kstep, voffA); PG8_STAGE(PG8_SB(1, 1), cB + hstep + kstep, voffB);
        PG8_WAIT_V(6); PG8_BAR;
    } else {
        PG8_STAGE(PG8_SB(0, 0), cB, voffB); PG8_STAGE(PG8_SA(0, 0), cA, voffA); PG8_STAGE(PG8_SB(0, 1), cB + hstep, voffB); PG8_STAGE(PG8_SA(0, 1), cA + hstep, voffA);
        if (wr == 1) PG8_BAR;
        PG8_WAIT_V(4); PG8_BAR;
        PG8_STAGE(PG8_SB(1, 0), cB + kstep, voffB); PG8_STAGE(PG8_SA(1, 0), cA + kstep, voffA); PG8_STAGE(PG8_SB(1, 1), cB + hstep + kstep, voffB);
        PG8_WAIT_V(6); PG8_BAR;
    }
    for (;;) {
        const bool has_next = S.next(ui + 1, nxt);
        const char* nA = has_next ? S.aptr(nxt) : cA; const char* nB = has_next ? S.bptr(nxt) : cB;
        for (int t = 0; t < nt; t += 2) {
            const bool last = (t == nt - 2);
            const char* a1 = cA + (size_t)(t + 1) * kstep;
            const char* a2 = last ? nA : cA + (size_t)(t + 2) * kstep; const char* b2 = last ? nB : cB + (size_t)(t + 2) * kstep;
            const char* a3 = a2 + kstep; const char* b3 = b2 + kstep;
            if constexpr (SP2) {
            PG8_LDB(B0, 0, 0); PG8_LDB(B1, 0, 1); PG8_SCHED; PG8_LDA(At, 0, 0); PG8_STAGE(PG8_SA(1, 1), a1 + hstep, voffA);
            PG8_WAIT_V(8); PG8_WAIT_L(0); PG8_BAR; PG8_MMA(0, 0, At, B0); PG8_MMA(0, 1, At, B1); PG8_BAR; PG8_SCHED;
            PG8_LDA(At, 0, 1); PG8_STAGE(PG8_SB(0, 0), b2, voffB); PG8_STAGE(PG8_SB(0, 1), b2 + hstep, voffB); PG8_STAGE(PG8_SA(0, 0), a2, voffA);
            PG8_WAIT_V(8); PG8_WAIT_L(0); PG8_BAR; PG8_MMA(1, 0, At, B0); PG8_MMA(1, 1, At, B1); PG8_BAR; PG8_SCHED;
            PG8_LDB(B0, 1, 0); PG8_LDB(B1, 1, 1); PG8_SCHED; PG8_LDA(At, 1, 0); PG8_STAGE(PG8_SA(0, 1), a2 + hstep, voffA);
            PG8_WAIT_V(8); PG8_WAIT_L(0); PG8_BAR; PG8_MMA(0, 0, At, B0); PG8_MMA(0, 1, At, B1); PG8_BAR; PG8_SCHED;
            PG8_LDA(At, 1, 1); PG8_STAGE(PG8_SB(1, 0), b3, voffB); PG8_STAGE(PG8_SB(1, 1), b3 + hstep, voffB); PG8_STAGE(PG8_SA(1, 0), a3, voffA);
            PG8_WAIT_V(8); PG8_WAIT_L(0); PG8_BAR; PG8_MMA(1, 0, At, B0); PG8_MMA(1, 1, At, B1); PG8_BAR; PG8_SCHED;
            } else {
            PG8_LDB(B0, 0, 0); PG8_SCHED; PG8_LDA(At, 0, 0); PG8_STAGE(PG8_SA(1, 1), a1 + hstep, voffA);
            PG8_WAIT_L(8); PG8_BAR; PG8_WAIT_L(0); PG8_MMA(0, 0, At, B0); PG8_BAR; PG8_SCHED;
            PG8_LDB(B1, 0, 1); PG8_STAGE(PG8_SB(0, 0), b2, voffB);
            PG8_BAR; PG8_WAIT_L(0); PG8_MMA(0, 1, At, B1); PG8_BAR;
            PG8_LDA(At, 0, 1); PG8_STAGE(PG8_SA(0, 0), a2, voffA);
            PG8_BAR; PG8_WAIT_L(0); PG8_MMA(1, 0, At, B0); PG8_BAR; PG8_SCHED;
            PG8_STAGE(PG8_SB(0, 1), b2 + hstep, voffB);
            PG8_WAIT_V(6); PG8_BAR; PG8_MMA(1, 1, At, B1); PG8_BAR;
            PG8_LDB(B0, 1, 0); PG8_SCHED; PG8_LDA(At, 1, 0); PG8_STAGE(PG8_SA(0, 1), a2 + hstep, voffA);
            PG8_WAIT_L(8); PG8_BAR; PG8_WAIT_L(0); PG8_MMA(0, 0, At, B0); PG8_BAR; PG8_SCHED;
            PG8_LDB(B1, 1, 1); PG8_STAGE(PG8_SB(1, 0), b3, voffB);
            PG8_BAR; PG8_WAIT_L(0); PG8_MMA(0, 1, At, B1); PG8_BAR;
            PG8_LDA(At, 1, 1); PG8_STAGE(PG8_SA(1, 0), a3, voffA);
            PG8_BAR; PG8_WAIT_L(0); PG8_MMA(1, 0, At, B0); PG8_BAR; PG8_SCHED;
            PG8_STAGE(PG8_SB(1, 1), b3 + hstep, voffB);
            PG8_WAIT_V(6); PG8_BAR; PG8_MMA(1, 1, At, B1); PG8_BAR;
            }
        }
        if constexpr (ALIGN_EPI) { if (wr == 0) PG8_BAR; }
        asm volatile("s_nop 15\n\ts_nop 7" ::: "memory");
        if constexpr (!Epi::AFTER_DRAIN) { E(acc, cur, wr, wc, fr, fq); }
        if (!has_next) break;
#pragma unroll
        for (int a = 0; a < 2; ++a)
#pragma unroll
            for (int b = 0; b < 2; ++b)
#pragma unroll
                for (int m = 0; m < 4; ++m)
#pragma unroll
                    for (int n = 0; n < 2; ++n) acc[a][b][m][n] = (f32x4){0.f, 0.f, 0.f, 0.f};
        cur = nxt; cA = nA; cB = nB; ++ui;
        if constexpr (ALIGN_EPI) { if (wr == 1) PG8_BAR; }
    }
    PG8_WAIT_V(0);
    if constexpr (!ALIGN_EPI) { if (wr == 0) PG8_BAR; }
    PG8_BAR;
    if constexpr (Epi::AFTER_DRAIN) { E.fused(acc, cur, wr, wc, fr, fq, lds, wid, lane); }
#undef PG8_SA
#undef PG8_SB
#undef PG8_STAGE
#undef PG8_LDA
#undef PG8_LDB
#undef PG8_MMA
#undef PG8_LD32
#undef PG8_WAIT_V
#undef PG8_WAIT_L
#undef PG8_BAR
#undef PG8_SCHED
}
}

#define XB_TMO      128
#define XB_XCNT(j)  (256  + 64 * (j))
#define XB_XSUB(j)  (1280 + 64 * (j))
#define XB_XGEN(j)  (2304 + 64 * (j))
#define XB_TOP      3328
#define XB_TOPGEN   3392
#define XCD_BAR_WORDS 3456
#define XB_SPIN_CAP (1u << 20)
__device__ __forceinline__ unsigned xb_ld(unsigned* p)              { return __hip_atomic_load(p, __ATOMIC_RELAXED, __HIP_MEMORY_SCOPE_AGENT); }
__device__ __forceinline__ unsigned xb_add(unsigned* p, unsigned v) { return __hip_atomic_fetch_add(p, v, __ATOMIC_RELAXED, __HIP_MEMORY_SCOPE_AGENT); }
__device__ __forceinline__ unsigned xb_xcc_id() { return (unsigned)__builtin_amdgcn_s_getreg((3 << 11) | 20) & 0xFu; }
#define XB_SPIN(cond, bar) do { unsigned _sp = 0; while (cond) { __builtin_amdgcn_s_sleep(1); \
    if ((++_sp & 255u) == 0u) { if (xb_ld(&(bar)[XB_TMO])) break; if (_sp > XB_SPIN_CAP) { atomicAdd(&(bar)[XB_TMO], 1u); break; } } } } while (0)
struct XcdBarrier { unsigned* bar; unsigned x; volatile LAS unsigned* st; };
__device__ __forceinline__ XcdBarrier xcd_barrier_post(unsigned* bar, volatile LAS unsigned* st) {
    XcdBarrier b; b.bar = bar; b.x = xb_xcc_id(); b.st = st;
    if (threadIdx.x == 0) (void)xb_add(&bar[XB_XCNT(b.x)], 1u);
    return b;
}
__device__ __forceinline__ void xcd_barrier_complete(unsigned* bar, unsigned x, unsigned& nloc, unsigned& nx) {
    const unsigned G = gridDim.x * gridDim.y * gridDim.z;
    unsigned sum, cnt, mine, sp = 0u;
    for (;;) {
        sum = 0u; cnt = 0u; mine = 0u;
#pragma unroll
        for (unsigned j = 0; j < 16; ++j) { const unsigned c = xb_ld(&bar[XB_XCNT(j)]); sum += c; cnt += (c > 0u) ? 1u : 0u; mine = (j == x) ? c : mine; }
        if (sum == G) break;
        __builtin_amdgcn_s_sleep(1);
        if ((++sp & 255u) == 0u) { if (xb_ld(&bar[XB_TMO])) break; if (sp > XB_SPIN_CAP) { atomicAdd(&bar[XB_TMO], 1u); break; } }
    }
    nloc = mine > 0u ? mine : 1u; nx = cnt > 0u ? cnt : 1u;
}
__device__ __forceinline__ void xcd_arrive(const XcdBarrier& b) {
    asm volatile("s_waitcnt vmcnt(0)" ::: "memory");
    __syncthreads();
    if (threadIdx.x == 0) {
        unsigned* bar = b.bar;
        __builtin_amdgcn_s_waitcnt(0);
        unsigned nloc = b.st[0], nx = b.st[1]; const unsigned n = b.st[2];
        if (nloc == 0u) { xcd_barrier_complete(bar, b.x, nloc, nx); b.st[0] = nloc; b.st[1] = nx; }
        const unsigned old = xb_add(&bar[XB_XSUB(b.x)], 1u);
        if (old + 1u == (n + 1u) * nloc) {
            __builtin_amdgcn_fence(__ATOMIC_RELEASE, "agent");
            asm volatile("s_waitcnt vmcnt(0)" ::: "memory");
            (void)xb_add(&bar[XB_TOP], 1u);
        }
    }
}
__device__ __forceinline__ void xcd_wait(const XcdBarrier& b) {
    if (threadIdx.x == 0) {
        unsigned* bar = b.bar;
        const unsigned nx = b.st[1], n = b.st[2];
        { const unsigned target = (n + 1u) * nx; unsigned _sp = 0; while (xb_ld(&bar[XB_TOP]) < target) { __builtin_amdgcn_s_sleep(2);
              if ((++_sp & 255u) == 0u) { if (xb_ld(&bar[XB_TMO])) break; if (_sp > XB_SPIN_CAP) { atomicAdd(&bar[XB_TMO], 1u); break; } } } }
        __builtin_amdgcn_fence(__ATOMIC_ACQUIRE, "agent");
        asm volatile("s_waitcnt vmcnt(0)" ::: "memory");
        b.st[2] = n + 1u;
    }
    __syncthreads();
}
__device__ __forceinline__ void xcd_barrier(const XcdBarrier& b) { xcd_arrive(b); xcd_wait(b); }

struct Frame {
    LAS unsigned char* lds;
    int tid, lane, wave, vcu, G;
    const float* in[25]; float* out; unsigned char* ws;
};
#define WSP(T, off) ((T*)(F.ws + (off)))
#define XBP ((bf16*)((unsigned char*)F.out + OUT_XB))

struct TrItem { const float* src; const float* gain; bf16* dst; int ldw, K, f8; };
__device__ __forceinline__ unsigned pk4_fp8(float a, float b, float c, float d) { int p = 0; p = __builtin_amdgcn_cvt_pk_fp8_f32(a, b, p, false); p = __builtin_amdgcn_cvt_pk_fp8_f32(c, d, p, true); return (unsigned)p; }
__device__ __forceinline__ void tr_load(f32x4 (&v)[8], const TrItem& t, int lane) {
    const float* p = t.src + (size_t)(8 * (lane & 7)) * t.ldw + 4 * (lane >> 3);
#pragma unroll
    for (int j = 0; j < 8; ++j) v[j] = __builtin_nontemporal_load((const f32x4*)(p + (size_t)j * t.ldw));
}
__device__ __forceinline__ void tr_store(const f32x4 (&v)[8], const TrItem& t, int lane) {
    float g[8];
    if (t.gain) { const f32x4 g0 = *(const f32x4*)(t.gain + 8 * (lane & 7)), g1 = *(const f32x4*)(t.gain + 8 * (lane & 7) + 4);
        g[0] = g0[0]; g[1] = g0[1]; g[2] = g0[2]; g[3] = g0[3]; g[4] = g1[0]; g[5] = g1[1]; g[6] = g1[2]; g[7] = g1[3]; }
    else {
#pragma unroll
        for (int j = 0; j < 8; ++j) g[j] = 1.0f; }
    if (t.f8) {
        unsigned char* d8 = (unsigned char*)t.dst + (size_t)(4 * (lane >> 3)) * t.K + 8 * (lane & 7);
#pragma unroll
        for (int i = 0; i < 4; ++i) { u32x2 o; o.x = pk4_fp8(v[0][i] * g[0] * 64.f, v[1][i] * g[1] * 64.f, v[2][i] * g[2] * 64.f, v[3][i] * g[3] * 64.f);
            o.y = pk4_fp8(v[4][i] * g[4] * 64.f, v[5][i] * g[5] * 64.f, v[6][i] * g[6] * 64.f, v[7][i] * g[7] * 64.f);
            *(GAS u32x2*)(d8 + (size_t)i * t.K) = o; }
        return; }
    bf16* d = t.dst + (size_t)(4 * (lane >> 3)) * t.K + 8 * (lane & 7);
#pragma unroll
    for (int i = 0; i < 4; ++i) { u32x4 o; o.x = pk2(v[0][i] * g[0], v[1][i] * g[1]); o.y = pk2(v[2][i] * g[2], v[3][i] * g[3]); o.z = pk2(v[4][i] * g[4], v[5][i] * g[5]); o.w = pk2(v[6][i] * g[6], v[7][i] * g[7]);
        *(GAS u32x4*)(d + (size_t)i * t.K) = o; }
}
__device__ __forceinline__ void tr_alpha(const float* win, const float* wup, const float* gain, unsigned char* dst8, int k0, int n0, int lane) {
    const int lk = lane & 7, ln = lane >> 3;
    f32x4 wu[16];
#pragma unroll
    for (int r = 0; r < 16; ++r) wu[r] = *(const f32x4*)(wup + r * 512 + n0 + 4 * ln);
    f32x4 av[8][4];
#pragma unroll
    for (int j = 0; j < 8; ++j) { const float* a = win + (size_t)(k0 + 8 * lk + j) * WIN_LD + 3072;
#pragma unroll
        for (int r4 = 0; r4 < 4; ++r4) av[j][r4] = *(const f32x4*)(a + 4 * r4); }
    asm volatile("" ::: "memory");
    f32x4 v[8];
#pragma unroll
    for (int j = 0; j < 8; ++j) { f32x4 acc = {0.f, 0.f, 0.f, 0.f};
#pragma unroll
        for (int r4 = 0; r4 < 4; ++r4) acc += wu[4 * r4] * av[j][r4][0] + wu[4 * r4 + 1] * av[j][r4][1] + wu[4 * r4 + 2] * av[j][r4][2] + wu[4 * r4 + 3] * av[j][r4][3];
        v[j] = acc; }
    TrItem t; t.f8 = 1; t.src = nullptr; t.gain = gain + k0; t.dst = (bf16*)(dst8 + (size_t)n0 * DM + k0); t.ldw = 0; t.K = DM;
    tr_store(v, t, lane);
}
__device__ __forceinline__ void row_to_bf16(const float* xrow, bf16* orow, float* rinv, int lane, unsigned* qrow = nullptr) {
    const GAS f32x4* xr = (const GAS f32x4*)xrow + lane;
    f32x4 v[8]; float s = 0.f;
#pragma unroll
    for (int j = 0; j < 8; ++j) { v[j] = __builtin_nontemporal_load(xr + 64 * j); s += (v[j].x * v[j].x + v[j].y * v[j].y) + (v[j].z * v[j].z + v[j].w * v[j].w); }
    s = wave_sum(s);
    if (lane == 0) *rinv = 1.0f / sqrtf(s * (1.0f / DM) + NORM_EPS);
    GAS u32x2* o8 = (GAS u32x2*)orow + lane;
#pragma unroll
    for (int j = 0; j < 8; ++j) { u32x2 w; w.x = pk2(v[j].x, v[j].y); w.y = pk2(v[j].z, v[j].w); o8[64 * j] = w; }
    if (qrow) {
#pragma unroll
        for (int j = 0; j < 8; ++j) ((GAS unsigned*)qrow)[lane + 64 * j] = pk4_fp8(v[j].x * 8.f, v[j].y * 8.f, v[j].z * 8.f, v[j].w * 8.f); }
}

__device__ __forceinline__ TrItem p0_item(Frame& F, int r) {
    constexpr int I_A = 32 * 80, I_B = 32 * 96;
    const float* w_in = F.in[4]; const float* g_mix = F.in[2]; bf16* W1T = WSP(bf16, WS_W1T);
    TrItem t; t.f8 = 0;
    if (r < I_A) { const int kb = r / 80, nb = r % 80; t.src = w_in + (size_t)(64 * kb) * WIN_LD + 32 * nb; t.ldw = WIN_LD; t.gain = g_mix + 64 * kb; t.dst = W1T + (size_t)(32 * nb) * DM + 64 * kb; t.K = DM; return t; } r -= I_A;
    if (r < I_B) { const int kb = r / 96, nb = r % 96; t.src = w_in + (size_t)(64 * kb) * WIN_LD + 3088 + 32 * nb; t.ldw = WIN_LD; t.gain = g_mix + 64 * kb; t.dst = W1T + (size_t)(3072 + 32 * nb) * DM + 64 * kb; t.K = DM; return t; } r -= I_B;
    { const int kb = r / 64, nb = r % 64; t.src = F.in[17] + (size_t)(64 * kb) * 2048 + 32 * nb; t.ldw = 2048; t.gain = F.in[3] + 64 * kb; t.dst = WSP(bf16, WS_WKVT) + (size_t)(32 * nb) * DM + 64 * kb; t.K = DM; return t; }
}
__device__ __forceinline__ TrItem p0g_item(Frame& F, int r) {
    TrItem t; t.f8 = 1;
    if (r < 32 * 192) { const int kb = r / 192, nb = r % 192; t.src = F.in[19] + (size_t)(64 * kb) * NGT + 32 * nb; t.ldw = NGT; t.gain = F.in[2] + 64 * kb; t.dst = (bf16*)(F.ws + WS_WG8 + (size_t)(32 * nb) * DM + 64 * kb); t.K = DM; return t; } r -= 32 * 192;
    if (r < 32 * 32) { const int kb = r / 32, nb = r % 32;
        t.src = F.in[4] + (size_t)(64 * kb) * WIN_LD + 6160 + 32 * nb; t.ldw = WIN_LD; t.gain = F.in[2] + 64 * kb; t.dst = (bf16*)(F.ws + WS_WG8 + (size_t)(6144 + 32 * nb) * DM + 64 * kb); t.K = DM; return t; } r -= 32 * 32;
    { const int kb = r / 16, nb = r % 16;
        t.src = F.in[4] + (size_t)(64 * kb) * WIN_LD + 2560 + 32 * nb; t.ldw = WIN_LD; t.gain = F.in[2] + 64 * kb; t.dst = (bf16*)(F.ws + WS_WG8 + (size_t)(7680 + 32 * nb) * DM + 64 * kb); t.K = DM; return t; }
}
__device__ __forceinline__ TrItem p1t_item(Frame& F, int r) {
    constexpr int I_BR = 3 * 16 * 64;
    TrItem t; t.f8 = 0;
    if (r < I_BR) { const int br = r / 1024, q = r % 1024, kb = q / 64, nb = q % 64;
        t.src = F.in[18] + (size_t)br * 1024 * 2048 + (size_t)(64 * kb) * 2048 + 32 * nb; t.ldw = 2048; t.gain = nullptr; t.dst = WSP(bf16, WS_WBT) + (size_t)br * 2048 * 1024 + (size_t)(32 * nb) * 1024 + 64 * kb; t.K = 1024; return t; } r -= I_BR;
    { const int kb = r / 64, nb = r % 64; t.src = F.in[21] + (size_t)(64 * kb) * 2048 + 32 * nb; t.ldw = 2048; t.gain = nullptr; t.dst = WSP(bf16, WS_WOT) + (size_t)(32 * nb) * DM + 64 * kb; t.K = DM; return t; }
}
__device__ __forceinline__ TrItem p2_item(Frame& F, int r) {
    TrItem t; t.f8 = 0;
    { const int kb = r / 352, nb = r % 352; const int j0 = 32 * nb; const int drow = (j0 < DFF) ? (256 * (j0 / 128) + (j0 % 128)) : (256 * ((j0 - DFF) / 128) + 128 + ((j0 - DFF) % 128));
        t.src = F.in[23] + (size_t)(64 * kb) * (2 * DFF) + j0; t.ldw = 2 * DFF; t.gain = F.in[22] + 64 * kb; t.dst = WSP(bf16, WS_WFIT) + (size_t)drow * DM + 64 * kb; t.K = DM; return t; }
}
__device__ __forceinline__ TrItem p5t_item(Frame& F, int r) {
    TrItem t; t.f8 = 0;
    { const int kb = r / 64, nb = r % 64; t.src = F.in[24] + (size_t)(64 * kb) * DM + 32 * nb; t.ldw = DM; t.gain = nullptr; t.dst = WSP(bf16, WS_WFDT) + (size_t)(32 * nb) * DFF + 64 * kb; t.K = DFF; return t; }
}
#define TR_RUN(DECODE, NITEMS) do { \
    for (int it = gw; it < (NITEMS); it += 4 * NGW) { const int it2 = it + NGW, it3 = it + 2 * NGW, it4 = it + 3 * NGW; const bool two = it2 < (NITEMS), three = it3 < (NITEMS), four = it4 < (NITEMS); \
        const TrItem ta = DECODE(F, it); const TrItem tb = DECODE(F, two ? it2 : it); const TrItem tc = DECODE(F, three ? it3 : it); const TrItem td = DECODE(F, four ? it4 : it); \
        f32x4 va[8], vb[8], vc[8], vd[8]; tr_load(va, ta, F.lane); if (two) tr_load(vb, tb, F.lane); if (three) tr_load(vc, tc, F.lane); if (four) tr_load(vd, td, F.lane); \
        tr_store(va, ta, F.lane); if (two) tr_store(vb, tb, F.lane); if (three) tr_store(vc, tc, F.lane); if (four) tr_store(vd, td, F.lane); } } while (0)

__device__ __forceinline__ void p0_prologue(Frame& F) {
    const int gw = F.vcu * NWAVES + F.wave, NGW = F.G * NWAVES;
    constexpr int NITEMS = 32 * 80 + 32 * 96 + 32 * 64;
    for (int it = NGW - 1 - gw; it < 32 * 16; it += NGW) { const int kb = it / 16, nb = it % 16; tr_alpha(F.in[4], F.in[5], F.in[2], F.ws + WS_WG8 + (size_t)7168 * DM, 64 * kb, 32 * nb, F.lane); }
    TR_RUN(p0_item, NITEMS);
    for (int m = gw; m < TOK; m += NGW) row_to_bf16(F.in[0] + (size_t)m * DM, XBP + (size_t)m * DM, WSP(float, WS_RINVX) + m, F.lane, (unsigned*)(F.ws + WS_XQ + (size_t)m * DM));
    for (int m = gw; m < MEMROWS; m += NGW) row_to_bf16(F.in[1] + (size_t)m * DM, WSP(bf16, WS_MEMB) + (size_t)m * DM, WSP(float, WS_RINVM) + m, F.lane);
    if (gw == 0) {
        const int l = F.lane;
        float d1 = F.in[10][l] * F.in[11][l] + F.in[10][l + 64] * F.in[11][l + 64];
        float d2 = F.in[12][l] * F.in[13][l] + F.in[12][l + 64] * F.in[13][l + 64];
        d1 = wave_sum(d1); d2 = wave_sum(d2);
        const float gq = wave_max(fmaxf(fabsf(F.in[8][l]), fabsf(F.in[8][l + 64]))), gk = wave_max(fmaxf(fabsf(F.in[9][l]), fabsf(F.in[9][l + 64])));
        const float mq = wave_max(fmaxf(fmaxf(fabsf(F.in[15][l]), fabsf(F.in[15][l + 64])), fmaxf(fabsf(F.in[15][l + 128]), fabsf(F.in[15][l + 192]))));
        const float mk = wave_max(fmaxf(fmaxf(fabsf(F.in[16][l]), fabsf(F.in[16][l + 64])), fmaxf(fabsf(F.in[16][l + 128]), fabsf(F.in[16][l + 192]))));
        if (l == 0) { float* sc = WSP(float, WS_SC); sc[0] = expf(d1) - expf(d2) + LAM_INIT; sc[1] = 11.313708499f * gq * gk * LOG2E; sc[2] = 16.0f * mq * mk * LOG2E; }
    }
}
__device__ __forceinline__ void p0_gates(Frame& F) {
    const int gw = F.vcu * NWAVES + F.wave, NGW = F.G * NWAVES;
    TR_RUN(p0g_item, 32 * 192 + 32 * 32 + 32 * 16);
}
__device__ __forceinline__ void p2_convert(Frame& F) {
    const int gw = F.vcu * NWAVES + F.wave, NGW = F.G * NWAVES;
    TR_RUN(p2_item, 32 * 352);
}
template <int DH>
__device__ __forceinline__ void knorm8(bf16* base  , size_t ld, const float* gain, int lane) {
    constexpr int NCH = DH / 64;
    bf16* p = base + (size_t)(lane >> 3) * ld + (lane & 7) * 8;
    u32x4 v[NCH]; float ss = 0.f;
#pragma unroll
    for (int i = 0; i < NCH; ++i) { v[i] = *(const u32x4*)(p + 64 * i);
        const float a0 = bflo(v[i].x), a1 = bfhi(v[i].x), a2 = bflo(v[i].y), a3 = bfhi(v[i].y), a4 = bflo(v[i].z), a5 = bfhi(v[i].z), a6 = bflo(v[i].w), a7 = bfhi(v[i].w);
        ss += (a0 * a0 + a1 * a1) + (a2 * a2 + a3 * a3) + (a4 * a4 + a5 * a5) + (a6 * a6 + a7 * a7); }
    ss += __shfl_xor(ss, 1); ss += __shfl_xor(ss, 2); ss += __shfl_xor(ss, 4);
    const float rn = frsq(ss * (1.0f / DH) + NORM_EPS);
#pragma unroll
    for (int i = 0; i < NCH; ++i) { const float* g = gain + ((lane & 7) + 8 * i) * 8; const f32x4 g0 = *(const f32x4*)g, g1 = *(const f32x4*)(g + 4);
        u32x4 w;
        w.x = pk2(bflo(v[i].x) * rn * g0[0], bfhi(v[i].x) * rn * g0[1]); w.y = pk2(bflo(v[i].y) * rn * g0[2], bfhi(v[i].y) * rn * g0[3]);
        w.z = pk2(bflo(v[i].z) * rn * g1[0], bfhi(v[i].z) * rn * g1[1]); w.w = pk2(bflo(v[i].w) * rn * g1[2], bfhi(v[i].w) * rn * g1[3]);
        *(u32x4*)(p + 64 * i) = w; }
}

__device__ __forceinline__ void p1_tail_convert(Frame& F, int first, int nw) {
    const int gw = ((int)blockIdx.x - first) * NWAVES + F.wave, NGW = nw * NWAVES;
    TR_RUN(p1t_item, 3 * 16 * 64 + 32 * 64);
}
__device__ __forceinline__ void p5_tail_convert(Frame& F, int first, int nw) {
    const int gw = ((int)blockIdx.x - first) * NWAVES + F.wave, NGW = nw * NWAVES;
    TR_RUN(p5t_item, 88 * 64);
}

constexpr int BG_NH = 2 * 32 * 352;
template <bool V> struct BoolT { static constexpr bool value = V; };
struct BgConv { const float* src; const float* gain; bf16* dst; int h, step; };
__device__ __forceinline__ void bg_load(const BgConv& B, f32x4 (&v)[4], f32x4& gv, int lane) {
    const int hh = (B.h < BG_NH) ? B.h : BG_NH - 1;
    const int r = hh >> 1, half = hh & 1, kb = r / 352, nb = r % 352;
    const float* p = B.src + (size_t)(64 * kb + 4 * half + 8 * (lane & 7)) * (2 * DFF) + 32 * nb + 4 * (lane >> 3);
#pragma unroll
    for (int j = 0; j < 4; ++j) v[j] = __builtin_nontemporal_load((const f32x4*)(p + (size_t)j * (2 * DFF)));
    gv = *(const f32x4*)(B.gain + 64 * kb + 4 * half + 8 * (lane & 7));
}
__device__ __forceinline__ void bg_store(const BgConv& B, const f32x4 (&v)[4], const f32x4& gv, int lane) {
    const int r = B.h >> 1, half = B.h & 1, kb = r / 352, nb = r % 352; const int j0 = 32 * nb;
    const int drow = (j0 < DFF) ? (256 * (j0 / 128) + (j0 % 128)) : (256 * ((j0 - DFF) / 128) + 128 + ((j0 - DFF) % 128));
    bf16* d = B.dst + (size_t)(drow + 4 * (lane >> 3)) * DM + 64 * kb + 4 * half + 8 * (lane & 7);
#pragma unroll
    for (int i = 0; i < 4; ++i) { u32x2 o; o.x = pk2(v[0][i] * gv[0], v[1][i] * gv[1]); o.y = pk2(v[2][i] * gv[2], v[3][i] * gv[3]); *(GAS u32x2*)(d + (size_t)i * DM) = o; }
}

constexpr int AT_K = 0, AT_V = 34816, AT_P = AT_V + 36864, AT_G = AT_P + 18432, AT_L = AT_G + 2048, AT_R = AT_L + 1024, AT_END = AT_R + 1024;
static_assert(AT_END <= RING_BYTES, "attention LDS");
static_assert(RING_BYTES + 256 * 2 * 4 * 4 <= LDSCTL_OFF, "Epi1 K-norm scratch");
constexpr int VST = 576, PST = 144;

__device__ __forceinline__ void tile_load(u32x4 (&r)[4], const bf16* base, int ld, int tid) {
    const bf16* p = base + (size_t)(tid >> 3) * ld + (tid & 7) * 8;
#pragma unroll
    for (int i = 0; i < 4; ++i) r[i] = *(const u32x4*)(p + 64 * i);
}
__device__ __forceinline__ void tile_store_raw(const u32x4 (&r)[4], LAS unsigned char* buf, int tid) {
#pragma unroll
    for (int i = 0; i < 4; ++i) *(LAS u32x4*)(buf + (tid >> 3) * VST + ((tid & 7) + 8 * i) * 16) = r[i];
}
template <int DH, int NCOMP>
__device__ __forceinline__ void tile_store_norm(const u32x4 (&r)[4], LAS unsigned char* buf, const LAS float* gain, float scale, int tid) {
    constexpr int KST = DH * 2 + 16, CPR = DH / 8;
    float ss[2] = {0.f, 0.f};
#pragma unroll
    for (int i = 0; i < 4; ++i) { const int c = (NCOMP == 2) ? (i >> 1) : 0;
        const float a0 = bflo(r[i].x), a1 = bfhi(r[i].x), a2 = bflo(r[i].y), a3 = bfhi(r[i].y), a4 = bflo(r[i].z), a5 = bfhi(r[i].z), a6 = bflo(r[i].w), a7 = bfhi(r[i].w);
        ss[c] += (a0 * a0 + a1 * a1) + (a2 * a2 + a3 * a3) + (a4 * a4 + a5 * a5) + (a6 * a6 + a7 * a7); }
#pragma unroll
    for (int c = 0; c < NCOMP; ++c) { ss[c] += __shfl_xor(ss[c], 1); ss[c] += __shfl_xor(ss[c], 2); ss[c] += __shfl_xor(ss[c], 4); ss[c] = frsq(ss[c] * (1.0f / DH) + NORM_EPS) * scale; }
#pragma unroll
    for (int i = 0; i < 4; ++i) { const int c = (NCOMP == 2) ? (i >> 1) : 0; const int chunk = (tid & 7) + 8 * i, dch = chunk % CPR; const float rn = ss[c];
        const f32x4 g0 = *(const LAS f32x4*)(gain + dch * 8), g1 = *(const LAS f32x4*)(gain + dch * 8 + 4);
        u32x4 w;
        w.x = pk2(bflo(r[i].x) * rn * g0[0], bfhi(r[i].x) * rn * g0[1]); w.y = pk2(bflo(r[i].y) * rn * g0[2], bfhi(r[i].y) * rn * g0[3]);
        w.z = pk2(bflo(r[i].z) * rn * g1[0], bfhi(r[i].z) * rn * g1[1]); w.w = pk2(bflo(r[i].w) * rn * g1[2], bfhi(r[i].w) * rn * g1[3]);
        *(LAS u32x4*)(buf + ((tid >> 3) * NCOMP + c) * KST + dch * 16) = w; }
}

template <int DH, int NCOMP>
__device__ __forceinline__ void tile_store_k(const u32x4 (&r)[4], LAS unsigned char* buf, int tid) {
    constexpr int KST = DH * 2 + 16, CPR = DH / 8;
#pragma unroll
    for (int i = 0; i < 4; ++i) { const int c = (NCOMP == 2) ? (i >> 1) : 0; const int chunk = (tid & 7) + 8 * i, dch = chunk % CPR;
        *(LAS u32x4*)(buf + ((tid >> 3) * NCOMP + c) * KST + dch * 16) = r[i]; }
}
template <int DH, int NCOMP, int NRB>
struct AttnUnit {
    static constexpr int NDV = 8 / NRB, DVW = 256 / NDV, NBLK = DVW / 32, KS = DH / 16, KST = DH * 2 + 16;
    const bf16* Q; int ldq; const bf16* K; int ldk; const bf16* V; int ldv; int ntiles; const float* qg; float m2;
    template <bool BG = false>
    __device__ __forceinline__ void run(LAS unsigned char* lds, f32x16 (&O)[NCOMP][NBLK], BgConv* bg = nullptr) const {
        int tid = threadIdx.x; asm volatile("" : "+v"(tid));
        const int lane = tid & 63, wid = __builtin_amdgcn_readfirstlane(tid >> 6), r = lane & 31, h = lane >> 5;
        const int kh = wid & 1, compA = (wid >> 1) % NCOMP, rbA = wid / (2 * NCOMP);
        const int dvp = wid % NDV, rbB = wid / NDV;
        const int b16 = (lane >> 4) & 1, q4 = (lane & 15) >> 2, p4 = lane & 3;
        LAS unsigned char* kbuf = lds + AT_K; LAS unsigned char* vbuf = lds + AT_V; LAS unsigned char* pbuf = lds + AT_P;
        LAS float* gq = (LAS float*)(lds + AT_G); LAS float* lbuf = (LAS float*)(lds + AT_L);
        if (tid < DH) gq[tid] = qg[tid];
        __syncthreads();
        bf16x8 qf[KS];
        const float qscale = ((DH == 128) ? 0.08838834764831845f : 0.0625f) * LOG2E;
#pragma unroll
        for (int pass = 0; pass < NRB / 2; ++pass) {
            u32x4 qr[4]; tile_load(qr, Q + (size_t)(64 * pass) * ldq, ldq, tid);
            tile_store_norm<DH, NCOMP>(qr, kbuf, gq, qscale, tid);
            __syncthreads();
            if (rbA / 2 == pass) {
#pragma unroll
                for (int s = 0; s < KS; ++s) qf[s] = *(const LAS bf16x8*)(kbuf + ((32 * (rbA & 1) + r) * NCOMP + compA) * KST + (16 * s + 8 * h) * 2);
            }
            __syncthreads();
        }
        u32x4 kreg[4], vreg[4];
        tile_load(kreg, K, ldk, tid); tile_load(vreg, V, ldv, tid);
        tile_store_k<DH, NCOMP>(kreg, kbuf, tid);
#pragma unroll
        for (int c = 0; c < NCOMP; ++c)
#pragma unroll
            for (int b = 0; b < NBLK; ++b)
#pragma unroll
                for (int i = 0; i < 16; ++i) O[c][b][i] = 0.f;
        float lsum = 0.f;
        f32x4 bgv[4], bgg;
        __syncthreads();
        auto body = [&](const int t, auto moret, auto bgt) {
            constexpr bool more = decltype(moret)::value, BGI = decltype(bgt)::value;
            if (more) tile_load(kreg, K + (size_t)(64 * (t + 1)) * ldk, ldk, tid);
            f32x16 st;
#pragma unroll
            for (int i = 0; i < 16; ++i) st[i] = 0.f;
            if (DH == 128) {
                bf16x8 kfa[KS];
#pragma unroll
                for (int s = 0; s < KS; ++s) kfa[s] = *(const LAS bf16x8*)(kbuf + ((32 * kh + r) * NCOMP + compA) * KST + (16 * s + 8 * h) * 2);
                asm volatile("" ::: "memory");
                tile_store_raw(vreg, vbuf, tid);
#pragma unroll
                for (int s = 0; s < KS; ++s) st = MFMA32(kfa[s], qf[s], st);
            } else {
            tile_store_raw(vreg, vbuf, tid);
#pragma unroll
            for (int s = 0; s < KS; ++s) { const bf16x8 kf = *(const LAS bf16x8*)(kbuf + ((32 * kh + r) * NCOMP + compA) * KST + (16 * s + 8 * h) * 2); st = MFMA32(kf, qf[s], st);
                if ((s & 3) == 3) asm volatile("" ::: "memory"); }
            }
            float pe[16];
#pragma unroll
            for (int i = 0; i < 16; ++i) { pe[i] = fexp2(st[i] - m2); lsum += pe[i]; }
#pragma unroll
            for (int g = 0; g < 4; ++g) { u32x2 w; w.x = pk2(pe[4 * g], pe[4 * g + 1]); w.y = pk2(pe[4 * g + 2], pe[4 * g + 3]);
                *(LAS u32x2*)(pbuf + ((compA * NRB + rbA) * 32 + r) * PST + (32 * kh + 8 * g + 4 * h) * 2) = w; }
            __syncthreads();
            if (more) tile_load(vreg, V + (size_t)(64 * (t + 1)) * ldv, ldv, tid);
#pragma unroll
            for (int s = 0; s < 4; ++s) {
                bf16x8 pf[NCOMP];
#pragma unroll
                for (int c = 0; c < NCOMP; ++c) pf[c] = *(const LAS bf16x8*)(pbuf + ((c * NRB + rbB) * 32 + r) * PST + (16 * s + 8 * h) * 2);
#pragma unroll
                for (int b = 0; b < NBLK; ++b) {
                    const bf16x8 vf = trfrag(vbuf + (16 * s + 8 * h + q4) * VST + (DVW * dvp + 32 * b + 16 * b16 + 4 * p4) * 2, 4 * VST);
#pragma unroll
                    for (int c = 0; c < NCOMP; ++c) O[c][b] = MFMA32(pf[c], vf, O[c][b]);
                }
                asm volatile("" ::: "memory");
                if (DH == 128 && s == 1) { if (more) tile_store_k<DH, NCOMP>(kreg, kbuf, tid); }
            }
            if (DH != 128) { if (more) tile_store_k<DH, NCOMP>(kreg, kbuf, tid); }
            if constexpr (BGI) { bg_store(*bg, bgv, bgg, lane); bg->h += bg->step; bg_load(*bg, bgv, bgg, lane); }
            __syncthreads();
        };
        int t = 0;
        if constexpr (BG) {
            int n = 0; if (bg->h < BG_NH) { n = (BG_NH - 1 - bg->h) / bg->step + 1; const int fit = (ntiles - 1) / 2; n = (n < fit) ? n : fit; }
            if (n > 0) { bg_load(*bg, bgv, bgg, lane);
#pragma unroll 1
                for (int g = 0; g < n; ++g, t += 2) { body(t, BoolT<true>{}, BoolT<false>{}); body(t + 1, BoolT<true>{}, BoolT<true>{}); } } }
        for (; t < ntiles - 1; ++t) body(t, BoolT<true>{}, BoolT<false>{});
        body(ntiles - 1, BoolT<false>{}, BoolT<false>{});
        lsum += __shfl_xor(lsum, 32);
        if (h == 0) lbuf[((compA * NRB + rbA) * 2 + kh) * 32 + r] = lsum;
        __syncthreads();
    }
};

template <bool BG = false>
__device__ __forceinline__ void diff_unit(Frame& F, int bh, int c, BgConv* bg = nullptr) {
    typedef AttnUnit<128, 2, 2> AU;
    const int b = bh >> 2, hd = bh & 3;
    const bf16* Z = WSP(bf16, WS_Z); const float* sc = WSP(float, WS_SC);
    AU u; u.Q = Z + (size_t)(b * SEQ + 64 * c) * NZ + ZQ_DIFF + hd * 256; u.ldq = NZ; u.K = Z + (size_t)(b * SEQ) * NZ + ZK_DIFF + hd * 256; u.ldk = NZ;
    u.V = Z + (size_t)(b * SEQ) * NZ + ZV_DIFF + hd * 256; u.ldv = NZ; u.ntiles = c + 1; u.qg = F.in[8]; u.m2 = sc[1];
    f32x16 O[2][2];
    u.template run<BG>(F.lds, O, bg);
    int tid = F.tid; asm volatile("" : "+v"(tid));
    const int lane = tid & 63, wid = F.wave, r = lane & 31, h = lane >> 5, dvp = wid & 3, rbB = wid >> 2;
    LAS unsigned char* lds = F.lds;
    const LAS float* lbuf = (const LAS float*)(lds + AT_L);
    const float lam = sc[0];
    if (tid < 256) ((LAS float*)(lds + AT_G + 1024))[tid] = F.in[14][tid] * (1.0f - LAM_INIT);
#pragma unroll
    for (int i = 0; i < 16; ++i) { const int q = crow(i, h);
        const float l1 = lbuf[((0 * 2 + rbB) * 2 + 0) * 32 + q] + lbuf[((0 * 2 + rbB) * 2 + 1) * 32 + q];
        const float l2 = lbuf[((1 * 2 + rbB) * 2 + 0) * 32 + q] + lbuf[((1 * 2 + rbB) * 2 + 1) * 32 + q];
        const float i1 = frcp(l1), i2 = lam * frcp(l2);
        LAS unsigned char* orow = lds + (32 * rbB + q) * 1024; const int sw = (q & 1) << 4;
        *(LAS float*)(orow + (((64 * dvp + r) * 4) ^ sw)) = O[0][0][i] * i1 - O[1][0][i] * i2;
        *(LAS float*)(orow + (((64 * dvp + 32 + r) * 4) ^ sw)) = O[0][1][i] * i1 - O[1][1][i] * i2; }
    __syncthreads();
    { const int l = tid >> 3, sw = (l & 1) << 4;
      const LAS unsigned char* orow = lds + l * 1024;
      const LAS f32x4* gnt = (const LAS f32x4*)(lds + AT_G + 1024);
      f32x4 o[4][2]; float ss = 0.f;
#pragma unroll
      for (int i = 0; i < 4; ++i) { const int ch = (tid & 7) + 8 * i;
          o[i][0] = *(const LAS f32x4*)(orow + ((ch * 32) ^ sw)); o[i][1] = *(const LAS f32x4*)(orow + ((ch * 32 + 16) ^ sw));
#pragma unroll
          for (int e = 0; e < 4; ++e) ss += o[i][0][e] * o[i][0][e] + o[i][1][e] * o[i][1][e]; }
      ss += __shfl_xor(ss, 1); ss += __shfl_xor(ss, 2); ss += __shfl_xor(ss, 4);
      const float rn = frsq(ss * (1.0f / 256.0f) + NORM_EPS);
      bf16* Y = (bf16*)F.out + (size_t)TOK * 1024 + (size_t)(b * SEQ + 64 * c + l) * 1024 + hd * 256 + (tid & 7) * 8;
#pragma unroll
      for (int i = 0; i < 4; ++i) { const int ch = (tid & 7) + 8 * i;
          const f32x4 g0 = gnt[2 * ch], g1 = gnt[2 * ch + 1];
          u32x4 w;
          w.x = pk2(o[i][0][0] * rn * g0[0], o[i][0][1] * rn * g0[1]); w.y = pk2(o[i][0][2] * rn * g0[2], o[i][0][3] * rn * g0[3]);
          w.z = pk2(o[i][1][0] * rn * g1[0], o[i][1][1] * rn * g1[1]); w.w = pk2(o[i][1][2] * rn * g1[2], o[i][1][3] * rn * g1[3]);
          *(u32x4*)(Y + 64 * i) = w; } }
    __syncthreads();
}
__device__ __forceinline__ void mem_unit(Frame& F, int b, int hd, int qb) {
    typedef AttnUnit<256, 1, 4> AU;
    const bf16* Z = WSP(bf16, WS_Z); const bf16* KVM = WSP(bf16, WS_KVM); const float* sc = WSP(float, WS_SC);
    AU u; u.Q = Z + (size_t)(b * SEQ + 128 * qb) * NZ + ZQ_MEM + hd * 256; u.ldq = NZ; u.K = KVM + (size_t)(b * NMEM) * 2048 + hd * 256; u.ldk = 2048;
    u.V = KVM + (size_t)(b * NMEM) * 2048 + 1024 + hd * 256; u.ldv = 2048; u.ntiles = 4; u.qg = F.in[15]; u.m2 = sc[2];
    f32x16 O[1][4];
    u.run(F.lds, O);
    const int lane = F.lane, wid = F.wave, r = lane & 31, h = lane >> 5, dvp = wid & 1, rbB = wid >> 1;
    const LAS float* lbuf = (const LAS float*)(F.lds + AT_L);
    bf16* Y = WSP(bf16, WS_YMEM);
#pragma unroll
    for (int i = 0; i < 16; ++i) { const int q = crow(i, h);
        const float il = frcp(lbuf[(rbB * 2 + 0) * 32 + q] + lbuf[(rbB * 2 + 1) * 32 + q]);
        bf16* yp = Y + (size_t)(b * SEQ + 128 * qb + 32 * rbB + q) * 1024 + hd * 256 + 128 * dvp + r;
#pragma unroll
        for (int blk = 0; blk < 4; ++blk) yp[32 * blk] = (bf16)(pk2(O[0][blk][i] * il, 0.f) & 0xffffu); }
    __syncthreads();
}

constexpr int GL_LA = 0;
constexpr int GL_VT = 32768;
constexpr int GL_KT = GL_VT + 36864;
constexpr int GL_KD = GL_KT + 20480;
constexpr int GL_ATT = GL_KD + 17408;
constexpr int GL_RED = GL_ATT + 9216;
constexpr int GL_SEG = GL_RED + 2048;
constexpr int GL_GY = GL_SEG + 2048;
static_assert(GL_GY + 32768 <= LDSCTL_OFF, "GLA LDS");
__device__ __forceinline__ void gla_load_la(LAS unsigned char* lds, const bf16* src, int tid) {
    const bf16* p = src + (size_t)(tid >> 3) * NZ + (tid & 7) * 8;
#pragma unroll
    for (int i = 0; i < 2; ++i) { const u32x4 v = *(const u32x4*)(p + 64 * i); LAS float* d = (LAS float*)(lds + GL_LA) + (tid >> 3) * 128 + ((tid & 7) + 8 * i) * 8;
        *(LAS f32x4*)d = (f32x4){bflo(v.x), bfhi(v.x), bflo(v.y), bfhi(v.y)}; *(LAS f32x4*)(d + 4) = (f32x4){bflo(v.z), bfhi(v.z), bflo(v.w), bfhi(v.w)}; }
}
__device__ __forceinline__ void gla_cumsum(LAS unsigned char* lds, int tid) {
    LAS float* la = (LAS float*)(lds + GL_LA) + (tid >> 7) * 16 * 128 + (tid & 127); LAS float* seg = (LAS float*)(lds + GL_SEG);
    float v[16];
#pragma unroll
    for (int i = 0; i < 16; ++i) v[i] = la[i * 128];
#pragma unroll
    for (int i = 1; i < 16; ++i) v[i] += v[i - 1];
    seg[tid] = v[15];
    __syncthreads();
    float off = 0.f;
#pragma unroll
    for (int sgi = 0; sgi < 3; ++sgi) off += (sgi < (tid >> 7)) ? seg[sgi * 128 + (tid & 127)] : 0.f;
#pragma unroll
    for (int i = 0; i < 16; ++i) la[i * 128] = v[i] + off;
}
__device__ __forceinline__ void gla_inc_unit(Frame& F, int bh, int n) {
    int tid = F.tid; asm volatile("" : "+v"(tid));
    const int lane = tid & 63, wid = F.wave, h = lane >> 5, b16 = (lane >> 4) & 1, q4 = (lane & 15) >> 2, p4 = lane & 3;
    const int b = bh >> 2, hd = bh & 3;
    const bf16* zrow = WSP(bf16, WS_Z) + (size_t)(b * SEQ + 64 * n) * NZ;
    LAS unsigned char* lds = F.lds;
    gla_load_la(lds, zrow + ZA_GLA + hd * 128, tid);
    u32x4 kr[2]; { const bf16* p = zrow + ZK_GLA + hd * 128 + (size_t)(tid >> 3) * NZ + (tid & 7) * 8; kr[0] = *(const u32x4*)p; kr[1] = *(const u32x4*)(p + 64); }
    { u32x4 vr[4]; tile_load(vr, zrow + ZV_GLA + hd * 256, NZ, tid); tile_store_raw(vr, lds + GL_VT, tid); }
    __syncthreads();
    gla_cumsum(lds, tid);
    __syncthreads();
    const LAS float* la = (const LAS float*)(lds + GL_LA);
#pragma unroll
    for (int i = 0; i < 2; ++i) { const int l = tid >> 3, d0 = ((tid & 7) + 8 * i) * 8;
        const f32x4 e0 = *(const LAS f32x4*)(la + 63 * 128 + d0), e1 = *(const LAS f32x4*)(la + 63 * 128 + d0 + 4), c0 = *(const LAS f32x4*)(la + l * 128 + d0), c1 = *(const LAS f32x4*)(la + l * 128 + d0 + 4);
        u32x4 w;
        w.x = pk2(bflo(kr[i].x) * fexp(e0[0] - c0[0]), bfhi(kr[i].x) * fexp(e0[1] - c0[1])); w.y = pk2(bflo(kr[i].y) * fexp(e0[2] - c0[2]), bfhi(kr[i].y) * fexp(e0[3] - c0[3]));
        w.z = pk2(bflo(kr[i].z) * fexp(e1[0] - c1[0]), bfhi(kr[i].z) * fexp(e1[1] - c1[1])); w.w = pk2(bflo(kr[i].w) * fexp(e1[2] - c1[2]), bfhi(kr[i].w) * fexp(e1[3] - c1[3]));
        *(LAS u32x4*)(lds + GL_KT + l * 320 + d0 * 2) = w; }
    if (tid < 128) WSP(float, WS_DEC)[(size_t)(bh * 64 + n) * 128 + tid] = fexp(la[63 * 128 + tid]);
    __syncthreads();
    f32x16 acc[4];
#pragma unroll
    for (int c = 0; c < 4; ++c)
#pragma unroll
        for (int i = 0; i < 16; ++i) acc[c][i] = 0.f;
#pragma unroll
    for (int s = 0; s < 4; ++s) {
        const bf16x8 af = trfrag(lds + GL_VT + (16 * s + 8 * h + q4) * VST + (32 * wid + 16 * b16 + 4 * p4) * 2, 4 * VST);
#pragma unroll
        for (int c = 0; c < 4; ++c) { const bf16x8 bf = trfrag(lds + GL_KT + (16 * s + 8 * h + q4) * 320 + (32 * c + 16 * b16 + 4 * p4) * 2, 4 * 320); acc[c] = MFMA32(af, bf, acc[c]); }
    }
    bf16* sb = WSP(bf16, WS_SB) + (size_t)(bh * 64 + n) * 256 * 128;
#pragma unroll
    for (int c = 0; c < 4; ++c)
#pragma unroll
        for (int i = 0; i < 16; ++i) sb[(size_t)(32 * wid + crow(i, h)) * 128 + 32 * c + (lane & 31)] = (bf16)(pk2(acc[c][i], 0.f) & 0xffffu);
    __syncthreads();
}
__device__ __forceinline__ void gla_scan(Frame& F) {
    const int NT = F.G * 512;
    for (int e = F.vcu * 512 + F.tid; e < 8 * 256 * 64; e += NT) {
        const int bh = e >> 14, rem = e & 16383, dv = rem >> 6, dk = (rem & 63) * 2;
        unsigned* sb = (unsigned*)(WSP(bf16, WS_SB) + (size_t)bh * 64 * 256 * 128 + (size_t)dv * 128 + dk);
        const float* dec = WSP(float, WS_DEC) + (size_t)bh * 64 * 128 + dk;
        float s0 = 0.f, s1 = 0.f;
#pragma unroll 8
        for (int n = 0; n < 64; ++n) { const unsigned inc = sb[(size_t)n * 256 * 64]; const f32x2 d = *(const f32x2*)(dec + n * 128);
            sb[(size_t)n * 256 * 64] = pk2(s0, s1); s0 = d.x * s0 + bflo(inc); s1 = d.y * s1 + bfhi(inc); }
    }
}
__device__ __forceinline__ void gla_out_unit(Frame& F, int bh, int n) {
    int tid = F.tid; asm volatile("" : "+v"(tid));
    const int lane = tid & 63, wid = F.wave, r = lane & 31, h = lane >> 5, b16 = (lane >> 4) & 1, q4 = (lane & 15) >> 2, p4 = lane & 3;
    const int b = bh >> 2, hd = bh & 3;
    const bf16* zrow = WSP(bf16, WS_Z) + (size_t)(b * SEQ + 64 * n) * NZ;
    LAS unsigned char* lds = F.lds;
    const bf16* sb = WSP(bf16, WS_SB) + (size_t)(bh * 64 + n) * 256 * 128 + (size_t)(32 * wid + r) * 128 + 8 * h;
    bf16x8 sf[8];
#pragma unroll
    for (int s = 0; s < 8; ++s) sf[s] = *(const bf16x8*)(sb + 16 * s);
    gla_load_la(lds, zrow + ZA_GLA + hd * 128, tid);
    u32x4 qr[2], kr[2];
    { const bf16* p = zrow + ZQ_GLA + hd * 128 + (size_t)(tid >> 3) * NZ + (tid & 7) * 8; qr[0] = *(const u32x4*)p; qr[1] = *(const u32x4*)(p + 64); }
    { const bf16* p = zrow + ZK_GLA + hd * 128 + (size_t)(tid >> 3) * NZ + (tid & 7) * 8; kr[0] = *(const u32x4*)p; kr[1] = *(const u32x4*)(p + 64); }
    { u32x4 vr[4]; tile_load(vr, zrow + ZV_GLA + hd * 256, NZ, tid); tile_store_raw(vr, lds + GL_VT, tid); }
    u32x4 gr[4]; tile_load(gr, zrow + ZG_GLA + hd * 256, NZ, tid);
    if (tid < 256) ((LAS float*)(lds + GL_RED))[tid] = F.in[7][tid];
    __syncthreads();
    gla_cumsum(lds, tid);
    __syncthreads();
    const LAS float* la = (const LAS float*)(lds + GL_LA);
    const float qs = 0.08838834764831845f;
#pragma unroll
    for (int i = 0; i < 2; ++i) { const int l = tid >> 3, d0 = ((tid & 7) + 8 * i) * 8;
        const f32x4 c0 = *(const LAS f32x4*)(la + l * 128 + d0), c1 = *(const LAS f32x4*)(la + l * 128 + d0 + 4);
        float ep[8], en[8];
#pragma unroll
        for (int e = 0; e < 4; ++e) { ep[e] = fexp(c0[e]); en[e] = fexp(-c0[e]); ep[4 + e] = fexp(c1[e]); en[4 + e] = fexp(-c1[e]); }
        u32x4 wq, wk;
        wq.x = pk2(bflo(qr[i].x) * qs * ep[0], bfhi(qr[i].x) * qs * ep[1]); wq.y = pk2(bflo(qr[i].y) * qs * ep[2], bfhi(qr[i].y) * qs * ep[3]);
        wq.z = pk2(bflo(qr[i].z) * qs * ep[4], bfhi(qr[i].z) * qs * ep[5]); wq.w = pk2(bflo(qr[i].w) * qs * ep[6], bfhi(qr[i].w) * qs * ep[7]);
        wk.x = pk2(bflo(kr[i].x) * en[0], bfhi(kr[i].x) * en[1]); wk.y = pk2(bflo(kr[i].y) * en[2], bfhi(kr[i].y) * en[3]);
        wk.z = pk2(bflo(kr[i].z) * en[4], bfhi(kr[i].z) * en[5]); wk.w = pk2(bflo(kr[i].w) * en[6], bfhi(kr[i].w) * en[7]);
        *(LAS u32x4*)(lds + GL_KT + l * 272 + d0 * 2) = wq; *(LAS u32x4*)(lds + GL_KD + l * 272 + d0 * 2) = wk; }
    __syncthreads();
    if (wid < 4) { const int mb = wid >> 1, lb = wid & 1; f32x16 st;
#pragma unroll
        for (int i = 0; i < 16; ++i) st[i] = 0.f;
#pragma unroll
        for (int s = 0; s < 8; ++s) { const bf16x8 kf = *(const LAS bf16x8*)(lds + GL_KD + (32 * mb + r) * 272 + (16 * s + 8 * h) * 2), qf = *(const LAS bf16x8*)(lds + GL_KT + (32 * lb + r) * 272 + (16 * s + 8 * h) * 2);
            st = MFMA32(kf, qf, st); }
        const int lrow = 32 * lb + r;
#pragma unroll
        for (int g = 0; g < 4; ++g) { float v[4];
#pragma unroll
            for (int e = 0; e < 4; ++e) { const int m = 32 * mb + 8 * g + 4 * h + e; v[e] = (m <= lrow) ? st[4 * g + e] : 0.f; }
            u32x2 w; w.x = pk2(v[0], v[1]); w.y = pk2(v[2], v[3]);
            *(LAS u32x2*)(lds + GL_ATT + lrow * PST + (32 * mb + 8 * g + 4 * h) * 2) = w; } }
    f32x16 acc[2];
#pragma unroll
    for (int lb = 0; lb < 2; ++lb)
#pragma unroll
        for (int i = 0; i < 16; ++i) acc[lb][i] = 0.f;
#pragma unroll
    for (int s = 0; s < 8; ++s)
#pragma unroll
        for (int lb = 0; lb < 2; ++lb) { const bf16x8 qf = *(const LAS bf16x8*)(lds + GL_KT + (32 * lb + r) * 272 + (16 * s + 8 * h) * 2); acc[lb] = MFMA32(qf, sf[s], acc[lb]); }
    __syncthreads();
#pragma unroll
    for (int s = 0; s < 4; ++s) { const bf16x8 vf = trfrag(lds + GL_VT + (16 * s + 8 * h + q4) * VST + (32 * wid + 16 * b16 + 4 * p4) * 2, 4 * VST);
#pragma unroll
        for (int lb = 0; lb < 2; ++lb) { const bf16x8 af = *(const LAS bf16x8*)(lds + GL_ATT + (32 * lb + r) * PST + (16 * s + 8 * h) * 2); acc[lb] = MFMA32(af, vf, acc[lb]); } }
#pragma unroll
    for (int lb = 0; lb < 2; ++lb)
#pragma unroll
        for (int i = 0; i < 16; ++i) { const int lr = crow(i, h);
            *(LAS float*)(lds + (lb ? GL_GY : GL_LA) + lr * 1024 + (((32 * wid + r) * 4) ^ ((lr & 1) << 4))) = acc[lb][i]; }
    __syncthreads();
    { const int l = tid >> 3, sw = (l & 1) << 4;
      const LAS unsigned char* orow = lds + ((l & 32) ? GL_GY : GL_LA) + (l & 31) * 1024;
      const LAS f32x4* gnt = (const LAS f32x4*)(lds + GL_RED);
      f32x4 o[4][2]; float ss = 0.f;
#pragma unroll
      for (int i = 0; i < 4; ++i) { const int c = (tid & 7) + 8 * i;
          o[i][0] = *(const LAS f32x4*)(orow + ((c * 32) ^ sw)); o[i][1] = *(const LAS f32x4*)(orow + ((c * 32 + 16) ^ sw));
#pragma unroll
          for (int e = 0; e < 4; ++e) ss += o[i][0][e] * o[i][0][e] + o[i][1][e] * o[i][1][e]; }
      ss += __shfl_xor(ss, 1); ss += __shfl_xor(ss, 2); ss += __shfl_xor(ss, 4);
      const float rn = frsq(ss * (1.0f / 256.0f) + NORM_EPS);
      bf16* Y = (bf16*)F.out + (size_t)(b * SEQ + 64 * n + l) * 1024 + hd * 256 + (tid & 7) * 8;
#pragma unroll
      for (int i = 0; i < 4; ++i) { const int c = (tid & 7) + 8 * i;
          const f32x4 g0 = gnt[2 * c], g1 = gnt[2 * c + 1];
          const unsigned gw[4] = {gr[i].x, gr[i].y, gr[i].z, gr[i].w};
          float y[8];
#pragma unroll
          for (int e = 0; e < 4; ++e) { const float ga = bflo(gw[e]), gb = bfhi(gw[e]);
              const float oa = (e < 2) ? o[i][0][2 * e] : o[i][1][2 * e - 4], ob = (e < 2) ? o[i][0][2 * e + 1] : o[i][1][2 * e - 3];
              const float na = (e < 2) ? g0[2 * e] : g1[2 * e - 4], nb = (e < 2) ? g0[2 * e + 1] : g1[2 * e - 3];
              y[2 * e] = oa * rn * na * (ga * sigmoidf_(ga)); y[2 * e + 1] = ob * rn * nb * (gb * sigmoidf_(gb)); }
          u32x4 w; w.x = pk2(y[0], y[1]); w.y = pk2(y[2], y[3]); w.z = pk2(y[4], y[5]); w.w = pk2(y[6], y[7]);
          *(u32x4*)(Y + 64 * i) = w; } }
    __syncthreads();
}

constexpr int N_PHASES = 9;
constexpr int BM_ROWS = 256;
static_assert(RING_BYTES + 8 * 256 * 4 <= LDSCTL_OFF, "P5 1/rms table");
struct Args { const float* in[25]; float* out; unsigned char* ws; int ph_lo, ph_hi, li, pad; };
__global__ void __launch_bounds__(NWAVES * 64, 2) mk_fwd(Args args) {
    extern __shared__ __attribute__((aligned(16))) unsigned char lds_raw[];
    Frame F;
    F.lds = (LAS unsigned char*)lds_raw;
    F.tid = threadIdx.x; F.lane = F.tid & 63; F.wave = __builtin_amdgcn_readfirstlane(F.tid >> 6);
    F.G = gridDim.x; { const int bx = blockIdx.x; F.vcu = (F.G % 8 == 0) ? (bx % 8) * (F.G / 8) + bx / 8 : bx; }
#pragma unroll
    for (int i = 0; i < 25; ++i) F.in[i] = args.in[i];
    F.out = args.out; F.ws = args.ws;
    volatile LAS unsigned* MISC = (volatile LAS unsigned*)(F.lds + MISC_OFF);
    for (int u = F.tid; u < (LDS_BYTES - LDSCTL_OFF) / 4; u += NWAVES * 64) ((LAS unsigned*)(F.lds + LDSCTL_OFF))[u] = 0u;
    __syncthreads();
    gu32* ctl = (gu32*)(F.ws + WS_CTL);
    XcdBarrier bar; bar.bar = (unsigned*)(ctl + CW_BAR); bar.x = 0; bar.st = nullptr;
    if (MK_N_LAUNCHES == 1) bar = xcd_barrier_post((unsigned*)(ctl + CW_BAR), MISC + 8);
#define GRID_BAR() do { if (MK_N_LAUNCHES == 1) xcd_barrier(bar); } while (0)
    const int lo = args.ph_lo, hi = args.ph_hi;
#ifndef PHMASK
#define PHMASK 0x1ff
#endif
#define IN(k) (((PHMASK >> (k)) & 1) && lo <= (k) && (k) < hi)
#define BOTH(k) (IN(k) && IN((k) + 1))
#ifndef REPMASK
#define REPMASK 0
#endif
#define NREP(k) ((((REPMASK) >> (k)) & 1) ? rt2 : 1)
    const int G = F.G; const int rt2 = 1 + (args.ph_hi > 0);

#if MK_N_LAUNCHES == 1
    { p0_prologue(F); xcd_arrive(bar); p0_gates(F); xcd_wait(bar); xcd_arrive(bar); }
#else
    if (IN(0)) { for (int rep = 0; rep < NREP(0); ++rep) { p0_prologue(F); p0_gates(F); __syncthreads(); } if (BOTH(0)) GRID_BAR(); }
#endif
    if (IN(1)) {
        pg8::SchedP1 S; S.tm.init(TOK, 22 * 256, WGM_P1); S.G = G; S.c = (int)blockIdx.x; S.A = (const char*)XBP; S.B = (const char*)WSP(bf16, WS_W1T);
        S.A2 = (const char*)WSP(bf16, WS_MEMB); S.B2 = (const char*)WSP(bf16, WS_WKVT); S.tstep = (size_t)256 * DM * 2;
        pg8::Epi1 E{WSP(bf16, WS_Z), WSP(bf16, WS_GATES), WSP(bf16, WS_KVM), WSP(float, WS_RINVX), WSP(float, WS_RINVM), F.in[6], F.in[20], F.in[9], F.in[16], F.lds};
#ifndef ONLY8
        for (int rep = 0; rep < NREP(1); ++rep) pg8::gemm_phase<pg8::Epi1, pg8::SchedP1, true, true>(F.lds, DM, S, E);
#endif
        { const int nfull = (S.tm.nwg + 16) % G;
          if (nfull > 0 && (int)blockIdx.x >= nfull) p1_tail_convert(F, nfull, G - nfull); else if (nfull == 0) p1_tail_convert(F, 0, G); }
#if MK_N_LAUNCHES == 1
        xcd_wait(bar);
#endif
        { pg8::SchedPlain S8; S8.tm.init(TOK, 8 * 256, WGM_P1); S8.pn0 = 24; S8.G = G; S8.c = (int)blockIdx.x; S8.A = (const char*)(F.ws + WS_XQ); S8.B = (const char*)(F.ws + WS_WG8); S8.tstep = (size_t)256 * DM;
          pg8::EpiG EG{WSP(unsigned char, WS_GATES), WSP(float, WS_RINVX), F.in[20], WSP(bf16, WS_Z), F.in[6]};
          pg8::gemm_phase8<pg8::EpiG, pg8::SchedPlain, true, true>(F.lds, DM / 2, S8, EG); }
#if MK_N_LAUNCHES == 1
        xcd_arrive(bar);
#endif
        { pg8::SchedPlain S8; S8.tm.init(TOK, NGT, WGM_P1); S8.G = G; S8.c = (int)blockIdx.x; S8.A = (const char*)(F.ws + WS_XQ); S8.B = (const char*)(F.ws + WS_WG8); S8.tstep = (size_t)256 * DM;
          pg8::EpiG EG{WSP(unsigned char, WS_GATES), WSP(float, WS_RINVX), F.in[20], WSP(bf16, WS_Z), F.in[6]};
#ifndef NO8
          pg8::gemm_phase8<pg8::EpiG, pg8::SchedPlain, true, true>(F.lds, DM / 2, S8, EG);
#endif
        }
#if MK_N_LAUNCHES == 1
        xcd_wait(bar);
#else
        if (BOTH(1)) GRID_BAR();
#endif
    }
#if MK_N_LAUNCHES == 1
    {
        BgConv bg; bg.src = F.in[23]; bg.gain = F.in[22]; bg.dst = WSP(bf16, WS_WFIT); bg.h = F.vcu * NWAVES + F.wave; bg.step = G * NWAVES;
        for (int u = F.vcu; u < 512; u += G) gla_inc_unit(F, u >> 6, u & 63);
        xcd_arrive(bar);
        for (int u = F.vcu; u < 256; u += G) mem_unit(F, u >> 7, (u >> 5) & 3, u & 31);
        xcd_wait(bar);
        gla_scan(F);
        xcd_arrive(bar);
        for (int u = F.vcu; u < 256; u += G) { const int bh = u >> 5, c = u & 31; diff_unit<true>(F, bh, 63 - c, &bg); diff_unit<true>(F, bh, c, &bg); }
        xcd_wait(bar);
        for (int u = F.vcu; u < 512; u += G) gla_out_unit(F, u >> 6, u & 63);
        for (; bg.h < BG_NH; bg.h += bg.step) { f32x4 v[4], gv; bg_load(bg, v, gv, F.lane); bg_store(bg, v, gv, F.lane); }
        GRID_BAR();
    }
#else
    if (IN(2)) {
        for (int rep = 0; rep < NREP(2); ++rep) for (int u = F.vcu; u < 512; u += G) gla_inc_unit(F, u >> 6, u & 63);
        if (BOTH(2)) GRID_BAR();
    }
    if (IN(3)) { gla_scan(F); for (int rep = 0; rep < NREP(4); ++rep) for (int u = F.vcu; u < 256; u += G) mem_unit(F, u >> 7, (u >> 5) & 3, u & 31); if (BOTH(3)) GRID_BAR(); }
    if (IN(4)) {
        for (int rep = 0; rep < NREP(6); ++rep) for (int u = F.vcu; u < 512; u += G) gla_out_unit(F, u >> 6, u & 63);
        { BgConv bg; bg.src = F.in[23]; bg.gain = F.in[22]; bg.dst = WSP(bf16, WS_WFIT); bg.h = F.vcu * NWAVES + F.wave; bg.step = G * NWAVES;
          for (int rep = 0; rep < NREP(5); ++rep) for (int u = F.vcu; u < 256; u += G) { const int bh = u >> 5, c = u & 31; diff_unit<true>(F, bh, 63 - c, &bg); diff_unit<true>(F, bh, c, &bg); }
          for (; bg.h < BG_NH; bg.h += bg.step) { f32x4 v[4], gv; bg_load(bg, v, gv, F.lane); bg_store(bg, v, gv, F.lane); } }
        if (BOTH(4)) GRID_BAR();
    }
#endif
    if (IN(5)) {
        pg8::SchedP3 S; S.tm.init(TOK, DM, WGM_P3); S.G = G; S.c = (int)blockIdx.x; S.A = (const char*)F.out; S.A2 = (const char*)WSP(bf16, WS_YMEM); S.B = (const char*)WSP(bf16, WS_WBT);
        S.tstep = (size_t)256 * 1024 * 2; S.astride = (size_t)TOK * 1024 * 2; S.bstride = (size_t)DM * 1024 * 2;
        pg8::Epi3 E{WSP(unsigned char, WS_GATES), WSP(bf16, WS_MERGED)};
        for (int rep = 0; rep < NREP(7); ++rep) pg8::gemm_phase<pg8::Epi3, pg8::SchedP3, true, true>(F.lds, 1024, S, E);
        if (BOTH(5)) GRID_BAR();
    }
    if (IN(6)) {
        pg8::SchedPlain S; S.tm.init(TOK, DM, WGM_P4); S.G = G; S.c = (int)blockIdx.x; S.A = (const char*)WSP(bf16, WS_MERGED); S.B = (const char*)WSP(bf16, WS_WOT); S.tstep = (size_t)256 * DM * 2;
        pg8::Epi4 E{XBP, WSP(bf16, WS_X1B), WSP(float, WS_SS8)};
        for (int rep = 0; rep < NREP(8); ++rep) pg8::gemm_phase<pg8::Epi4, pg8::SchedPlain, false, true>(F.lds, DM, S, E);
        if (BOTH(6)) GRID_BAR();
    }
    if (IN(7)) {
        pg8::SchedPlain S; S.tm.init(TOK, 2 * DFF, WGM_P5); S.G = G; S.c = (int)blockIdx.x; S.A = (const char*)WSP(bf16, WS_X1B); S.B = (const char*)WSP(bf16, WS_WFIT); S.tstep = (size_t)256 * DM * 2;
        { LAS float* rt = (LAS float*)(F.lds + RING_BYTES); const float* ss8 = WSP(float, WS_SS8);
          for (int e = F.tid; e < 8 * BM_ROWS; e += NWAVES * 64) { const int ord = e >> 8, row = e & 255; pg8::Unit uu;
              if (S.next(ord, uu)) { const float* p = ss8 + (size_t)(uu.pm * BM_ROWS + row) * 8; const f32x4 s0 = *(const f32x4*)p, s1 = *(const f32x4*)(p + 4);
                  rt[e] = frsq((((s0[0] + s0[1]) + (s0[2] + s0[3])) + ((s1[0] + s1[1]) + (s1[2] + s1[3]))) * (1.0f / DM) + NORM_EPS); } }
          __syncthreads(); }
        pg8::Epi5 E{(const LAS float*)(F.lds + RING_BYTES), WSP(bf16, WS_ACT)};
        pg8::gemm_phase<pg8::Epi5, pg8::SchedPlain, true, true>(F.lds, DM, S, E);
        { const int nfull = S.tm.nwg % G;
          if (nfull > 0 && (int)blockIdx.x >= nfull) p5_tail_convert(F, nfull, G - nfull); else if (nfull == 0) p5_tail_convert(F, 0, G); }
        if (BOTH(7)) GRID_BAR();
    }
    if (IN(8)) {
        pg8::SchedPlain S; S.tm.init(TOK, DM, WGM_P6); S.G = G; S.c = (int)blockIdx.x; S.A = (const char*)WSP(bf16, WS_ACT); S.B = (const char*)WSP(bf16, WS_WFDT); S.tstep = (size_t)256 * DFF * 2;
        pg8::Epi6 E{WSP(bf16, WS_X1B), F.out};
        pg8::gemm_phase<pg8::Epi6, pg8::SchedPlain, true, true>(F.lds, DFF, S, E);
    }
#undef IN
#undef BOTH
}

extern "C" void kernel_launch(void* const* d_in, const int* in_sizes, int n_in, void* d_out, int out_size, void* d_ws, size_t ws_size, hipStream_t stream) {
    static int grid = 0;
    if (grid == 0) {
        if (n_in != 25 || in_sizes[0] != TOK * DM || out_size != TOK * DM || ws_size < WS_END) {
            fprintf(stderr, "kernel_launch: unexpected problem: n_in %d in0 %d out %d ws %zu (need %zu)\n", n_in, n_in > 0 ? in_sizes[0] : -1, out_size, ws_size, (size_t)WS_END); grid = -1; return; }
        int dev = 0, cus = 0, per_cu = 0;
        if (hipGetDevice(&dev) != hipSuccess || hipDeviceGetAttribute(&cus, hipDeviceAttributeMultiprocessorCount, dev) != hipSuccess) { grid = -1; return; }
        if (hipFuncSetAttribute((const void*)mk_fwd, hipFuncAttributeMaxDynamicSharedMemorySize, LDS_BYTES) != hipSuccess) { fprintf(stderr, "kernel_launch: hipFuncSetAttribute failed\n"); grid = -1; return; }
        if (hipOccupancyMaxActiveBlocksPerMultiprocessor(&per_cu, (const void*)mk_fwd, NWAVES * 64, LDS_BYTES) != hipSuccess || per_cu < 1) { fprintf(stderr, "kernel_launch: occupancy query says %d\n", per_cu); per_cu = 1; }
        (void)hipGetLastError();
        grid = cus;
        if (grid != 256) fprintf(stderr, "kernel_launch: note: %d CUs (P4's epilogue expects 256 workgroups)\n", grid);
    }
    if (grid < 0) return;
    (void)hipMemsetAsync((char*)d_ws + WS_CTL, 0, CTL_ZERO_BYTES, stream);
    Args a{};
    for (int i = 0; i < 25; ++i) a.in[i] = (const float*)d_in[i];
    a.out = (float*)d_out; a.ws = (unsigned char*)d_ws;
    if (MK_N_LAUNCHES == 1) {
        a.ph_lo = 0; a.ph_hi = N_PHASES; a.li = 0;
        hipLaunchKernelGGL(mk_fwd, dim3(grid), dim3(NWAVES * 64), LDS_BYTES, stream, a);
    } else {
        for (int li = 0; li < N_PHASES; ++li) { a.ph_lo = li; a.ph_hi = li + 1; a.li = li; hipLaunchKernelGGL(mk_fwd, dim3(grid), dim3(NWAVES * 64), LDS_BYTES, stream, a); }
    }
}
```
